# Optimizing an MI355X kernel written in HIP

```python
import math
import jax, jax.numpy as jnp
from jax import lax
import numpy as np

D_MODEL = 1024
BATCH = 16
SEQ = 4096
DEPTH = 2

CTX_LEN = 256
GRID_W = 64
MIX_WIDTH = D_MODEL
GROUP_W = MIX_WIDTH // 4
N_SUB = 4
SUB_W = GROUP_W // N_SUB
CONV_W = 3
POOL_WINDOWS = (2, 4, 8, 16)
MLA_HEADS = 4
MLA_NOPE = GROUP_W // MLA_HEADS
MLA_ROPE = MLA_NOPE // 2
MLA_V = GROUP_W // MLA_HEADS
MLA_Q_RANK = GROUP_W
MLA_KV_RANK = GROUP_W // 2
MLA_SCALE = 1.0 / math.sqrt(MLA_NOPE + MLA_ROPE)
ROPE_BASE = 10000.0
D_FF = 4 * D_MODEL
EPS = 1e-6
Q_BLOCK = 128

OFF_FOURIER = 0
OFF_CONV = OFF_FOURIER + GROUP_W
OFF_POOL = OFF_CONV + 3 * GROUP_W
OFF_MLA_Q = OFF_POOL + GROUP_W
OFF_MLA_KV = OFF_MLA_Q + MLA_Q_RANK
OFF_MLA_KR = OFF_MLA_KV + MLA_KV_RANK
IN_COLS = OFF_MLA_KR + MLA_ROPE

kernel_name = "hybrid_fourier_conv_pool_mla_dit"


def rmsnorm(x, g):
    xf = x.astype(jnp.float32)
    y = xf * lax.rsqrt(jnp.mean(xf * xf, axis=-1, keepdims=True) + EPS)
    return (y * g.astype(jnp.float32)).astype(x.dtype)


def modulate(h, shift, scale):
    return h * (1.0 + scale) + shift


def axial_rope_tables(n):
    rows = n // GRID_W
    row = jnp.repeat(jnp.arange(rows, dtype=jnp.float32), GRID_W)
    col = jnp.tile(jnp.arange(GRID_W, dtype=jnp.float32), rows)
    half = MLA_ROPE // 2
    inv = ROPE_BASE ** (-jnp.arange(0, half, 2, dtype=jnp.float32) / half)
    ang_r = row[:, None] * inv[None, :]
    ang_c = col[:, None] * inv[None, :]
    ang = jnp.concatenate([ang_r, ang_r, ang_c, ang_c], axis=-1)
    return jnp.cos(ang), jnp.sin(ang)


def apply_axial_rope(x, cos, sin):
    half = MLA_ROPE // 2
    quarter = half // 2

    def rot(v):
        return jnp.concatenate([-v[..., quarter:], v[..., :quarter]], axis=-1)

    rotated = jnp.concatenate([rot(x[..., :half]), rot(x[..., half:])], axis=-1)
    return x * cos.astype(x.dtype) + rotated * sin.astype(x.dtype)


def fourier_mix(u, w):
    b, n, _ = u.shape
    f = jnp.fft.fft2(u.astype(jnp.float32).reshape(b, n, N_SUB, SUB_W), axes=(1, 3), norm="ortho").real
    return f.reshape(b, n, GROUP_W).astype(u.dtype) @ w


def short_conv_mix(u, conv_w):
    bg, cg, xin = jnp.split(u, 3, axis=-1)
    z = cg * xin
    n = z.shape[1]
    pad = CONV_W // 2
    zp = jnp.pad(z, ((0, 0), (pad, CONV_W - 1 - pad), (0, 0)))
    y = sum(zp[:, k:k + n] * conv_w[k] for k in range(CONV_W))
    return bg * y


def pool_mix(u, pool_w, pool_scale):
    b, n, _ = u.shape
    uf = u.astype(jnp.float32)
    cs = jnp.concatenate([jnp.zeros((b, 1, GROUP_W), jnp.float32), jnp.cumsum(uf, axis=1)], axis=1)
    t = jnp.arange(n)
    outs = []
    for g, w in enumerate(POOL_WINDOWS):
        lo = jnp.maximum(t - w // 2, 0)
        hi = jnp.minimum(t + w // 2 - 1, n - 1)
        sl = slice(g * SUB_W, (g + 1) * SUB_W)
        csg = cs[..., sl]
        s = jnp.take(csg, hi + 1, axis=1) - jnp.take(csg, lo, axis=1)
        cnt = (hi - lo + 1).astype(jnp.float32)[None, :, None]
        outs.append((s / cnt - uf[..., sl]).astype(u.dtype) @ pool_w[g])
    return jnp.concatenate(outs, axis=-1) * pool_scale


def mla_project(p, q_norm_g, w_uq, kv_norm_g, w_ukv):
    b, n, _ = p.shape
    cq = p[..., OFF_MLA_Q:OFF_MLA_KV]
    ckv = p[..., OFF_MLA_KV:OFF_MLA_KR]
    k_pe = p[..., OFF_MLA_KR:IN_COLS]
    q = (rmsnorm(cq, q_norm_g) @ w_uq).reshape(b, n, MLA_HEADS, MLA_NOPE + MLA_ROPE)
    kv = (rmsnorm(ckv, kv_norm_g) @ w_ukv).reshape(b, n, MLA_HEADS, MLA_NOPE + MLA_V)
    return q[..., :MLA_NOPE], q[..., MLA_NOPE:], kv[..., :MLA_NOPE], k_pe, kv[..., MLA_NOPE:]


def mla_attend(q_nope, q_pe, k_nope, k_pe, v):
    s = (jnp.einsum('bqhd,bkhd->bhqk', q_nope, k_nope, preferred_element_type=jnp.float32)
         + jnp.einsum('bqhr,bkr->bhqk', q_pe, k_pe, preferred_element_type=jnp.float32))
    p = jax.nn.softmax(s * MLA_SCALE, axis=-1)
    return jnp.einsum('bhqk,bkhd->bqhd', p.astype(v.dtype), v)


def blocked_mla_attend(q_nope, q_pe, k_nope, k_pe, v):
    b, n = q_nope.shape[:2]
    nb = n // Q_BLOCK
    qn = q_nope.reshape(b, nb, Q_BLOCK, MLA_HEADS, MLA_NOPE).transpose(1, 0, 2, 3, 4)
    qp = q_pe.reshape(b, nb, Q_BLOCK, MLA_HEADS, MLA_ROPE).transpose(1, 0, 2, 3, 4)
    out = lax.map(lambda qs: mla_attend(qs[0], qs[1], k_nope, k_pe, v), (qn, qp))
    return out.transpose(1, 0, 2, 3, 4).reshape(b, n, MLA_HEADS * MLA_V)


def local_mixers(p, fourier_w, conv_w, pool_w, pool_scale):
    return (fourier_mix(p[..., OFF_FOURIER:OFF_CONV], fourier_w),
            short_conv_mix(p[..., OFF_CONV:OFF_POOL], conv_w),
            pool_mix(p[..., OFF_POOL:OFF_MLA_Q], pool_w, pool_scale))


def sq_relu_mlp(h, w1, w2):
    return jnp.square(jax.nn.relu(h @ w1)) @ w2


def setup_inputs(seed: int = 0) -> dict:
    key = jax.random.key(seed)
    ks = jax.random.split(key, 24)
    f32 = jnp.float32
    nrm = lambda k, shape, s: jax.random.normal(k, shape, f32) * s
    L = DEPTH
    return {
        "x": nrm(ks[0], (BATCH, SEQ, D_MODEL), 1.0),
        "c": nrm(ks[1], (BATCH, D_MODEL), 1.0),
        "ctx": nrm(ks[2], (BATCH, CTX_LEN, D_MODEL), 1.0),
        "c_ctx": nrm(ks[3], (D_MODEL,), 1.0),
        "ada_w": nrm(ks[4], (L, D_MODEL, 6 * D_MODEL), 0.5 * D_MODEL ** -0.5),
        "ada_b": nrm(ks[5], (L, 6 * D_MODEL), 0.02),
        "norm1_g": 1.0 + nrm(ks[6], (L, D_MODEL), 0.05),
        "norm2_g": 1.0 + nrm(ks[7], (L, D_MODEL), 0.05),
        "w_in": nrm(ks[8], (L, D_MODEL, IN_COLS), D_MODEL ** -0.5),
        "fourier_w": nrm(ks[9], (L, GROUP_W, GROUP_W), GROUP_W ** -0.5),
        "conv_w": nrm(ks[10], (L, CONV_W, GROUP_W), CONV_W ** -0.5),
        "pool_w": nrm(ks[11], (L, N_SUB, SUB_W, SUB_W), SUB_W ** -0.5),
        "pool_scale": 1.0 + nrm(ks[12], (L, GROUP_W), 0.1),
        "q_norm_g": 1.0 + nrm(ks[13], (L, MLA_Q_RANK), 0.05),
        "w_uq": nrm(ks[14], (L, MLA_Q_RANK, MLA_HEADS * (MLA_NOPE + MLA_ROPE)), MLA_Q_RANK ** -0.5),
        "kv_norm_g": 1.0 + nrm(ks[15], (L, MLA_KV_RANK), 0.05),
        "w_ukv": nrm(ks[16], (L, MLA_KV_RANK, MLA_HEADS * (MLA_NOPE + MLA_V)), MLA_KV_RANK ** -0.5),
        "w_out": nrm(ks[17], (L, MIX_WIDTH, D_MODEL), MIX_WIDTH ** -0.5),
        "mlp_w1": nrm(ks[18], (L, D_MODEL, D_FF), D_MODEL ** -0.5),
        "mlp_w2": nrm(ks[19], (L, D_FF, D_MODEL), D_FF ** -0.5),
        "final_norm_g": 1.0 + nrm(ks[20], (D_MODEL,), 0.05),
    }


def reference(x, c, ctx, c_ctx, ada_w, ada_b, norm1_g, norm2_g, w_in, fourier_w, conv_w,
              pool_w, pool_scale, q_norm_g, w_uq, kv_norm_g, w_ukv, w_out, mlp_w1, mlp_w2,
              final_norm_g):
    b, n, _ = x.shape
    cos, sin = axial_rope_tables(n)
    for l in range(DEPTH):
        last = l == DEPTH - 1
        mod_x = (jax.nn.silu(c) @ ada_w[l] + ada_b[l])[:, None, :]
        mod_c = jax.nn.silu(c_ctx) @ ada_w[l] + ada_b[l]
        sh1x, sc1x, g1x, sh2x, sc2x, g2x = jnp.split(mod_x, 6, axis=-1)
        sh1c, sc1c, g1c, sh2c, sc2c, g2c = jnp.split(mod_c, 6, axis=-1)

        hx = modulate(rmsnorm(x, norm1_g[l]), sh1x, sc1x)
        hc = modulate(rmsnorm(ctx, norm1_g[l]), sh1c, sc1c)
        px = hx @ w_in[l]
        pc = hc @ w_in[l]

        qn_c, qp_c, kn_c, kp_c, v_c = mla_project(pc, q_norm_g[l], w_uq[l], kv_norm_g[l], w_ukv[l])
        qn_x, qp_x, kn_x, kp_x, v_x = mla_project(px, q_norm_g[l], w_uq[l], kv_norm_g[l], w_ukv[l])
        qp_x = apply_axial_rope(qp_x, cos[:, None, :], sin[:, None, :])
        kp_x = apply_axial_rope(kp_x, cos, sin)
        kn_all = jnp.concatenate([kn_c, kn_x], axis=1)
        kp_all = jnp.concatenate([kp_c, kp_x], axis=1)
        v_all = jnp.concatenate([v_c, v_x], axis=1)
        attn_x = blocked_mla_attend(qn_x, qp_x, kn_all, kp_all, v_all)

        f_x, s_x, p_x = local_mixers(px, fourier_w[l], conv_w[l], pool_w[l], pool_scale[l])
        out_x = jnp.concatenate([f_x, s_x, p_x, attn_x], axis=-1) @ w_out[l]
        x = x + g1x * out_x
        x = x + g2x * sq_relu_mlp(modulate(rmsnorm(x, norm2_g[l]), sh2x, sc2x), mlp_w1[l], mlp_w2[l])

        if not last:
            attn_c = mla_attend(qn_c, qp_c, kn_c, kp_c, v_c).reshape(b, -1, GROUP_W)
            f_c, s_c, p_c = local_mixers(pc, fourier_w[l], conv_w[l], pool_w[l], pool_scale[l])
            out_c = jnp.concatenate([f_c, s_c, p_c, attn_c], axis=-1) @ w_out[l]
            ctx = ctx + g1c * out_c
            ctx = ctx + g2c * sq_relu_mlp(modulate(rmsnorm(ctx, norm2_g[l]), sh2c, sc2c), mlp_w1[l], mlp_w2[l])
    return rmsnorm(x, final_norm_g)
```

```cpp
#include <hip/hip_runtime.h>
#include <hip/hip_cooperative_groups.h>
#include <cstdio>
#include <cstdint>
namespace cg = cooperative_groups;

#define LAS __attribute__((address_space(3)))
typedef unsigned short bf16_t;
typedef short bf16x8 __attribute__((ext_vector_type(8)));
typedef short s16x4 __attribute__((ext_vector_type(4)));
typedef float f32x4 __attribute__((ext_vector_type(4)));
typedef float f32x2 __attribute__((ext_vector_type(2)));
typedef float f32x16 __attribute__((ext_vector_type(16)));
typedef unsigned u32x4 __attribute__((ext_vector_type(4)));
typedef unsigned u32x2 __attribute__((ext_vector_type(2)));

constexpr int NB = 16, SEQ = 4096, DM = 1024, CTX = 256, ML = NB * SEQ, MC = NB * CTX, MT = ML + MC;
constexpr int LDP = 1792, DFF = 4096, NKEY = SEQ + CTX, NHEAD = 4, QKD = 96;
constexpr float EPS = 1e-6f;
constexpr float QSCALE = 0.10206207261596577f * 1.4426950408889634f;

constexpr size_t MiB = 1u << 20;
constexpr size_t WL = 24 * MiB;
constexpr size_t O_WIN = 0, O_WOUT = 3670016, O_W1 = 5767168, O_W2 = 14155776, O_WUQ = 22544384, O_WK = 22806528, O_WV = 22872064, O_WF = 22937600, O_POOL = 23199744;
constexpr size_t WS_CTL = 48 * MiB + 832 * 1024, CTL_BYTES = 16384;
constexpr size_t WS_MOD = 48 * MiB, WS_RQ = 49 * MiB, WS_RKV = 49 * MiB + 512 * 1024, WS_DFTC = 50 * MiB, WS_DFT = 51 * MiB, WS_XC = 115 * MiB, WS_H = 131 * MiB, WS_OV = 267 * MiB;
constexpr size_t WS_P = WS_OV, WS_MIX = WS_OV + 238 * MiB, WS_UT = WS_OV + 374 * MiB, WS_UTC = WS_OV + 438 * MiB, WS_Q = WS_OV + 442 * MiB, WS_QC = WS_OV + 490 * MiB,
                 WS_KC = WS_OV + 493 * MiB, WS_VT = WS_OV + 544 * MiB, WS_POOLIN = WS_OV + 578 * MiB, WS_ACT = WS_OV, WS_RSS = WS_OV + 613 * MiB, RSS_STRIDE = 512 * 1024, WS_VEC = WS_OV + 615 * MiB, WS_PT = WS_OV + 617 * MiB, WS_QT = WS_OV + 649 * MiB, WS_END = WS_OV + 681 * MiB;
constexpr size_t WS_ROPE = WS_VEC + 1 * MiB;
constexpr int V_GN2 = 0, V_CB2 = 2 * 17 * 1024, V_GN1 = V_CB2 + 2 * 17 * 4096, V_CB1 = V_GN1 + 17 * 1024;

__device__ __forceinline__ unsigned cvt_pk_bf16(float lo, float hi) { unsigned r; asm volatile("v_cvt_pk_bf16_f32 %0, %1, %2" : "=v"(r) : "v"(lo), "v"(hi)); return r; }
__device__ __forceinline__ unsigned f2bf(float f) { unsigned u = __builtin_bit_cast(unsigned, f); return (u + 0x7fffu + ((u >> 16) & 1u)) >> 16; }
__device__ __forceinline__ unsigned pk2(float lo, float hi) { return f2bf(lo) | (f2bf(hi) << 16); }
__device__ __forceinline__ float bflo(unsigned w) { return __uint_as_float(w << 16); }
__device__ __forceinline__ float bfhi(unsigned w) { return __uint_as_float(w & 0xffff0000u); }
__device__ __forceinline__ float bf1(bf16_t b) { return __uint_as_float((unsigned)b << 16); }
__device__ __forceinline__ float shx(float v, int mask, int lane) { return __builtin_bit_cast(float, __builtin_amdgcn_ds_bpermute((lane ^ mask) << 2, __builtin_bit_cast(int, v))); }
__device__ __forceinline__ float wave_sum(float v, int lane) {
#pragma unroll
    for (int o = 1; o < 64; o <<= 1) v += shx(v, o, lane);
    return v;
}
__device__ __forceinline__ float invfreq(int j) {
    return j == 0 ? 1.0f : j == 1 ? 0.31622776601683794f : j == 2 ? 0.1f : j == 3 ? 0.031622776601683794f : j == 4 ? 0.01f : j == 5 ? 0.0031622776601683794f : j == 6 ? 0.001f : 0.00031622776601683794f;
}

namespace pg8 {
constexpr int BM = 256, BK = 64, HALF = 128, HTB = HALF * BK * 2, STAGE_BYTES = 8 * HTB, NXCD = 8, WGM = 8;
__host__ __device__ __forceinline__ int lds_byte(int r, int c) { const int st = (r >> 4) * 2 + (c >> 5), rr = r & 15, cc = c & 31, ob = rr * 64 + cc * 2; return st * 1024 + (ob ^ (((ob >> 9) & 1) << 5)); }
__host__ __device__ __forceinline__ void stage_rc(int b, int& R, int& C) { const int st = b / 1024, sb = b % 1024, swz = sb ^ (((sb >> 9) & 1) << 5); R = (st >> 1) * 16 + swz / 64; C = (st & 1) * 32 + (swz % 64) / 2; }
__host__ __device__ __forceinline__ int perm32(int rho) { const int n = rho >> 4, i = rho & 15; return 8 * (i >> 2) + 4 * n + (i & 3); }
struct Unit { int pm, pn; };
__device__ __forceinline__ const char* uptr(const char* p) { const unsigned long long v = (unsigned long long)p; const unsigned lo = __builtin_amdgcn_readfirstlane((unsigned)v), hi = __builtin_amdgcn_readfirstlane((unsigned)(v >> 32)); return (const char*)(((unsigned long long)hi << 32) | lo); }
struct Gemm { const bf16_t* A; const bf16_t* Bt; int M, N, K, lda, ldb; };
struct StaticOrder {
    int nM, nN, nwg, G, c;
    __device__ void init(int M, int N, int G_, int c_) { nM = M / BM; nN = N / BM; nwg = nM * nN; G = G_; c = c_; }
    __device__ bool next(int i, Unit& u) const {
        const long L = (long)i * G + c; if (L >= nwg) return false;
        int wgid = (int)L; { const int q = nwg / NXCD, r = nwg % NXCD, xcd = wgid % NXCD, off = wgid / NXCD; wgid = (xcd < r ? xcd * (q + 1) : r * (q + 1) + (xcd - r) * q) + off; }
        const int nig = WGM * nN, gid = wgid / nig, fm = gid * WGM, gsz = (nM - fm) < WGM ? (nM - fm) : WGM;
        u.pm = fm + ((wgid % nig) % gsz); u.pn = (wgid % nig) / gsz; return true;
    }
};

template <class Epi>
__device__ __forceinline__ void gemm_phase(LAS unsigned char* lds, const Gemm g, const StaticOrder& S, const Epi& E, const int tid) {
    const int wid = __builtin_amdgcn_readfirstlane(tid >> 6), lane = tid & 63, wr = wid >> 2, wc = wid & 3, fr = lane & 15, fq = lane >> 4;
    const int K = g.K, nt = K / BK;
    unsigned voffA[2], voffB[2];
#pragma unroll
    for (int i = 0; i < 2; ++i) { int R, C; stage_rc(tid * 16 + i * 8192, R, C); const int Rb = (R & ~31) + perm32(R & 31);
        voffA[i] = (unsigned)(R * g.lda + C) * 2u; voffB[i] = (unsigned)(Rb * g.ldb + C) * 2u; }
    const size_t kstep = (size_t)(BK * 2);
    const size_t hsA = (size_t)HALF * g.lda * 2, hsB = (size_t)HALF * g.ldb * 2;
    const size_t tsA = 2 * hsA, tsB = 2 * hsB;
    const unsigned ldsw = (unsigned)wid * 1024u;
    const int aoff = lds_byte(wr * 64 + fr, fq * 8), boff = lds_byte(wc * 32 + fr, fq * 8);
#define PG8_SA(b, h) (((b) * 2 + (h)) * HTB)
#define PG8_SB(b, h) ((4 + (b) * 2 + (h)) * HTB)
#define PG8_STAGE(bufoff, gbase, voff) do { const char* _gb = uptr((const char*)(gbase)); _Pragma("unroll") for (int _i = 0; _i < 2; ++_i) \
        __builtin_amdgcn_global_load_lds((const unsigned*)(_gb + (voff)[_i]), (LAS unsigned*)(lds + (bufoff) + ldsw + _i * 8192), 16, 0, 0); } while (0)
#define PG8_LDA(dst, b, h) do { _Pragma("unroll") for (int m = 0; m < 4; ++m) _Pragma("unroll") for (int k = 0; k < 2; ++k) dst[m][k] = *(const LAS bf16x8*)(lds + PG8_SA(b, h) + aoff + m * 2048 + k * 1024); } while (0)
#define PG8_LDB(dst, b, h) do { _Pragma("unroll") for (int n = 0; n < 2; ++n) _Pragma("unroll") for (int k = 0; k < 2; ++k) dst[n][k] = *(const LAS bf16x8*)(lds + PG8_SB(b, h) + boff + n * 2048 + k * 1024); } while (0)
#define PG8_MMA(ai, bj, At, Bt) do { __builtin_amdgcn_s_setprio(1); _Pragma("unroll") for (int m = 0; m < 4; ++m) _Pragma("unroll") for (int n = 0; n < 2; ++n) _Pragma("unroll") for (int k = 0; k < 2; ++k) \
        acc[ai][bj][m][n] = __builtin_amdgcn_mfma_f32_16x16x32_bf16(Bt[n][k], At[m][k], acc[ai][bj][m][n], 0, 0, 0); __builtin_amdgcn_s_setprio(0); } while (0)
#define PG8_WAIT_V(n) asm volatile("s_waitcnt vmcnt(" #n ")" ::: "memory")
#define PG8_WAIT_L(n) asm volatile("s_waitcnt lgkmcnt(" #n ")" ::: "memory")
#define PG8_BAR __builtin_amdgcn_s_barrier()
#define PG8_SCHED __builtin_amdgcn_sched_barrier(0)
    Unit cur, nxt; int ui = 0;
    if (!S.next(0, cur)) return;
    f32x4 acc[2][2][4][2];
#pragma unroll
    for (int a = 0; a < 2; ++a)
#pragma unroll
        for (int b = 0; b < 2; ++b)
#pragma unroll
            for (int m = 0; m < 4; ++m)
#pragma unroll
                for (int n = 0; n < 2; ++n) acc[a][b][m][n] = (f32x4){0.f, 0.f, 0.f, 0.f};
    bf16x8 At[4][2], B0[2][2], B1[2][2];
    const char* cA = (const char*)g.A + (size_t)cur.pm * tsA; const char* cB = (const char*)g.Bt + (size_t)cur.pn * tsB;
    PG8_STAGE(PG8_SB(0, 0), cB, voffB); PG8_STAGE(PG8_SB(0, 1), cB + hsB, voffB); PG8_STAGE(PG8_SA(0, 0), cA, voffA); PG8_STAGE(PG8_SA(0, 1), cA + hsA, voffA);
    if (wr == 1) PG8_BAR;
    PG8_WAIT_V(2); PG8_BAR;
    PG8_STAGE(PG8_SB(1, 0), cB + kstep, voffB); PG8_STAGE(PG8_SA(1, 0), cA + kstep, voffA); PG8_STAGE(PG8_SB(1, 1), cB + hsB + kstep, voffB);
    PG8_WAIT_V(6); PG8_BAR;
    for (;;) {
        const bool has_next = S.next(ui + 1, nxt);
        const char* nA = has_next ? (const char*)g.A + (size_t)nxt.pm * tsA : cA; const char* nB = has_next ? (const char*)g.Bt + (size_t)nxt.pn * tsB : cB;
        for (int t = 0; t < nt; t += 2) {
            const bool last = (t == nt - 2);
            const char* a1 = cA + (size_t)(t + 1) * kstep;
            const char* a2 = last ? nA : cA + (size_t)(t + 2) * kstep; const char* b2 = last ? nB : cB + (size_t)(t + 2) * kstep;
            const char* a3 = a2 + kstep; const char* b3 = b2 + kstep;
            PG8_LDB(B0, 0, 0); PG8_LDB(B1, 0, 1); PG8_SCHED; PG8_LDA(At, 0, 0); PG8_STAGE(PG8_SA(1, 1), a1 + hsA, voffA);
            PG8_WAIT_V(8); PG8_WAIT_L(0); PG8_BAR; PG8_MMA(0, 0, At, B0); PG8_MMA(0, 1, At, B1); PG8_BAR; PG8_SCHED;
            PG8_LDA(At, 0, 1); PG8_STAGE(PG8_SB(0, 0), b2, voffB); PG8_STAGE(PG8_SB(0, 1), b2 + hsB, voffB); PG8_STAGE(PG8_SA(0, 0), a2, voffA);
            PG8_WAIT_V(8); PG8_WAIT_L(0); PG8_BAR; PG8_MMA(1, 0, At, B0); PG8_MMA(1, 1, At, B1); PG8_BAR; PG8_SCHED;
            PG8_LDB(B0, 1, 0); PG8_LDB(B1, 1, 1); PG8_SCHED; PG8_LDA(At, 1, 0); PG8_STAGE(PG8_SA(0, 1), a2 + hsA, voffA);
            PG8_WAIT_V(8); PG8_WAIT_L(0); PG8_BAR; PG8_MMA(0, 0, At, B0); PG8_MMA(0, 1, At, B1); PG8_BAR; PG8_SCHED;
            PG8_LDA(At, 1, 1); PG8_STAGE(PG8_SB(1, 0), b3, voffB); PG8_STAGE(PG8_SB(1, 1), b3 + hsB, voffB); PG8_STAGE(PG8_SA(1, 0), a3, voffA);
            PG8_WAIT_V(8); PG8_WAIT_L(0); PG8_BAR; PG8_MMA(1, 0, At, B0); PG8_MMA(1, 1, At, B1); PG8_BAR; PG8_SCHED;
        }
        if (wr == 0) PG8_BAR;
        E(acc, cur, wr, wc, fr, fq);
        if (!has_next) break;
#pragma unroll
        for (int a = 0; a < 2; ++a)
#pragma unroll
            for (int b = 0; b < 2; ++b)
#pragma unroll
                for (int m = 0; m < 4; ++m)
#pragma unroll
                    for (int n = 0; n < 2; ++n) acc[a][b][m][n] = (f32x4){0.f, 0.f, 0.f, 0.f};
        cur = nxt; cA = nA; cB = nB; ++ui;
        if (wr == 1) PG8_BAR;
    }
    PG8_WAIT_V(0);
    PG8_BAR;
#undef PG8_SA
#undef PG8_SB
#undef PG8_STAGE
#undef PG8_LDA
#undef PG8_LDB
#undef PG8_MMA
#undef PG8_WAIT_V
#undef PG8_WAIT_L
#undef PG8_BAR
#undef PG8_SCHED
}
}

enum { M_P = 0, M_UT = 1, M_Q = 2, M_K = 3, M_VT = 4, M_POOL = 5, M_DFT = 6, M_DFTC = 7, M_RES = 8, M_RELU2 = 9, M_PS = 10, M_F32 = 11 };
struct EpiArgs {
    bf16_t* o0; bf16_t* o1;
    const float* f0; const float* f1;
    float* x0; float* x1;
    int ld; int goff;
};
__device__ __forceinline__ u32x4 pack8(const f32x4& a, const f32x4& b) { u32x4 w; w.x = cvt_pk_bf16(a[0], a[1]); w.y = cvt_pk_bf16(a[2], a[3]); w.z = cvt_pk_bf16(b[0], b[1]); w.w = cvt_pk_bf16(b[2], b[3]); return w; }

#define GAS __attribute__((address_space(1)))
typedef GAS u32x4* gv4p; typedef GAS f32x4* gf4p; typedef const GAS f32x4* gcf4p; typedef const GAS float* gcfp;
template <int MODE> __device__ __forceinline__ void store8(const EpiArgs& e, int row, int col, f32x4 v0, f32x4 v1, const f32x4 sA, const f32x4 sB) {
    if constexpr (MODE == M_P || MODE == M_PS) {
        *(gv4p)(e.o0 + (size_t)row * e.ld + col) = pack8(v0, v1);
    } else if constexpr (MODE == M_UT) {
        const int part = row >> 8, n = row & 255;
        bf16_t* dst;
        if (col < ML) { const int b = col >> 12, t = col & 4095; dst = e.o0 + ((size_t)(b * 256 + n) * 8192 + part * 4096 + t); }
        else { const int cc = col - ML, b = cc >> 8, t = cc & 255; dst = e.o1 + ((size_t)(b * 256 + n) * 512 + part * 256 + t); }
        *(gv4p)dst = pack8(v0, v1);
    } else if constexpr (MODE == M_Q) {
        if (col < 384) {
            const float s = sA[0];
            bf16_t* dst = row < ML ? e.o0 + (size_t)row * 384 + col : e.o1 + (size_t)(row - ML) * 384 + col;
            *(gv4p)dst = pack8(v0 * s, v1 * s);
        }
    } else if constexpr (MODE == M_K) {
        const int h = col >> 6, d = col & 63; const float s = sA[0];
        int b, key; if (row < ML) { b = row >> 12; key = CTX + (row & 4095); } else { const int rr = row - ML; b = rr >> 8; key = rr & 255; }
        *(gv4p)(e.o0 + ((size_t)((b * 4 + h) * NKEY + key) * QKD + d)) = pack8(v0 * s, v1 * s);
    } else if constexpr (MODE == M_VT) {
        int b, key; if (col < ML) { b = col >> 12; key = CTX + (col & 4095); } else { const int cc = col - ML; b = cc >> 8; key = cc & 255; }
        *(gv4p)(e.o0 + ((size_t)(b * 256 + row) * NKEY + key)) = pack8(v0 * sA, v1 * sB);
    } else if constexpr (MODE == M_POOL) {
        *(gv4p)(e.o0 + (size_t)row * DM + 512 + col) = pack8(v0 * sA, v1 * sB);
    } else if constexpr (MODE == M_DFT) {
        const int b = col >> 8, n = col & 255;
        *(gv4p)(e.o0 + (size_t)(b * SEQ + row) * DM + n) = pack8(v0 * (1.f / 512.f), v1 * (1.f / 512.f));
    } else if constexpr (MODE == M_F32) {
        GAS float* d = (GAS float*)e.o0 + (size_t)row * 4096 + col; *(gf4p)d = v0; *(gf4p)(d + 4) = v1;
    } else if constexpr (MODE == M_DFTC) {
        const int b = col >> 8, n = col & 255;
        *(gv4p)(e.o0 + (size_t)(ML + b * CTX + row) * DM + n) = pack8(v0 * (1.f / 128.f), v1 * (1.f / 128.f));
    } else if constexpr (MODE == M_RELU2) {
#pragma unroll
        for (int i = 0; i < 4; ++i) { const float a = fmaxf(v0[i], 0.f), b = fmaxf(v1[i], 0.f); v0[i] = a * a; v1[i] = b * b; }
        *(gv4p)(e.o0 + (size_t)row * e.ld + col) = pack8(v0, v1);
    }
}
template <int MODE> __device__ __forceinline__ void epi_loops(const EpiArgs& e, const f32x4 (&acc)[2][2][4][2], const pg8::Unit& u, int wr, int wc, int fr, int fq) {
    const int row0 = u.pm * 256 + wr * 64 + fr, col0 = u.pn * 256 + wc * 32 + 8 * fq;
    const f32x4 zero4 = (f32x4){0.f, 0.f, 0.f, 0.f};
    if constexpr (MODE == M_RES) {
        const int bi = row0 < ML ? (row0 >> 12) : 16;
        gcfp gp = (gcfp)((const float*)e.o1 + (size_t)bi * 6144 + e.goff + col0);
        f32x4 gt[2][2];
#pragma unroll
        for (int bj = 0; bj < 2; ++bj) { gt[bj][0] = *(gcf4p)(gp + bj * 128); gt[bj][1] = *(gcf4p)(gp + bj * 128 + 4); }
        const bool lat = row0 < ML;
        gcfp sbase = lat ? (gcfp)(e.f0 + (size_t)row0 * DM + col0) : (gcfp)(e.f1 + (size_t)(row0 - ML) * DM + col0);
        GAS float* dbase = lat ? (GAS float*)(e.x0 + (size_t)row0 * DM + col0) : (GAS float*)(e.x1 + (size_t)(row0 - ML) * DM + col0);
        const int emit = e.ld;
        unsigned char* wsb = (unsigned char*)e.x1 - WS_XC;
        const float* vec = (const float*)(wsb + WS_VEC);
        gcfp gnp = (gcfp)(vec + (emit == 3 ? V_GN1 : V_GN2 + (emit == 2 ? 17 * 1024 : 0)) + bi * 1024 + col0);
        GAS float* rss = (GAS float*)(wsb + WS_RSS + (size_t)(emit > 0 ? emit - 1 : 0) * RSS_STRIDE) + row0;
        GAS bf16_t* hbase = (GAS bf16_t*)(wsb + WS_H) + (size_t)row0 * DM + col0;
        f32x4 gn[2][2];
#pragma unroll
        for (int bj = 0; bj < 2; ++bj) { gn[bj][0] = emit ? *(gcf4p)(gnp + bj * 128) : zero4; gn[bj][1] = emit ? *(gcf4p)(gnp + bj * 128 + 4) : zero4; }
        const int lane_e = fq * 16 + fr;
        f32x4 cur[2][2], nxt[2][2];
#pragma unroll
        for (int bj = 0; bj < 2; ++bj) { cur[bj][0] = *(gcf4p)(sbase + bj * 128); cur[bj][1] = *(gcf4p)(sbase + bj * 128 + 4); }
#pragma unroll
        for (int g = 0; g < 8; ++g) {
            const int ai = g >> 2, m = g & 3;
            if (g + 1 < 8) { const int a2 = (g + 1) >> 2, m2 = (g + 1) & 3; const size_t off = (size_t)(a2 * 128 + m2 * 16) * DM;
#pragma unroll
                for (int bj = 0; bj < 2; ++bj) { nxt[bj][0] = *(gcf4p)(sbase + off + bj * 128); nxt[bj][1] = *(gcf4p)(sbase + off + bj * 128 + 4); } }
            const size_t offc = (size_t)(ai * 128 + m * 16) * DM;
            float sq = 0.f;
#pragma unroll
            for (int bj = 0; bj < 2; ++bj) {
                const f32x4 x0 = cur[bj][0] + gt[bj][0] * acc[ai][bj][m][0], x1 = cur[bj][1] + gt[bj][1] * acc[ai][bj][m][1];
                *(gf4p)(dbase + offc + bj * 128) = x0; *(gf4p)(dbase + offc + bj * 128 + 4) = x1;
                if (emit) { *(gv4p)(hbase + offc + bj * 128) = pack8(x0 * gn[bj][0], x1 * gn[bj][1]);
                    sq += (x0[0] * x0[0] + x0[1] * x0[1]) + (x0[2] * x0[2] + x0[3] * x0[3]) + (x1[0] * x1[0] + x1[1] * x1[1]) + (x1[2] * x1[2] + x1[3] * x1[3]); }
            }
            if (emit) { sq += shx(sq, 16, lane_e); sq += shx(sq, 32, lane_e); if (fq == 0) atomicAdd((float*)(rss + ai * 128 + m * 16), sq); }
            asm volatile("" ::: "memory");
#pragma unroll
            for (int bj = 0; bj < 2; ++bj) { cur[bj][0] = nxt[bj][0]; cur[bj][1] = nxt[bj][1]; }
        }
    } else {
        float rs[8]; f32x4 cs[2][2];
        if constexpr (MODE == M_Q || MODE == M_K) {
#pragma unroll
            for (int g = 0; g < 8; ++g) rs[g] = ((gcfp)e.f0)[row0 + (g >> 2) * 128 + (g & 3) * 16] * (MODE == M_Q ? QSCALE : 1.0f);
        }
        if constexpr (MODE == M_VT || MODE == M_POOL) {
#pragma unroll
            for (int bj = 0; bj < 2; ++bj) { cs[bj][0] = *(gcf4p)(e.f0 + col0 + bj * 128); cs[bj][1] = *(gcf4p)(e.f0 + col0 + bj * 128 + 4); }
        }
        if constexpr (MODE == M_RELU2 || MODE == M_PS) {
            const int bi = row0 < ML ? (row0 >> 12) : 16;
#pragma unroll
            for (int g = 0; g < 8; ++g) rs[g] = 1.0f / sqrtf(((gcfp)e.f0)[row0 + (g >> 2) * 128 + (g & 3) * 16] * (1.f / DM) + EPS);
#pragma unroll
            for (int bj = 0; bj < 2; ++bj) { cs[bj][0] = *(gcf4p)(e.f1 + (size_t)bi * e.goff + col0 + bj * 128); cs[bj][1] = *(gcf4p)(e.f1 + (size_t)bi * e.goff + col0 + bj * 128 + 4); }
        }
#pragma unroll
        for (int ai = 0; ai < 2; ++ai)
#pragma unroll
            for (int m = 0; m < 4; ++m)
#pragma unroll
                for (int bj = 0; bj < 2; ++bj) {
                    f32x4 sA = zero4, sB = zero4;
                    if constexpr (MODE == M_Q || MODE == M_K) sA[0] = rs[ai * 4 + m];
                    if constexpr (MODE == M_VT || MODE == M_POOL) { sA = cs[bj][0]; sB = cs[bj][1]; }
                    if constexpr (MODE == M_RELU2 || MODE == M_PS) { const float rr = rs[ai * 4 + m];
                        store8<MODE>(e, row0 + ai * 128 + m * 16, col0 + bj * 128, acc[ai][bj][m][0] * rr + cs[bj][0], acc[ai][bj][m][1] * rr + cs[bj][1], sA, sB); }
                    else
                    store8<MODE>(e, row0 + ai * 128 + m * 16, col0 + bj * 128, acc[ai][bj][m][0], acc[ai][bj][m][1], sA, sB);
                }
    }
}
struct Epi {
    int mode; EpiArgs e;
    __device__ __forceinline__ void operator()(const f32x4 (&acc)[2][2][4][2], const pg8::Unit& u, int wr, int wc, int fr, int fq) const {
        switch (mode) {
            case M_P: epi_loops<M_P>(e, acc, u, wr, wc, fr, fq); break;
            case M_UT: epi_loops<M_UT>(e, acc, u, wr, wc, fr, fq); break;
            case M_Q: epi_loops<M_Q>(e, acc, u, wr, wc, fr, fq); break;
            case M_K: epi_loops<M_K>(e, acc, u, wr, wc, fr, fq); break;
            case M_VT: epi_loops<M_VT>(e, acc, u, wr, wc, fr, fq); break;
            case M_POOL: epi_loops<M_POOL>(e, acc, u, wr, wc, fr, fq); break;
            case M_DFTC: epi_loops<M_DFTC>(e, acc, u, wr, wc, fr, fq); break;
            case M_RES: epi_loops<M_RES>(e, acc, u, wr, wc, fr, fq); break;
            case M_PS: epi_loops<M_PS>(e, acc, u, wr, wc, fr, fq); break;
            case M_F32: epi_loops<M_F32>(e, acc, u, wr, wc, fr, fq); break;
            default: epi_loops<M_RELU2>(e, acc, u, wr, wc, fr, fq); break;
        }
    }
};

struct Args { const float* in[21]; float* out; unsigned char* ws; int ph_lo, ph_hi; };
typedef const __attribute__((address_space(4))) Args* KArgs;

__device__ __forceinline__ void transpose_item(const float* W, int K, int N, bf16_t* WT, LAS float* scr, int item, int lane) {
    const int nblk = N / 32, kb = item / nblk, nb = item % nblk, k0 = 64 * kb, n0 = 32 * nb;
#pragma unroll 8
    for (int i = 0; i < 32; ++i) { const int kk = 2 * i + (lane >> 5); scr[kk * 33 + (lane & 31)] = W[(size_t)(k0 + kk) * N + n0 + (lane & 31)]; }
    asm volatile("s_waitcnt lgkmcnt(0)" ::: "memory");
    const int c = lane & 7;
#pragma unroll
    for (int j = 0; j < 4; ++j) { const int n = (lane >> 3) + 8 * j; const LAS float* s = scr + (8 * c) * 33 + n;
        u32x4 o; o.x = pk2(s[0 * 33], s[1 * 33]); o.y = pk2(s[2 * 33], s[3 * 33]); o.z = pk2(s[4 * 33], s[5 * 33]); o.w = pk2(s[6 * 33], s[7 * 33]);
        *(u32x4*)(WT + (size_t)(n0 + n) * K + k0 + 8 * c) = o; }
    asm volatile("s_waitcnt lgkmcnt(0)" ::: "memory");
}

__device__ __forceinline__ void phase_setup(KArgs ap, unsigned char* ws, LAS unsigned char* lds, int tid, int lane, int wave, const int BX, const int G) {
    {
        LAS float* S = (LAS float*)lds;
        LAS float* part = (LAS float*)(lds + 17 * 1024 * 4);
        float* mod = (float*)(ws + WS_MOD);
        if (BX < 192) {
            for (int i = tid; i < 17 * 1024; i += 512) { const int r = i >> 10, k = i & 1023; const float v = r < 16 ? ap->in[1][r * 1024 + k] : ap->in[3][k]; S[i] = v / (1.f + expf(-v)); }
        }
        __syncthreads();
        for (int item = BX; item < 192; item += G) {
            const int l = item / 96, n0 = (item % 96) * 64;
            const float* W = ap->in[4] + (size_t)l * 1024 * 6144 + n0 + lane;
            float acc[17];
#pragma unroll
            for (int r = 0; r < 17; ++r) acc[r] = 0.f;
            for (int k = wave * 128; k < wave * 128 + 128; k += 4) {
                const float w0 = W[(size_t)k * 6144], w1 = W[(size_t)(k + 1) * 6144], w2 = W[(size_t)(k + 2) * 6144], w3 = W[(size_t)(k + 3) * 6144];
#pragma unroll
                for (int r = 0; r < 17; ++r) { const f32x4 s = *(const LAS f32x4*)(S + r * 1024 + k); acc[r] += s[0] * w0 + s[1] * w1 + s[2] * w2 + s[3] * w3; }
            }
#pragma unroll
            for (int r = 0; r < 17; ++r) part[(wave * 17 + r) * 64 + lane] = acc[r];
            __syncthreads();
            for (int i = tid; i < 17 * 64; i += 512) { const int r = i >> 6, j = i & 63; float s = ap->in[5][l * 6144 + n0 + j];
#pragma unroll
                for (int w = 0; w < 8; ++w) s += part[(w * 17 + r) * 64 + j];
                mod[(size_t)(l * 17 + r) * 6144 + n0 + j] = s; }
            __syncthreads();
        }
    }
    {
        LAS float* scr = (LAS float*)(lds + wave * 16384);
        const int gw = BX * 8 + wave, NGW = G * 8;
        constexpr int I_IN = 16 * 53, I_OUT = 16 * 32, I_1 = 16 * 128, I_2 = 64 * 32, I_L = I_IN + I_OUT + I_1 + I_2;
        for (int it = gw; it < 2 * I_L; it += NGW) {
            const int l = it / I_L; int r = it % I_L; unsigned char* wl = ws + l * WL;
            if (r < I_IN) { transpose_item(ap->in[8] + (size_t)l * 1024 * 1696, 1024, 1696, (bf16_t*)(wl + O_WIN), scr, r, lane); continue; } r -= I_IN;
            if (r < I_OUT) { transpose_item(ap->in[17] + (size_t)l * 1024 * 1024, 1024, 1024, (bf16_t*)(wl + O_WOUT), scr, r, lane); continue; } r -= I_OUT;
            if (r < I_1) { transpose_item(ap->in[18] + (size_t)l * 1024 * 4096, 1024, 4096, (bf16_t*)(wl + O_W1), scr, r, lane); continue; } r -= I_1;
            transpose_item(ap->in[19] + (size_t)l * 4096 * 1024, 4096, 1024, (bf16_t*)(wl + O_W2), scr, r, lane);
        }
    }
    {
        const int gt = BX * 512 + tid, NGT = G * 512;
        for (int l = 0; l < 2; ++l) {
            unsigned char* wl = ws + l * WL;
            { unsigned* z = (unsigned*)((bf16_t*)(wl + O_WIN) + (size_t)1696 * 1024); for (int i = gt; i < 96 * 1024 / 2; i += NGT) z[i] = 0u; }
            { bf16_t* o = (bf16_t*)(wl + O_WUQ); const float* w = ap->in[14] + (size_t)l * 256 * 384; const float* gq = ap->in[13] + l * 256;
              for (int i = gt; i < 512 * 256; i += NGT) { const int n = i >> 8, k = i & 255; o[i] = (bf16_t)(n < 384 ? f2bf(gq[k] * w[k * 384 + n]) : 0u); } }
            { bf16_t* ok = (bf16_t*)(wl + O_WK); bf16_t* ov = (bf16_t*)(wl + O_WV); const float* w = ap->in[16] + (size_t)l * 128 * 512; const float* gk = ap->in[15] + l * 128;
              for (int i = gt; i < 256 * 128; i += NGT) { const int n = i >> 7, k = i & 127, h = n >> 6, d = n & 63; const float gg = gk[k];
                  ok[i] = (bf16_t)f2bf(gg * w[k * 512 + h * 128 + d]); ov[i] = (bf16_t)f2bf(gg * w[k * 512 + h * 128 + 64 + d]); } }
            { bf16_t* o = (bf16_t*)(wl + O_WF); const float* fw = ap->in[9] + (size_t)l * 256 * 256;
              for (int i = gt; i < 512 * 256; i += NGT) { const int r = i >> 8, kin = i & 255, part = r >> 8, n = r & 255, h = kin >> 6, c = kin & 63; float s = 0.f;
                  for (int k2 = 0; k2 < 64; ++k2) { const float ang = (float)((c * k2) & 63) * (1.f / 32.f); const float tr = part ? sinpif(ang) : cospif(ang); s += tr * fw[(h * 64 + k2) * 256 + n]; }
                  o[i] = (bf16_t)f2bf(s); } }
            { bf16_t* o = (bf16_t*)(wl + O_POOL); const float* pw = ap->in[11] + (size_t)l * 4 * 64 * 64;
              for (int i = gt; i < 256 * 256; i += NGT) { const int r = i >> 8, k = i & 255, g = r >> 6, n = r & 63; o[i] = (bf16_t)((k >> 6) == g ? f2bf(pw[(g * 64 + (k & 63)) * 64 + n]) : 0u); } }
        }
        { float* tab = (float*)(ws + WS_ROPE); for (int i = gt; i < 512; i += NGT) { float sn, cs; sincosf((float)(i >> 3) * invfreq(i & 7), &sn, &cs); tab[2 * i] = cs; tab[2 * i + 1] = sn; } }
        { u32x4* z = (u32x4*)(ws + WS_RSS); for (int i = gt; i < (int)(3 * RSS_STRIDE / 16); i += NGT) z[i] = (u32x4){0u, 0u, 0u, 0u}; }
        { u32x4* o = (u32x4*)(ws + WS_DFT);
          for (int i = gt; i < 2 * 2048 * 512; i += NGT) { const int part = i >> 20, ii = i & ((1 << 20) - 1), row = ii >> 9, t0 = (ii & 511) * 8; float v[8];
#pragma unroll
              for (int e = 0; e < 8; ++e) { const float ang = (float)(((row + 1) * (t0 + e)) & 4095) * (1.f / 2048.f); v[e] = part ? sinpif(ang) : cospif(ang); }
              u32x4 w; w.x = pk2(v[0], v[1]); w.y = pk2(v[2], v[3]); w.z = pk2(v[4], v[5]); w.w = pk2(v[6], v[7]); o[i] = w; } }
        { u32x4* o = (u32x4*)(ws + WS_DFTC);
          for (int i = gt; i < 256 * 64; i += NGT) { const int row = i >> 6, j0 = (i & 63) * 8; float v[8];
#pragma unroll
              for (int e = 0; e < 8; ++e) { const int j = j0 + e, t = j & 255; const float ang = (float)((row * t) & 255) * (1.f / 128.f); v[e] = (j >> 8) ? -sinpif(ang) : cospif(ang); }
              u32x4 w; w.x = pk2(v[0], v[1]); w.y = pk2(v[2], v[3]); w.z = pk2(v[4], v[5]); w.w = pk2(v[6], v[7]); o[i] = w; } }
    }
}

__device__ __forceinline__ void phase_vectors(KArgs ap, unsigned char* ws, LAS unsigned char* lds, int tid, int lane, int wave, const int BX, const int G) {
    const float* mod = (const float*)(ws + WS_MOD);
    float* vec = (float*)(ws + WS_VEC);
    { const int gt = BX * 512 + tid, NGT = G * 512;
      for (int i = gt; i < 2 * 17 * 1024; i += NGT) { const int l = i / (17 * 1024), r = (i >> 10) % 17, k = i & 1023; vec[V_GN2 + i] = ap->in[7][l * 1024 + k] * (1.0f + mod[(size_t)(l * 17 + r) * 6144 + 4096 + k]); }
      for (int i = gt; i < 17 * 1024; i += NGT) { const int r = i >> 10, k = i & 1023; vec[V_GN1 + i] = ap->in[6][1024 + k] * (1.0f + mod[(size_t)(17 + r) * 6144 + 1024 + k]); } }
    LAS float* S = (LAS float*)lds;
    LAS float* part = (LAS float*)(lds + 17 * 1024 * 4);
    for (int item = BX; item < 156; item += G) {
        const bool up = item < 128;
        const int l = up ? item / 64 : 1, n0 = up ? (item % 64) * 64 : (item - 128) * 64, N = up ? 4096 : 1696, soff = up ? 3072 : 0;
        const float* Wb = up ? ap->in[18] + (size_t)l * 1024 * 4096 : ap->in[8] + (size_t)1024 * 1696;
        __syncthreads();
        for (int i = tid; i < 17 * 1024; i += 512) { const int r = i >> 10, k = i & 1023; S[i] = mod[(size_t)(l * 17 + r) * 6144 + soff + k]; }
        __syncthreads();
        const bool cv = n0 + lane < N;
        const float* W = Wb + n0 + (cv ? lane : 0);
        float acc[17];
#pragma unroll
        for (int r = 0; r < 17; ++r) acc[r] = 0.f;
        for (int k = wave * 128; k < wave * 128 + 128; k += 4) {
            const float w0 = W[(size_t)k * N], w1 = W[(size_t)(k + 1) * N], w2 = W[(size_t)(k + 2) * N], w3 = W[(size_t)(k + 3) * N];
#pragma unroll
            for (int r = 0; r < 17; ++r) { const f32x4 sv = *(const LAS f32x4*)(S + r * 1024 + k); acc[r] += sv[0] * w0 + sv[1] * w1 + sv[2] * w2 + sv[3] * w3; }
        }
#pragma unroll
        for (int r = 0; r < 17; ++r) part[(wave * 17 + r) * 64 + lane] = cv ? acc[r] : 0.f;
        __syncthreads();
        for (int i = tid; i < 17 * 64; i += 512) { const int r = i >> 6, j = i & 63; float sum = 0.f;
#pragma unroll
            for (int w = 0; w < 8; ++w) sum += part[(w * 17 + r) * 64 + j];
            if (up) vec[V_CB2 + (size_t)(l * 17 + r) * 4096 + n0 + j] = sum; else vec[V_CB1 + (size_t)r * 1792 + n0 + j] = sum; }
    }
    __syncthreads();
}
constexpr int RPI = 8;
__device__ __forceinline__ void phase_norm_mod(const float* xl, const float* xc, const float* g, const float* mod, int shoff, int scoff, bf16_t* H, int nrows, int lane, int wave, const int BX, const int G) {
    const int gw = BX * 8 + wave, NGW = G * 8;
    for (int row0 = gw; row0 < nrows; row0 += NGW * RPI) {
        f32x4 v[RPI][4]; float ss[RPI];
#pragma unroll
        for (int i = 0; i < RPI; ++i) { const int row = row0 + i * NGW; ss[i] = 0.f;
            if (row < nrows) { const float* src = row < ML ? xl + (size_t)row * DM : xc + (size_t)(row - ML) * DM;
#pragma unroll
                for (int j = 0; j < 4; ++j) v[i][j] = *(const f32x4*)(src + lane * 4 + 256 * j); }
            else {
#pragma unroll
                for (int j = 0; j < 4; ++j) v[i][j] = (f32x4){0.f, 0.f, 0.f, 0.f}; } }
#pragma unroll
        for (int i = 0; i < RPI; ++i) {
#pragma unroll
            for (int j = 0; j < 4; ++j) ss[i] += (v[i][j][0] * v[i][j][0] + v[i][j][1] * v[i][j][1]) + (v[i][j][2] * v[i][j][2] + v[i][j][3] * v[i][j][3]); }
#pragma unroll
        for (int o = 1; o < 64; o <<= 1) {
#pragma unroll
            for (int i = 0; i < RPI; ++i) ss[i] += shx(ss[i], o, lane); }
#pragma unroll
        for (int i = 0; i < RPI; ++i) { const int row = row0 + i * NGW;
            if (row < nrows) {
                const float rr = 1.0f / sqrtf(ss[i] * (1.f / DM) + EPS);
                const float* mv = mod + (size_t)(row < ML ? (row >> 12) : 16) * 6144;
#pragma unroll
                for (int j = 0; j < 4; ++j) { const int col = lane * 4 + 256 * j;
                    const f32x4 gg = *(const f32x4*)(g + col), sc = *(const f32x4*)(mv + scoff + col), sh = *(const f32x4*)(mv + shoff + col);
                    const f32x4 o = (v[i][j] * rr * gg) * (sc + 1.0f) + sh;
                    u32x2 w; w.x = cvt_pk_bf16(o[0], o[1]); w.y = cvt_pk_bf16(o[2], o[3]);
                    *(u32x2*)(H + (size_t)row * DM + col) = w; } } }
    }
}
__device__ __forceinline__ void phase_final_norm(float* x, const float* g, int lane, int wave, const int BX, const int G) {
    const int gw = BX * 8 + wave, NGW = G * 8;
    for (int row0 = gw; row0 < ML; row0 += NGW * RPI) {
        f32x4 v[RPI][4]; float ss[RPI];
#pragma unroll
        for (int i = 0; i < RPI; ++i) { const int row = row0 + i * NGW; ss[i] = 0.f;
#pragma unroll
            for (int j = 0; j < 4; ++j) v[i][j] = *(const f32x4*)(x + (size_t)row * DM + lane * 4 + 256 * j); }
#pragma unroll
        for (int i = 0; i < RPI; ++i) {
#pragma unroll
            for (int j = 0; j < 4; ++j) ss[i] += (v[i][j][0] * v[i][j][0] + v[i][j][1] * v[i][j][1]) + (v[i][j][2] * v[i][j][2] + v[i][j][3] * v[i][j][3]); }
#pragma unroll
        for (int o = 1; o < 64; o <<= 1) {
#pragma unroll
            for (int i = 0; i < RPI; ++i) ss[i] += shx(ss[i], o, lane); }
#pragma unroll
        for (int i = 0; i < RPI; ++i) { const int row = row0 + i * NGW;
            const float rr = 1.0f / sqrtf(ss[i] * (1.f / DM) + EPS);
#pragma unroll
            for (int j = 0; j < 4; ++j) { const int col = lane * 4 + 256 * j; const f32x4 gg = *(const f32x4*)(g + col); *(f32x4*)(x + (size_t)row * DM + col) = v[i][j] * rr * gg; } }
    }
}

__device__ __forceinline__ void phase_token_local(const bf16_t* P, float* rq, float* rkv, bf16_t* Kc, bf16_t* MIX, bf16_t* POOLIN, const float* conv_w, const float* ropetab, int tid, int lane, int wave, const int BX, const int G) {
    const int gw = BX * 8 + wave, NGW = G * 8;
    for (int row0 = gw; row0 < MT; row0 += NGW * RPI) {
        u32x2 cq[RPI]; unsigned ck[RPI]; float sq[RPI], sk[RPI];
#pragma unroll
        for (int i = 0; i < RPI; ++i) { const int row = min(row0 + i * NGW, MT - 1); const GAS bf16_t* pr = (const GAS bf16_t*)P + (size_t)row * LDP;
            cq[i] = *(const GAS u32x2*)(pr + 1280 + lane * 4); ck[i] = *(const GAS unsigned*)(pr + 1536 + lane * 2); }
#pragma unroll
        for (int i = 0; i < RPI; ++i) { const float a0 = bflo(cq[i].x), a1 = bfhi(cq[i].x), a2 = bflo(cq[i].y), a3 = bfhi(cq[i].y), k0 = bflo(ck[i]), k1 = bfhi(ck[i]);
            sq[i] = (a0 * a0 + a1 * a1) + (a2 * a2 + a3 * a3); sk[i] = k0 * k0 + k1 * k1; }
#pragma unroll
        for (int o = 1; o < 64; o <<= 1) {
#pragma unroll
            for (int i = 0; i < RPI; ++i) { sq[i] += shx(sq[i], o, lane); sk[i] += shx(sk[i], o, lane); } }
#pragma unroll
        for (int i = 0; i < RPI; ++i) { const int row = row0 + i * NGW;
            if (row < MT && lane == 0) { ((GAS float*)rq)[row] = 1.0f / sqrtf(sq[i] * (1.f / 256.f) + EPS); ((GAS float*)rkv)[row] = 1.0f / sqrtf(sk[i] * (1.f / 128.f) + EPS); } }
    }
    {
        const int gt0 = BX * 512 + tid, NGT0 = G * 512;
        for (int e = gt0; e < MT * 4; e += NGT0) {
            const int row = e >> 2, L = e & 3;
            const bool lat = row < ML; int b, t, key;
            if (lat) { b = row >> 12; t = row & 4095; key = CTX + t; } else { const int rr = row - ML; b = rr >> 8; t = rr & 255; key = t; }
            const GAS bf16_t* pr = (const GAS bf16_t*)P + (size_t)row * LDP + 1664;
            const u32x4 own = *(const GAS u32x4*)(pr + 8 * L), par = *(const GAS u32x4*)(pr + 8 * (L ^ 1));
            u32x4 outw = own;
            if (lat) {
                const int ipos = (L & 2) ? (t & 63) : (t >> 6);
                const GAS f32x4* tb = (const GAS f32x4*)(ropetab + ipos * 16);
                const f32x4 t0 = tb[0], t1 = tb[1], t2 = tb[2], t3 = tb[3];
                const float sg = (L & 1) ? 1.0f : -1.0f;
                float xo[8] = {bflo(own.x), bfhi(own.x), bflo(own.y), bfhi(own.y), bflo(own.z), bfhi(own.z), bflo(own.w), bfhi(own.w)};
                float xp[8] = {bflo(par.x), bfhi(par.x), bflo(par.y), bfhi(par.y), bflo(par.z), bfhi(par.z), bflo(par.w), bfhi(par.w)};
                float cs[8] = {t0[0], t0[2], t1[0], t1[2], t2[0], t2[2], t3[0], t3[2]}, sn[8] = {t0[1], t0[3], t1[1], t1[3], t2[1], t2[3], t3[1], t3[3]};
                float o[8];
#pragma unroll
                for (int j = 0; j < 8; ++j) o[j] = xo[j] * cs[j] + sg * xp[j] * sn[j];
                outw.x = pk2(o[0], o[1]); outw.y = pk2(o[2], o[3]); outw.z = pk2(o[4], o[5]); outw.w = pk2(o[6], o[7]);
            }
#pragma unroll
            for (int h = 0; h < 4; ++h) *(GAS u32x4*)((GAS bf16_t*)Kc + (size_t)((b * 4 + h) * NKEY + key) * QKD + 64 + 8 * L) = outw;
        }
    }
    const int rpb = (MT + G - 1) / G;
    const int rbeg = BX * rpb, rend = min(rbeg + rpb, MT);
    const int c16 = tid & 63, ch = c16 * 4;
    const f32x4 cw0 = *(const f32x4*)(conv_w + ch), cw1 = *(const f32x4*)(conv_w + 256 + ch), cw2 = *(const f32x4*)(conv_w + 512 + ch);
    const int hw = 1 << (c16 >> 4);
    for (int row = rbeg + (tid >> 6); row < rend; row += 8) {
        int t, n; if (row < ML) { t = row & 4095; n = SEQ; } else { t = (row - ML) & 255; n = CTX; }
        const bf16_t* pr = P + (size_t)row * LDP;
        const u32x2 bg = *(const u32x2*)(pr + 256 + ch), cg = *(const u32x2*)(pr + 512 + ch), xi = *(const u32x2*)(pr + 768 + ch);
        const bool hp = t > 0, hn = t < n - 1;
        const bf16_t* pp = hp ? pr - LDP : pr; const bf16_t* pn = hn ? pr + LDP : pr;
        const u32x2 c0 = *(const u32x2*)(pp + 512 + ch), x0 = *(const u32x2*)(pp + 768 + ch), c2 = *(const u32x2*)(pn + 512 + ch), x2 = *(const u32x2*)(pn + 768 + ch);
        const bf16_t* pq = pr + 1024 + ch;
        u32x2 tap[16];
#pragma unroll
        for (int k = 0; k < 16; ++k) { const int d = k - 8; const bool ok = (d >= -hw) && (d < hw) && (t + d >= 0) && (t + d < n);
            tap[k] = *(const u32x2*)(pq + (ptrdiff_t)(ok ? d : 0) * LDP); if (!ok) tap[k] = (u32x2){0u, 0u}; }
        const u32x2 u0 = *(const u32x2*)pq;
        {
            const f32x4 z = (f32x4){bflo(cg.x) * bflo(xi.x), bfhi(cg.x) * bfhi(xi.x), bflo(cg.y) * bflo(xi.y), bfhi(cg.y) * bfhi(xi.y)};
            const f32x4 zp = (f32x4){bflo(c0.x) * bflo(x0.x), bfhi(c0.x) * bfhi(x0.x), bflo(c0.y) * bflo(x0.y), bfhi(c0.y) * bfhi(x0.y)};
            const f32x4 zn = (f32x4){bflo(c2.x) * bflo(x2.x), bfhi(c2.x) * bfhi(x2.x), bflo(c2.y) * bflo(x2.y), bfhi(c2.y) * bfhi(x2.y)};
            const f32x4 y = z * cw1 + zp * (hp ? cw0 : cw0 * 0.f) + zn * (hn ? cw2 : cw2 * 0.f);
            u32x2 w; w.x = cvt_pk_bf16(bflo(bg.x) * y[0], bfhi(bg.x) * y[1]); w.y = cvt_pk_bf16(bflo(bg.y) * y[2], bfhi(bg.y) * y[3]);
            *(u32x2*)(MIX + (size_t)row * DM + 256 + ch) = w;
        }
        {
            f32x4 sacc = (f32x4){0.f, 0.f, 0.f, 0.f};
#pragma unroll
            for (int k = 0; k < 16; ++k) sacc += (f32x4){bflo(tap[k].x), bfhi(tap[k].x), bflo(tap[k].y), bfhi(tap[k].y)};
            const int lo = max(t - hw, 0), hi = min(t + hw - 1, n - 1);
            const float ic = 1.0f / (float)(hi - lo + 1);
            u32x2 w; w.x = cvt_pk_bf16(sacc[0] * ic - bflo(u0.x), sacc[1] * ic - bfhi(u0.x)); w.y = cvt_pk_bf16(sacc[2] * ic - bflo(u0.y), sacc[3] * ic - bfhi(u0.y));
            *(u32x2*)(POOLIN + (size_t)row * 256 + ch) = w;
        }
    }
}

__device__ __forceinline__ void phase_dft_combine(unsigned char* ws, int tid, int lane, int wave, const int BX, const int G) {
    const GAS float* PT = (const GAS float*)(ws + WS_PT); const GAS float* QT = (const GAS float*)(ws + WS_QT);
    GAS bf16_t* MIX = (GAS bf16_t*)(ws + WS_MIX);
    const int gt = BX * 512 + tid, NGT = G * 512;
    for (int i = gt; i < 2048 * 512; i += NGT) {
        const int r = i >> 9, col = (i & 511) * 8, b = col >> 8, n = col & 255, k1 = r + 1;
        const f32x4 p0 = *(const GAS f32x4*)(PT + (size_t)r * 4096 + col), p1 = *(const GAS f32x4*)(PT + (size_t)r * 4096 + col + 4);
        const f32x4 q0 = *(const GAS f32x4*)(QT + (size_t)r * 4096 + col), q1 = *(const GAS f32x4*)(QT + (size_t)r * 4096 + col + 4);
        const float sc = 1.f / 512.f;
        *(gv4p)(MIX + (size_t)(b * SEQ + k1) * DM + n) = pack8((p0 - q0) * sc, (p1 - q1) * sc);
        *(gv4p)(MIX + (size_t)(b * SEQ + 4096 - k1) * DM + n) = pack8((p0 + q0) * sc, (p1 + q1) * sc);
    }
    const GAS bf16_t* UT = (const GAS bf16_t*)(ws + WS_UT);
    const int gw = BX * 8 + wave, NGW = G * 8;
    for (int rowi = gw; rowi < 4096; rowi += NGW) {
        const GAS u32x4* src = (const GAS u32x4*)(UT + (size_t)rowi * 8192) + lane;
        float sacc = 0.f;
#pragma unroll
        for (int c = 0; c < 8; ++c) { const u32x4 w = src[c * 64]; sacc += (bflo(w.x) + bfhi(w.x)) + (bflo(w.y) + bfhi(w.y)) + (bflo(w.z) + bfhi(w.z)) + (bflo(w.w) + bfhi(w.w)); }
        sacc = wave_sum(sacc, lane);
        if (lane == 0) { const int b = rowi >> 8, n = rowi & 255; MIX[(size_t)(b * SEQ) * DM + n] = (bf16_t)f2bf(sacc * (1.f / 512.f)); }
    }
}

constexpr int KROW = 208, VROW = 144, KBUF = 64 * KROW, VBUF = 64 * VROW, ABUF = KBUF + VBUF;
__device__ __forceinline__ void attn_unit(LAS unsigned char* lds, const bf16_t* Qb, const bf16_t* Kb, const bf16_t* Vtb, int nk, bf16_t* Ob, bool rope, int tok0, const int tid, const float* ropetab) {
    const int lane = tid & 63, r = lane & 31, hi = lane >> 5, wid = tid >> 6;
    bf16x8 qf[6];
    const bf16_t* qrow = Qb + (size_t)(wid * 32 + r) * 384 + 8 * hi;
#pragma unroll
    for (int d0 = 0; d0 < 6; ++d0) qf[d0] = *(const bf16x8*)(qrow + d0 * 16);
    if (rope) {
        const int t = tok0 + wid * 32 + r;
#pragma unroll
        for (int d0 = 4; d0 < 6; ++d0) {
            const int ipos = d0 == 4 ? (t >> 6) : (t & 63);
            bf16x8 o;
#pragma unroll
            for (int j = 0; j < 8; ++j) {
                const float own = bf1((bf16_t)qf[d0][j]);
                const float partner = shx(own, 32, lane);
                const f32x2 csn = *(const GAS f32x2*)(ropetab + (ipos * 8 + j) * 2); const float cs = csn[0], sn = csn[1];
                o[j] = (short)f2bf(own * cs + (hi ? partner : -partner) * sn);
            }
            qf[d0] = o;
        }
    }
    const int kc0 = tid, kc1 = tid + 512;
    const int kr0 = kc0 / 12, kcc0 = kc0 % 12, kr1 = kc1 / 12, kcc1 = kc1 % 12;
    const bool k1v = kc1 < 768;
    const int vr = tid >> 3, vcc = tid & 7;
    const bf16_t* kg0 = Kb + (size_t)kr0 * QKD + kcc0 * 8;
    const bf16_t* kg1 = Kb + (size_t)kr1 * QKD + kcc1 * 8;
    const bf16_t* vg = Vtb + (size_t)vr * NKEY + vcc * 8;
    const int kl0 = kr0 * KROW + kcc0 * 16, kl1 = kr1 * KROW + kcc1 * 16, vl = KBUF + vr * VROW + vcc * 16;
    const int NT = nk >> 6;
    u32x4 sk0, sk1 = (u32x4){0u, 0u, 0u, 0u}, sv;
    sk0 = *(const u32x4*)kg0; if (k1v) sk1 = *(const u32x4*)kg1; sv = *(const u32x4*)vg;
    *(LAS u32x4*)(lds + kl0) = sk0; if (k1v) *(LAS u32x4*)(lds + kl1) = sk1; *(LAS u32x4*)(lds + vl) = sv;
    __syncthreads();
    f32x16 ot0, ot1;
#pragma unroll
    for (int i = 0; i < 16; ++i) { ot0[i] = 0.f; ot1[i] = 0.f; }
    float m_run = -1e30f, l_run = 0.f;
    for (int tI = 0; tI < NT; ++tI) {
        LAS unsigned char* cur = lds + (tI & 1) * ABUF;
        LAS unsigned char* nxt = lds + ((tI + 1) & 1) * ABUF;
        const bool more = tI + 1 < NT;
        if (more) { const size_t ko = (size_t)(tI + 1) * 64 * QKD; sk0 = *(const u32x4*)(kg0 + ko); if (k1v) sk1 = *(const u32x4*)(kg1 + ko); sv = *(const u32x4*)(vg + (tI + 1) * 64); }
        f32x16 s0, s1;
#pragma unroll
        for (int i = 0; i < 16; ++i) { s0[i] = 0.f; s1[i] = 0.f; }
        __builtin_amdgcn_s_setprio(1);
#pragma unroll
        for (int d0 = 0; d0 < 6; ++d0) {
            const bf16x8 a0 = *(const LAS bf16x8*)(cur + r * KROW + d0 * 32 + hi * 16);
            const bf16x8 a1 = *(const LAS bf16x8*)(cur + (32 + r) * KROW + d0 * 32 + hi * 16);
            s0 = __builtin_amdgcn_mfma_f32_32x32x16_bf16(a0, qf[d0], s0, 0, 0, 0);
            s1 = __builtin_amdgcn_mfma_f32_32x32x16_bf16(a1, qf[d0], s1, 0, 0, 0);
        }
        __builtin_amdgcn_s_setprio(0);
        float mx = s0[0];
#pragma unroll
        for (int i = 1; i < 16; ++i) mx = fmaxf(mx, s0[i]);
#pragma unroll
        for (int i = 0; i < 16; ++i) mx = fmaxf(mx, s1[i]);
        mx = fmaxf(mx, shx(mx, 32, lane));
        const float m_new = fmaxf(m_run, mx);
        const float alpha = __builtin_amdgcn_exp2f(m_run - m_new);
        m_run = m_new;
        float ps = 0.f;
#pragma unroll
        for (int i = 0; i < 16; ++i) { s0[i] = __builtin_amdgcn_exp2f(s0[i] - m_new); s1[i] = __builtin_amdgcn_exp2f(s1[i] - m_new); ps += s0[i] + s1[i]; }
        l_run = l_run * alpha + ps;
#pragma unroll
        for (int i = 0; i < 16; ++i) { ot0[i] *= alpha; ot1[i] *= alpha; }
        bf16x8 pb[4];
#pragma unroll
        for (int s = 0; s < 4; ++s) {
            u32x4 w;
            if (s < 2) { w.x = cvt_pk_bf16(s0[8 * s + 0], s0[8 * s + 1]); w.y = cvt_pk_bf16(s0[8 * s + 2], s0[8 * s + 3]); w.z = cvt_pk_bf16(s0[8 * s + 4], s0[8 * s + 5]); w.w = cvt_pk_bf16(s0[8 * s + 6], s0[8 * s + 7]); }
            else { const int q = s - 2; w.x = cvt_pk_bf16(s1[8 * q + 0], s1[8 * q + 1]); w.y = cvt_pk_bf16(s1[8 * q + 2], s1[8 * q + 3]); w.z = cvt_pk_bf16(s1[8 * q + 4], s1[8 * q + 5]); w.w = cvt_pk_bf16(s1[8 * q + 6], s1[8 * q + 7]); }
            pb[s] = __builtin_bit_cast(bf16x8, w);
        }
#pragma unroll
        for (int s = 0; s < 4; ++s) {
            const int ko = (16 * s + 4 * hi) * 2;
            const s16x4 l0 = *(const LAS s16x4*)(cur + KBUF + r * VROW + ko), h0 = *(const LAS s16x4*)(cur + KBUF + r * VROW + ko + 16);
            const s16x4 l1 = *(const LAS s16x4*)(cur + KBUF + (32 + r) * VROW + ko), h1 = *(const LAS s16x4*)(cur + KBUF + (32 + r) * VROW + ko + 16);
            const bf16x8 a0 = __builtin_shufflevector(l0, h0, 0, 1, 2, 3, 4, 5, 6, 7), a1 = __builtin_shufflevector(l1, h1, 0, 1, 2, 3, 4, 5, 6, 7);
            __builtin_amdgcn_s_setprio(1);
            ot0 = __builtin_amdgcn_mfma_f32_32x32x16_bf16(a0, pb[s], ot0, 0, 0, 0);
            ot1 = __builtin_amdgcn_mfma_f32_32x32x16_bf16(a1, pb[s], ot1, 0, 0, 0);
            __builtin_amdgcn_s_setprio(0);
        }
        if (more) { *(LAS u32x4*)(nxt + kl0) = sk0; if (k1v) *(LAS u32x4*)(nxt + kl1) = sk1; *(LAS u32x4*)(nxt + vl) = sv; }
        __syncthreads();
    }
    const float lt = l_run + shx(l_run, 32, lane);
    const float il = 1.0f / lt;
    bf16_t* orow = Ob + (size_t)(wid * 32 + r) * DM;
#pragma unroll
    for (int g = 0; g < 4; ++g) {
        u32x2 w0, w1;
        w0.x = cvt_pk_bf16(ot0[4 * g] * il, ot0[4 * g + 1] * il); w0.y = cvt_pk_bf16(ot0[4 * g + 2] * il, ot0[4 * g + 3] * il);
        w1.x = cvt_pk_bf16(ot1[4 * g] * il, ot1[4 * g + 1] * il); w1.y = cvt_pk_bf16(ot1[4 * g + 2] * il, ot1[4 * g + 3] * il);
        *(u32x2*)(orow + 8 * g + 4 * hi) = w0;
        *(u32x2*)(orow + 32 + 8 * g + 4 * hi) = w1;
    }
}
__device__ __forceinline__ void phase_attention(LAS unsigned char* lds, unsigned char* ws, bool with_ctx, const int tid, const int bx, const int G) {
    const int vcu = (G % 8 == 0) ? (bx % 8) * (G / 8) + bx / 8 : bx;
    const bf16_t* Q = (const bf16_t*)(ws + WS_Q); const bf16_t* Qc = (const bf16_t*)(ws + WS_QC);
    const bf16_t* Kc = (const bf16_t*)(ws + WS_KC); const bf16_t* Vt = (const bf16_t*)(ws + WS_VT);
    bf16_t* MIX = (bf16_t*)(ws + WS_MIX);
    const int nunits = 1024 + (with_ctx ? 64 : 0);
    for (int u = vcu; u < nunits; u += G) {
        if (u < 1024) {
            const int bh = u >> 4, qb = u & 15, b = bh >> 2, h = bh & 3;
            attn_unit(lds, Q + (size_t)(b * SEQ + qb * 256) * 384 + h * QKD, Kc + (size_t)bh * NKEY * QKD, Vt + (size_t)bh * 64 * NKEY, NKEY,
                      MIX + (size_t)(b * SEQ + qb * 256) * DM + 768 + h * 64, true, qb * 256, tid, (const float*)(ws + WS_ROPE));
        } else {
            const int bh = u - 1024, b = bh >> 2, h = bh & 3;
            attn_unit(lds, Qc + (size_t)(b * CTX) * 384 + h * QKD, Kc + (size_t)bh * NKEY * QKD, Vt + (size_t)bh * 64 * NKEY, CTX,
                      MIX + (size_t)(ML + b * CTX) * DM + 768 + h * 64, false, 0, tid, (const float*)(ws + WS_ROPE));
        }
    }
}

struct Job { pg8::Gemm g; Epi e; };
__device__ __forceinline__ bool get_job(KArgs ap, unsigned char* ws, float* outp, int l, int kind, int j, Job& J) {
    unsigned char* wl = ws + (size_t)l * WL;
    const int Mx = l == 0 ? MT : ML;
    bf16_t* P = (bf16_t*)(ws + WS_P); bf16_t* MIX = (bf16_t*)(ws + WS_MIX); bf16_t* H = (bf16_t*)(ws + WS_H);
    const float* rq = (const float*)(ws + WS_RQ); const float* rkv = (const float*)(ws + WS_RKV);
    const float* mod = (const float*)(ws + WS_MOD) + (size_t)l * 17 * 6144;
    float* xc = (float*)(ws + WS_XC);
    J.e.e = EpiArgs{nullptr, nullptr, nullptr, nullptr, nullptr, nullptr, 0, 0};
    if (kind == 0) { if (j) return false;
        J.g = pg8::Gemm{H, (const bf16_t*)(wl + O_WIN), MT, LDP, DM, DM, DM}; J.e.mode = l == 0 ? M_P : M_PS; J.e.e.o0 = P; J.e.e.ld = LDP;
        J.e.e.f0 = (const float*)(ws + WS_RSS + 2 * RSS_STRIDE); J.e.e.f1 = (const float*)(ws + WS_VEC) + V_CB1; J.e.e.goff = LDP; return true; }
    if (kind == 1) { if (j) return false;
        J.g = pg8::Gemm{(const bf16_t*)(wl + O_WF), P, 512, Mx, 256, 256, LDP}; J.e.mode = M_UT; J.e.e.o0 = (bf16_t*)(ws + WS_UT); J.e.e.o1 = (bf16_t*)(ws + WS_UTC); return true; }
    if (kind == 2) {
        switch (j) {
            case 0: J.g = pg8::Gemm{(const bf16_t*)(ws + WS_DFT), (const bf16_t*)(ws + WS_UT), 2048, 4096, 4096, 4096, 8192}; J.e.mode = M_F32; J.e.e.o0 = (bf16_t*)(ws + WS_PT); return true;
            case 6: J.g = pg8::Gemm{(const bf16_t*)(ws + WS_DFT) + (size_t)2048 * 4096, (const bf16_t*)(ws + WS_UT) + 4096, 2048, 4096, 4096, 4096, 8192}; J.e.mode = M_F32; J.e.e.o0 = (bf16_t*)(ws + WS_QT); return true;
            case 1: J.g = pg8::Gemm{P + 1280, (const bf16_t*)(wl + O_WUQ), Mx, 512, 256, LDP, 256}; J.e.mode = M_Q; J.e.e.o0 = (bf16_t*)(ws + WS_Q); J.e.e.o1 = (bf16_t*)(ws + WS_QC); J.e.e.f0 = rq; return true;
            case 2: J.g = pg8::Gemm{P + 1536, (const bf16_t*)(wl + O_WK), MT, 256, 128, LDP, 128}; J.e.mode = M_K; J.e.e.o0 = (bf16_t*)(ws + WS_KC); J.e.e.f0 = rkv; return true;
            case 3: J.g = pg8::Gemm{(const bf16_t*)(wl + O_WV), P + 1536, 256, MT, 128, 128, LDP}; J.e.mode = M_VT; J.e.e.o0 = (bf16_t*)(ws + WS_VT); J.e.e.f0 = rkv; return true;
            case 4: J.g = pg8::Gemm{(const bf16_t*)(ws + WS_POOLIN), (const bf16_t*)(wl + O_POOL), Mx, 256, 256, 256, 256}; J.e.mode = M_POOL; J.e.e.o0 = MIX; J.e.e.f0 = ap->in[12] + l * 256; return true;
            case 5: if (l != 0) return false;
                J.g = pg8::Gemm{(const bf16_t*)(ws + WS_DFTC), (const bf16_t*)(ws + WS_UTC), 256, 4096, 512, 512, 512}; J.e.mode = M_DFTC; J.e.e.o0 = MIX; return true;
            default: return false;
        }
    }
    if (kind == 4 || kind == 7) { if (j) return false;
        if (kind == 4) J.g = pg8::Gemm{MIX, (const bf16_t*)(wl + O_WOUT), Mx, DM, DM, DM, DM};
        else J.g = pg8::Gemm{(const bf16_t*)(ws + WS_ACT), (const bf16_t*)(wl + O_W2), Mx, DM, DFF, DFF, DFF};
        J.e.mode = M_RES; J.e.e.o1 = (bf16_t*)mod; J.e.e.goff = kind == 4 ? 2048 : 5120;
        J.e.e.f0 = (l == 0 && kind == 4) ? ap->in[0] : outp; J.e.e.f1 = (l == 0 && kind == 4) ? ap->in[2] : xc; J.e.e.x0 = outp; J.e.e.x1 = xc;
        J.e.e.ld = kind == 4 ? 1 + l : (l == 0 ? 3 : 0); return true; }
    if (kind == 6) { if (j) return false;
        J.g = pg8::Gemm{H, (const bf16_t*)(wl + O_W1), Mx, DFF, DM, DM, DM}; J.e.mode = M_RELU2; J.e.e.o0 = (bf16_t*)(ws + WS_ACT); J.e.e.ld = DFF;
        J.e.e.f0 = (const float*)(ws + WS_RSS + (size_t)l * RSS_STRIDE); J.e.e.f1 = (const float*)(ws + WS_VEC) + V_CB2 + l * 17 * 4096; J.e.e.goff = DFF; return true; }
    return false;
}

#define XB_TMO      128
#define XB_XCNT(j)  (256  + 64 * (j))
#define XB_XSUB(j)  (1280 + 64 * (j))
#define XB_XGEN(j)  (2304 + 64 * (j))
#define XB_TOP      3328
#define XB_TOPGEN   3392
#define XCD_BAR_WORDS 3456
#define XB_SPIN_CAP (1u << 18)
__device__ __forceinline__ unsigned xb_ld(unsigned* p)              { return __hip_atomic_load(p, __ATOMIC_RELAXED, __HIP_MEMORY_SCOPE_AGENT); }
__device__ __forceinline__ unsigned xb_add(unsigned* p, unsigned v) { return __hip_atomic_fetch_add(p, v, __ATOMIC_RELAXED, __HIP_MEMORY_SCOPE_AGENT); }
__device__ __forceinline__ unsigned xb_xcc_id() { return (unsigned)__builtin_amdgcn_s_getreg((3 << 11) | 20) & 0xFu; }
#define XB_SPIN(cond, bar) do { unsigned _sp = 0; while (cond) { __builtin_amdgcn_s_sleep(1); \
    if ((++_sp & 255u) == 0u) { if (xb_ld(&(bar)[XB_TMO])) break; if (_sp > XB_SPIN_CAP) { atomicAdd(&(bar)[XB_TMO], 1u); break; } } } } while (0)
struct XcdBarrier { unsigned* bar; unsigned x; volatile LAS unsigned* st; };
__device__ __forceinline__ XcdBarrier xcd_barrier_post(unsigned* bar, volatile LAS unsigned* st) {
    XcdBarrier b; b.bar = bar; b.x = xb_xcc_id(); b.st = st;
    if (threadIdx.x == 0) (void)xb_add(&bar[XB_XCNT(b.x)], 1u);
    return b;
}
__device__ __forceinline__ void xcd_barrier_complete(unsigned* bar, unsigned x, unsigned& nloc, unsigned& nx) {
    const unsigned G = gridDim.x * gridDim.y * gridDim.z;
    unsigned sum, cnt, mine, sp = 0u;
    for (;;) {
        sum = 0u; cnt = 0u; mine = 0u;
#pragma unroll
        for (unsigned j = 0; j < 16; ++j) { const unsigned c = xb_ld(&bar[XB_XCNT(j)]); sum += c; cnt += (c > 0u) ? 1u : 0u; mine = (j == x) ? c : mine; }
        if (sum == G) break;
        __builtin_amdgcn_s_sleep(1);
        if ((++sp & 255u) == 0u) { if (xb_ld(&bar[XB_TMO])) break; if (sp > XB_SPIN_CAP) { atomicAdd(&bar[XB_TMO], 1u); break; } }
    }
    nloc = mine > 0u ? mine : 1u; nx = cnt > 0u ? cnt : 1u;
}
__device__ __forceinline__ void xcd_barrier(const XcdBarrier& b) {
    asm volatile("s_waitcnt vmcnt(0)" ::: "memory");
    __syncthreads();
    if (threadIdx.x == 0) {
        unsigned* bar = b.bar;
        __builtin_amdgcn_s_waitcnt(0);
        unsigned nloc = b.st[0], nx = b.st[1];
        if (nloc == 0u) { xcd_barrier_complete(bar, b.x, nloc, nx); b.st[0] = nloc; b.st[1] = nx; }
        const unsigned old = xb_add(&bar[XB_XSUB(b.x)], 1u);
        const unsigned gen = old / nloc;
        if (old + 1u == (gen + 1u) * nloc) {
            __builtin_amdgcn_fence(__ATOMIC_RELEASE, "agent");
            asm volatile("s_waitcnt vmcnt(0)" ::: "memory");
            const unsigned og = xb_add(&bar[XB_TOP], 1u);
            const unsigned tg = og / nx;
            if (og + 1u == (tg + 1u) * nx) xb_add(&bar[XB_TOPGEN], 1u);
            else XB_SPIN(xb_ld(&bar[XB_TOPGEN]) == tg, bar);
            __builtin_amdgcn_fence(__ATOMIC_ACQUIRE, "agent");
            xb_add(&bar[XB_XGEN(b.x)], 1u);
            asm volatile("s_waitcnt vmcnt(0)" ::: "memory");
        } else {
            XB_SPIN(xb_ld(&bar[XB_XGEN(b.x)]) == gen, bar);
            __builtin_amdgcn_fence(__ATOMIC_ACQUIRE, "agent");
            asm volatile("s_waitcnt vmcnt(0)" ::: "memory");
        }
    }
    __syncthreads();
}

constexpr int LDS_BYTES = 147456;
constexpr int N_PHASES = 2 + 9 * 2;
template <int PH> __device__ __forceinline__ void run_phase(LAS unsigned char* lds) {
    int tid = threadIdx.x; asm volatile("" : "+v"(tid));
    int BX = blockIdx.x, G = gridDim.x; asm volatile("" : "+s"(BX), "+s"(G));
    const int lane = tid & 63, wave = __builtin_amdgcn_readfirstlane(tid >> 6);
    KArgs ap = (KArgs)__builtin_amdgcn_kernarg_segment_ptr(); asm volatile("" : "+s"(ap));
    unsigned char* ws = ap->ws; float* outp = ap->out;
    if constexpr (PH == 0) {
        phase_setup(ap, ws, lds, tid, lane, wave, BX, G);
    } else if constexpr (PH == 1) {
        phase_vectors(ap, ws, lds, tid, lane, wave, BX, G);
        phase_norm_mod(ap->in[0], ap->in[2], ap->in[6], (const float*)(ws + WS_MOD), 0, 1024, (bf16_t*)(ws + WS_H), MT, lane, wave, BX, G);
    } else {
        constexpr int l = (PH - 2) / 9, kind = (PH - 2) % 9;
        const float* mod = (const float*)(ws + WS_MOD) + (size_t)l * 17 * 6144;
        if constexpr (kind == 1) phase_token_local((const bf16_t*)(ws + WS_P), (float*)(ws + WS_RQ), (float*)(ws + WS_RKV), (bf16_t*)(ws + WS_KC), (bf16_t*)(ws + WS_MIX), (bf16_t*)(ws + WS_POOLIN), ap->in[10] + l * 768, (const float*)(ws + WS_ROPE), tid, lane, wave, BX, G);
        if constexpr (kind == 3) { phase_dft_combine(ws, tid, lane, wave, BX, G); phase_attention(lds, ws, l == 0, tid, BX, G); }
        else if constexpr (kind == 5) { }
        else if constexpr (kind == 8) {
            if constexpr (l == 0) { }
            else phase_final_norm(outp, ap->in[20], lane, wave, BX, G);
        } else {
            Job J; int lr = l, kr = kind; asm volatile("" : "+s"(lr), "+s"(kr));
            for (int j = 0;; ++j) {
                KArgs ap2 = ap; unsigned char* ws2 = ws; float* out2 = outp; int tid2 = tid, BX2 = BX, G2 = G;
                asm volatile("" : "+s"(ap2), "+s"(ws2), "+s"(out2), "+v"(tid2), "+s"(BX2), "+s"(G2));
                if (kr == 2 && j > 6) break;
                const int jj = kr == 2 ? (j == 0 ? 0 : j == 1 ? 6 : j - 1) : j;
                if (!get_job(ap2, ws2, out2, lr, kr, jj, J)) break;
                const int rot = kr == 2 ? (jj == 6 ? 128 : jj == 2 ? 32 : jj == 3 ? 48 : jj == 4 ? 64 : jj == 5 ? 80 : 0) : 0;
                pg8::StaticOrder S; S.init(J.g.M, J.g.N, G2, (BX2 + rot) % G2);
                pg8::gemm_phase<Epi>(lds, J.g, S, J.e, tid2);
            }
        }
    }
}
__global__ void __launch_bounds__(512, 2) fwd_megakernel(Args a) {
    extern __shared__ __attribute__((aligned(16))) unsigned char lds_raw[];
    LAS unsigned char* lds = (LAS unsigned char*)lds_raw;
    cg::grid_group grid = cg::this_grid();
    const int ph_lo = a.ph_lo, ph_hi = a.ph_hi;
    for (int u = threadIdx.x; u < (LDS_BYTES - 131072) / 4; u += 512) ((LAS unsigned*)(lds + 131072))[u] = 0u;
    __syncthreads();
    const XcdBarrier bar = xcd_barrier_post((unsigned*)(a.ws + WS_CTL), (volatile LAS unsigned*)(lds + 131072 + 64));
#ifndef EXP_SYNC
#define EXP_SYNC 0
#endif
#ifndef EXP_REP
#define EXP_REP(k) 0
#endif
#define PH_EMPTY(k) ((k) == 7 || (k) == 16 || (k) == 10)
#define PHASE(k) if (!PH_EMPTY(k) && ph_lo <= (k) && (k) < ph_hi) { run_phase<k>(lds); if (EXP_REP(k)) { grid.sync(); run_phase<k>(lds); } if ((k) + 1 < ph_hi) { if ((k) == 0) grid.sync(); else xcd_barrier(bar); if (EXP_SYNC) xcd_barrier(bar); } }
    PHASE(0) PHASE(1) PHASE(2) PHASE(3) PHASE(4) PHASE(5) PHASE(6) PHASE(7) PHASE(8) PHASE(9) PHASE(10)
    PHASE(11) PHASE(12) PHASE(13) PHASE(14) PHASE(15) PHASE(16) PHASE(17) PHASE(18) PHASE(19)
#undef PHASE
}

#ifndef MK_MULTI_LAUNCH
#define MK_MULTI_LAUNCH 0
#endif
extern "C" void kernel_launch(void* const* d_in, const int* in_sizes, int n_in, void* d_out, int out_size, void* d_ws, size_t ws_size, hipStream_t stream) {
    static int grid = 0;
    if (grid == 0) {
        int dev = 0, cus = 0, per_cu = 0;
        hipGetDevice(&dev);
        hipDeviceGetAttribute(&cus, hipDeviceAttributeMultiprocessorCount, dev);
        hipFuncSetAttribute((const void*)fwd_megakernel, hipFuncAttributeMaxDynamicSharedMemorySize, LDS_BYTES);
        hipOccupancyMaxActiveBlocksPerMultiprocessor(&per_cu, (const void*)fwd_megakernel, 512, LDS_BYTES);
        (void)hipGetLastError();
        if (cus <= 0) cus = 256;
        grid = cus;
        if (per_cu < 1) fprintf(stderr, "kernel_launch: occupancy query says %d blocks/CU\n", per_cu);
        if (ws_size < WS_END) { fprintf(stderr, "kernel_launch: workspace too small (%zu < %zu)\n", ws_size, (size_t)WS_END); grid = -1; }
    }
    if (grid < 0) return;
    if (hipMemsetAsync((char*)d_ws + WS_CTL, 0, CTL_BYTES, stream) != hipSuccess) { fprintf(stderr, "kernel_launch: memset of barrier words failed\n"); return; }
    Args a{};
    for (int i = 0; i < 21; ++i) a.in[i] = (const float*)d_in[i];
    a.out = (float*)d_out; a.ws = (unsigned char*)d_ws;
#if MK_MULTI_LAUNCH
    for (int ph = 0; ph < N_PHASES; ++ph) { a.ph_lo = ph; a.ph_hi = ph + 1; hipLaunchKernelGGL(fwd_megakernel, dim3(grid), dim3(512), LDS_BYTES, stream, a); }
#else
    a.ph_lo = 0; a.ph_hi = N_PHASES;
    void* args[] = {&a};
    hipError_t e = hipLaunchCooperativeKernel((const void*)fwd_megakernel, dim3(grid), dim3(512), args, LDS_BYTES, stream);
    if (e != hipSuccess) fprintf(stderr, "cooperative launch failed: %s (grid %d)\n", hipGetErrorString(e), grid);
#endif
}
```

```cpp
#include <hip/hip_runtime.h>
#include <hip/hip_cooperative_groups.h>
#include <cstdio>
#include <cstdint>
namespace cg = cooperative_groups;

#define LAS __attribute__((address_space(3)))
typedef unsigned short bf16_t;
typedef short bf16x8 __attribute__((ext_vector_type(8)));
typedef short s16x4 __attribute__((ext_vector_type(4)));
typedef float f32x4 __attribute__((ext_vector_type(4)));
typedef float f32x2 __attribute__((ext_vector_type(2)));
typedef float f32x16 __attribute__((ext_vector_type(16)));
typedef unsigned u32x4 __attribute__((ext_vector_type(4)));
typedef unsigned u32x2 __attribute__((ext_vector_type(2)));

constexpr int NB = 16, SEQ = 4096, DM = 1024, CTX = 256, ML = NB * SEQ, MC = NB * CTX, MT = ML + MC;
constexpr int LDP = 1792, DFF = 4096, NKEY = SEQ + CTX, NHEAD = 4, QKD = 96;
constexpr float EPS = 1e-6f;
constexpr float QSCALE = 0.10206207261596577f * 1.4426950408889634f;

constexpr size_t MiB = 1u << 20;
constexpr size_t WL = 24 * MiB;
constexpr size_t O_WIN = 0, O_WOUT = 3670016, O_W1 = 5767168, O_W2 = 14155776, O_WUQ = 22544384, O_WK = 22806528, O_WV = 22872064, O_WF = 22937600, O_POOL = 23199744;
constexpr size_t WS_CTL = 48 * MiB + 832 * 1024, CTL_BYTES = 16384;
constexpr size_t WS_MOD = 48 * MiB, WS_RQ = 49 * MiB, WS_RKV = 49 * MiB + 512 * 1024, WS_DFTC = 50 * MiB, WS_DFT = 51 * MiB, WS_XC = 115 * MiB, WS_H = 131 * MiB, WS_OV = 267 * MiB;
constexpr size_t WS_P = WS_OV, WS_MIX = WS_OV + 238 * MiB, WS_UT = WS_OV + 374 * MiB, WS_UTC = WS_OV + 438 * MiB, WS_Q = WS_OV + 442 * MiB, WS_QC = WS_OV + 490 * MiB,
                 WS_KC = WS_OV + 493 * MiB, WS_VT = WS_OV + 544 * MiB, WS_POOLIN = WS_OV + 578 * MiB, WS_ACT = WS_OV, WS_RSS = WS_OV + 613 * MiB, RSS_STRIDE = 512 * 1024, WS_VEC = WS_OV + 615 * MiB, WS_PT = WS_OV + 617 * MiB, WS_QT = WS_OV + 649 * MiB, WS_END = WS_OV + 681 * MiB;
constexpr size_t WS_ROPE = WS_VEC + 1 * MiB;
constexpr int V_GN2 = 0, V_CB2 = 2 * 17 * 1024, V_GN1 = V_CB2 + 2 * 17 * 4096, V_CB1 = V_GN1 + 17 * 1024;

__device__ __forceinline__ unsigned cvt_pk_bf16(float lo, float hi) { unsigned r; asm volatile("v_cvt_pk_bf16_f32 %0, %1, %2" : "=v"(r) : "v"(lo), "v"(hi)); return r; }
__device__ __forceinline__ unsigned f2bf(float f) { unsigned u = __builtin_bit_cast(unsigned, f); return (u + 0x7fffu + ((u >> 16) & 1u)) >> 16; }
__device__ __forceinline__ unsigned pk2(float lo, float hi) { return f2bf(lo) | (f2bf(hi) << 16); }
__device__ __forceinline__ float bflo(unsigned w) { return __uint_as_float(w << 16); }
__device__ __forceinline__ float bfhi(unsigned w) { return __uint_as_float(w & 0xffff0000u); }
__device__ __forceinline__ float bf1(bf16_t b) { return __uint_as_float((unsigned)b << 16); }
__device__ __forceinline__ float shx(float v, int mask, int lane) { return __builtin_bit_cast(float, __builtin_amdgcn_ds_bpermute((lane ^ mask) << 2, __builtin_bit_cast(int, v))); }
__device__ __forceinline__ float wave_sum(float v, int lane) {
#pragma unroll
    for (int o = 1; o < 64; o <<= 1) v += shx(v, o, lane);
    return v;
}
__device__ __forceinline__ float invfreq(int j) {
    return j == 0 ? 1.0f : j == 1 ? 0.31622776601683794f : j == 2 ? 0.1f : j == 3 ? 0.031622776601683794f : j == 4 ? 0.01f : j == 5 ? 0.0031622776601683794f : j == 6 ? 0.001f : 0.00031622776601683794f;
}

namespace pg8 {
constexpr int BM = 256, BK = 64, HALF = 128, HTB = HALF * BK * 2, STAGE_BYTES = 8 * HTB, NXCD = 8, WGM = 8;
__host__ __device__ __forceinline__ int lds_byte(int r, int c) { const int st = (r >> 4) * 2 + (c >> 5), rr = r & 15, cc = c & 31, ob = rr * 64 + cc * 2; return st * 1024 + (ob ^ (((ob >> 9) & 1) << 5)); }
__host__ __device__ __forceinline__ void stage_rc(int b, int& R, int& C) { const int st = b / 1024, sb = b % 1024, swz = sb ^ (((sb >> 9) & 1) << 5); R = (st >> 1) * 16 + swz / 64; C = (st & 1) * 32 + (swz % 64) / 2; }
__host__ __device__ __forceinline__ int perm32(int rho) { const int n = rho >> 4, i = rho & 15; return 8 * (i >> 2) + 4 * n + (i & 3); }
struct Unit { int pm, pn; };
__device__ __forceinline__ const char* uptr(const char* p) { const unsigned long long v = (unsigned long long)p; const unsigned lo = __builtin_amdgcn_readfirstlane((unsigned)v), hi = __builtin_amdgcn_readfirstlane((unsigned)(v >> 32)); return (const char*)(((unsigned long long)hi << 32) | lo); }
struct Gemm { const bf16_t* A; const bf16_t* Bt; int M, N, K, lda, ldb; };
struct StaticOrder {
    int nM, nN, nwg, G, c;
    __device__ void init(int M, int N, int G_, int c_) { nM = M / BM; nN = N / BM; nwg = nM * nN; G = G_; c = c_; }
    __device__ bool next(int i, Unit& u) const {
        const long L = (long)i * G + c; if (L >= nwg) return false;
        int wgid = (int)L; { const int q = nwg / NXCD, r = nwg % NXCD, xcd = wgid % NXCD, off = wgid / NXCD; wgid = (xcd < r ? xcd * (q + 1) : r * (q + 1) + (xcd - r) * q) + off; }
        const int nig = WGM * nN, gid = wgid / nig, fm = gid * WGM, gsz = (nM - fm) < WGM ? (nM - fm) : WGM;
        u.pm = fm + ((wgid % nig) % gsz); u.pn = (wgid % nig) / gsz; return true;
    }
};

template <class Epi>
__device__ __forceinline__ void gemm_phase(LAS unsigned char* lds, const Gemm g, const StaticOrder& S, const Epi& E, const int tid) {
    const int wid = __builtin_amdgcn_readfirstlane(tid >> 6), lane = tid & 63, wr = wid >> 2, wc = wid & 3, fr = lane & 15, fq = lane >> 4;
    const int K = g.K, nt = K / BK;
    unsigned voffA[2], voffB[2];
#pragma unroll
    for (int i = 0; i < 2; ++i) { int R, C; stage_rc(tid * 16 + i * 8192, R, C); const int Rb = (R & ~31) + perm32(R & 31);
        voffA[i] = (unsigned)(R * g.lda + C) * 2u; voffB[i] = (unsigned)(Rb * g.ldb + C) * 2u; }
    const size_t kstep = (size_t)(BK * 2);
    const size_t hsA = (size_t)HALF * g.lda * 2, hsB = (size_t)HALF * g.ldb * 2;
    const size_t tsA = 2 * hsA, tsB = 2 * hsB;
    const unsigned ldsw = (unsigned)wid * 1024u;
    const int aoff = lds_byte(wr * 64 + fr, fq * 8), boff = lds_byte(wc * 32 + fr, fq * 8);
#define PG8_SA(b, h) (((b) * 2 + (h)) * HTB)
#define PG8_SB(b, h) ((4 + (b) * 2 + (h)) * HTB)
#define PG8_STAGE(bufoff, gbase, voff) do { const char* _gb = uptr((const char*)(gbase)); _Pragma("unroll") for (int _i = 0; _i < 2; ++_i) \
        __builtin_amdgcn_global_load_lds((const unsigned*)(_gb + (voff)[_i]), (LAS unsigned*)(lds + (bufoff) + ldsw + _i * 8192), 16, 0, 0); } while (0)
#define PG8_LDA(dst, b, h) do { _Pragma("unroll") for (int m = 0; m < 4; ++m) _Pragma("unroll") for (int k = 0; k < 2; ++k) dst[m][k] = *(const LAS bf16x8*)(lds + PG8_SA(b, h) + aoff + m * 2048 + k * 1024); } while (0)
#define PG8_LDB(dst, b, h) do { _Pragma("unroll") for (int n = 0; n < 2; ++n) _Pragma("unroll") for (int k = 0; k < 2; ++k) dst[n][k] = *(const LAS bf16x8*)(lds + PG8_SB(b, h) + boff + n * 2048 + k * 1024); } while (0)
#define PG8_MMA(ai, bj, At, Bt) do { __builtin_amdgcn_s_setprio(1); _Pragma("unroll") for (int m = 0; m < 4; ++m) _Pragma("unroll") for (int n = 0; n < 2; ++n) _Pragma("unroll") for (int k = 0; k < 2; ++k) \
        acc[ai][bj][m][n] = __builtin_amdgcn_mfma_f32_16x16x32_bf16(Bt[n][k], At[m][k], acc[ai][bj][m][n], 0, 0, 0); __builtin_amdgcn_s_setprio(0); } while (0)
#define PG8_WAIT_V(n) asm volatile("s_waitcnt vmcnt(" #n ")" ::: "memory")
#define PG8_WAIT_L(n) asm volatile("s_waitcnt lgkmcnt(" #n ")" ::: "memory")
#define PG8_BAR __builtin_amdgcn_s_barrier()
#define PG8_SCHED __builtin_amdgcn_sched_barrier(0)
    Unit cur, nxt; int ui = 0;
    if (!S.next(0, cur)) return;
    f32x4 acc[2][2][4][2];
#pragma unroll
    for (int a = 0; a < 2; ++a)
#pragma unroll
        for (int b = 0; b < 2; ++b)
#pragma unroll
            for (int m = 0; m < 4; ++m)
#pragma unroll
                for (int n = 0; n < 2; ++n) acc[a][b][m][n] = (f32x4){0.f, 0.f, 0.f, 0.f};
    bf16x8 At[4][2], B0[2][2], B1[2][2];
    const char* cA = (const char*)g.A + (size_t)cur.pm * tsA; const char* cB = (const char*)g.Bt + (size_t)cur.pn * tsB;
    PG8_STAGE(PG8_SB(0, 0), cB, voffB); PG8_STAGE(PG8_SB(0, 1), cB + hsB, voffB); PG8_STAGE(PG8_SA(0, 0), cA, voffA); PG8_STAGE(PG8_SA(0, 1), cA + hsA, voffA);
    if (wr == 1) PG8_BAR;
    PG8_WAIT_V(2); PG8_BAR;
    PG8_STAGE(PG8_SB(1, 0), cB + kstep, voffB); PG8_STAGE(PG8_SA(1, 0), cA + kstep, voffA); PG8_STAGE(PG8_SB(1, 1), cB + hsB + kstep, voffB);
    PG8_WAIT_V(6); PG8_BAR;
    for (;;) {
        const bool has_next = S.next(ui + 1, nxt);
        const char* nA = has_next ? (const char*)g.A + (size_t)nxt.pm * tsA : cA; const char* nB = has_next ? (const char*)g.Bt + (size_t)nxt.pn * tsB : cB;
        for (int t = 0; t < nt; t += 2) {
            const bool last = (t == nt - 2);
            const char* a1 = cA + (size_t)(t + 1) * kstep;
            const char* a2 = last ? nA : cA + (size_t)(t + 2) * kstep; const char* b2 = last ? nB : cB + (size_t)(t + 2) * kstep;
            const char* a3 = a2 + kstep; const char* b3 = b2 + kstep;
            PG8_LDB(B0, 0, 0); PG8_LDB(B1, 0, 1); PG8_SCHED; PG8_LDA(At, 0, 0); PG8_STAGE(PG8_SA(1, 1), a1 + hsA, voffA);
            PG8_WAIT_V(8); PG8_WAIT_L(0); PG8_BAR; PG8_MMA(0, 0, At, B0); PG8_MMA(0, 1, At, B1); PG8_BAR; PG8_SCHED;
            PG8_LDA(At, 0, 1); PG8_STAGE(PG8_SB(0, 0), b2, voffB); PG8_STAGE(PG8_SB(0, 1), b2 + hsB, voffB); PG8_STAGE(PG8_SA(0, 0), a2, voffA);
            PG8_WAIT_V(8); PG8_WAIT_L(0); PG8_BAR; PG8_MMA(1, 0, At, B0); PG8_MMA(1, 1, At, B1); PG8_BAR; PG8_SCHED;
            PG8_LDB(B0, 1, 0); PG8_LDB(B1, 1, 1); PG8_SCHED; PG8_LDA(At, 1, 0); PG8_STAGE(PG8_SA(0, 1), a2 + hsA, voffA);
            PG8_WAIT_V(8); PG8_WAIT_L(0); PG8_BAR; PG8_MMA(0, 0, At, B0); PG8_MMA(0, 1, At, B1); PG8_BAR; PG8_SCHED;
            PG8_LDA(At, 1, 1); PG8_STAGE(PG8_SB(1, 0), b3, voffB); PG8_STAGE(PG8_SB(1, 1), b3 + hsB, voffB); PG8_STAGE(PG8_SA(1, 0), a3, voffA);
            PG8_WAIT_V(8); PG8_WAIT_L(0); PG8_BAR; PG8_MMA(1, 0, At, B0); PG8_MMA(1, 1, At, B1); PG8_BAR; PG8_SCHED;
        }
        if (wr == 0) PG8_BAR;
        E(acc, cur, wr, wc, fr, fq);
        if (!has_next) break;
#pragma unroll
        for (int a = 0; a < 2; ++a)
#pragma unroll
            for (int b = 0; b < 2; ++b)
#pragma unroll
                for (int m = 0; m < 4; ++m)
#pragma unroll
                    for (int n = 0; n < 2; ++n) acc[a][b][m][n] = (f32x4){0.f, 0.f, 0.f, 0.f};
        cur = nxt; cA = nA; cB = nB; ++ui;
        if (wr == 1) PG8_BAR;
    }
    PG8_WAIT_V(0);
    PG8_BAR;
#undef PG8_SA
#undef PG8_SB
#undef PG8_STAGE
#undef PG8_LDA
#undef PG8_LDB
#undef PG8_MMA
#undef PG8_WAIT_V
#undef PG8_WAIT_L
#undef PG8_BAR
#undef PG8_SCHED
}
}

enum { M_P = 0, M_UT = 1, M_Q = 2, M_K = 3, M_VT = 4, M_POOL = 5, M_DFT = 6, M_DFTC = 7, M_RES = 8, M_RELU2 = 9, M_PS = 10, M_F32 = 11 };
struct EpiArgs {
    bf16_t* o0; bf16_t* o1;
    const float* f0; const float* f1;
    float* x0; float* x1;
    int ld; int goff;
};
__device__ __forceinline__ u32x4 pack8(const f32x4& a, const f32x4& b) { u32x4 w; w.x = cvt_pk_bf16(a[0], a[1]); w.y = cvt_pk_bf16(a[2], a[3]); w.z = cvt_pk_bf16(b[0], b[1]); w.w = cvt_pk_bf16(b[2], b[3]); return w; }

#define GAS __attribute__((address_space(1)))
typedef GAS u32x4* gv4p; typedef GAS f32x4* gf4p; typedef const GAS f32x4* gcf4p; typedef const GAS float* gcfp;
template <int MODE> __device__ __forceinline__ void store8(const EpiArgs& e, int row, int col, f32x4 v0, f32x4 v1, const f32x4 sA, const f32x4 sB) {
    if constexpr (MODE == M_P || MODE == M_PS) {
        *(gv4p)(e.o0 + (size_t)row * e.ld + col) = pack8(v0, v1);
    } else if constexpr (MODE == M_UT) {
        const int part = row >> 8, n = row & 255;
        bf16_t* dst;
        if (col < ML) { const int b = col >> 12, t = col & 4095; dst = e.o0 + ((size_t)(b * 256 + n) * 8192 + part * 4096 + t); }
        else { const int cc = col - ML, b = cc >> 8, t = cc & 255; dst = e.o1 + ((size_t)(b * 256 + n) * 512 + part * 256 + t); }
        *(gv4p)dst = pack8(v0, v1);
    } else if constexpr (MODE == M_Q) {
        if (col < 384) {
            const float s = sA[0];
            bf16_t* dst = row < ML ? e.o0 + (size_t)row * 384 + col : e.o1 + (size_t)(row - ML) * 384 + col;
            *(gv4p)dst = pack8(v0 * s, v1 * s);
        }
    } else if constexpr (MODE == M_K) {
        const int h = col >> 6, d = col & 63; const float s = sA[0];
        int b, key; if (row < ML) { b = row >> 12; key = CTX + (row & 4095); } else { const int rr = row - ML; b = rr >> 8; key = rr & 255; }
        *(gv4p)(e.o0 + ((size_t)((b * 4 + h) * NKEY + key) * QKD + d)) = pack8(v0 * s, v1 * s);
    } else if constexpr (MODE == M_VT) {
        int b, key; if (col < ML) { b = col >> 12; key = CTX + (col & 4095); } else { const int cc = col - ML; b = cc >> 8; key = cc & 255; }
        const u32x4 w = pack8(v0 * sA, v1 * sB); const int half = (key >> 3) & 1;
        GAS bf16_t* d = (GAS bf16_t*)e.o0 + ((size_t)(b * 256 + row) * NKEY + (key & ~15));
        *(GAS u32x2*)(d + (half ? 4 : 0)) = (u32x2){w.x, w.y}; *(GAS u32x2*)(d + (half ? 12 : 8)) = (u32x2){w.z, w.w};
    } else if constexpr (MODE == M_POOL) {
        *(gv4p)(e.o0 + (size_t)row * DM + 512 + col) = pack8(v0 * sA, v1 * sB);
    } else if constexpr (MODE == M_DFT) {
        const int b = col >> 8, n = col & 255;
        *(gv4p)(e.o0 + (size_t)(b * SEQ + row) * DM + n) = pack8(v0 * (1.f / 512.f), v1 * (1.f / 512.f));
    } else if constexpr (MODE == M_F32) {
        GAS float* d = (GAS float*)e.o0 + (size_t)row * 4096 + col; *(gf4p)d = v0; *(gf4p)(d + 4) = v1;
    } else if constexpr (MODE == M_DFTC) {
        const int b = col >> 8, n = col & 255;
        *(gv4p)(e.o0 + (size_t)(ML + b * CTX + row) * DM + n) = pack8(v0 * (1.f / 128.f), v1 * (1.f / 128.f));
    } else if constexpr (MODE == M_RELU2) {
#pragma unroll
        for (int i = 0; i < 4; ++i) { const float a = fmaxf(v0[i], 0.f), b = fmaxf(v1[i], 0.f); v0[i] = a * a; v1[i] = b * b; }
        *(gv4p)(e.o0 + (size_t)row * e.ld + col) = pack8(v0, v1);
    }
}
template <int MODE> __device__ __forceinline__ void epi_loops(const EpiArgs& e, const f32x4 (&acc)[2][2][4][2], const pg8::Unit& u, int wr, int wc, int fr, int fq) {
    const int row0 = u.pm * 256 + wr * 64 + fr, col0 = u.pn * 256 + wc * 32 + 8 * fq;
    const f32x4 zero4 = (f32x4){0.f, 0.f, 0.f, 0.f};
    if constexpr (MODE == M_RES) {
        const int bi = row0 < ML ? (row0 >> 12) : 16;
        gcfp gp = (gcfp)((const float*)e.o1 + (size_t)bi * 6144 + e.goff + col0);
        f32x4 gt[2][2];
#pragma unroll
        for (int bj = 0; bj < 2; ++bj) { gt[bj][0] = *(gcf4p)(gp + bj * 128); gt[bj][1] = *(gcf4p)(gp + bj * 128 + 4); }
        const bool lat = row0 < ML;
        gcfp sbase = lat ? (gcfp)(e.f0 + (size_t)row0 * DM + col0) : (gcfp)(e.f1 + (size_t)(row0 - ML) * DM + col0);
        GAS float* dbase = lat ? (GAS float*)(e.x0 + (size_t)row0 * DM + col0) : (GAS float*)(e.x1 + (size_t)(row0 - ML) * DM + col0);
        const int emit = e.ld;
        unsigned char* wsb = (unsigned char*)e.x1 - WS_XC;
        const float* vec = (const float*)(wsb + WS_VEC);
        gcfp gnp = (gcfp)(vec + (emit == 3 ? V_GN1 : V_GN2 + (emit == 2 ? 17 * 1024 : 0)) + bi * 1024 + col0);
        GAS float* rss = (GAS float*)(wsb + WS_RSS + (size_t)(emit > 0 ? emit - 1 : 0) * RSS_STRIDE) + row0;
        GAS bf16_t* hbase = (GAS bf16_t*)(wsb + WS_H) + (size_t)row0 * DM + col0;
        f32x4 gn[2][2];
#pragma unroll
        for (int bj = 0; bj < 2; ++bj) { gn[bj][0] = emit ? *(gcf4p)(gnp + bj * 128) : zero4; gn[bj][1] = emit ? *(gcf4p)(gnp + bj * 128 + 4) : zero4; }
        const int lane_e = fq * 16 + fr;
        f32x4 cur[2][2], nxt[2][2];
#pragma unroll
        for (int bj = 0; bj < 2; ++bj) { cur[bj][0] = *(gcf4p)(sbase + bj * 128); cur[bj][1] = *(gcf4p)(sbase + bj * 128 + 4); }
#pragma unroll
        for (int g = 0; g < 8; ++g) {
            const int ai = g >> 2, m = g & 3;
            if (g + 1 < 8) { const int a2 = (g + 1) >> 2, m2 = (g + 1) & 3; const size_t off = (size_t)(a2 * 128 + m2 * 16) * DM;
#pragma unroll
                for (int bj = 0; bj < 2; ++bj) { nxt[bj][0] = *(gcf4p)(sbase + off + bj * 128); nxt[bj][1] = *(gcf4p)(sbase + off + bj * 128 + 4); } }
            const size_t offc = (size_t)(ai * 128 + m * 16) * DM;
            float sq = 0.f;
#pragma unroll
            for (int bj = 0; bj < 2; ++bj) {
                const f32x4 x0 = cur[bj][0] + gt[bj][0] * acc[ai][bj][m][0], x1 = cur[bj][1] + gt[bj][1] * acc[ai][bj][m][1];
                *(gf4p)(dbase + offc + bj * 128) = x0; *(gf4p)(dbase + offc + bj * 128 + 4) = x1;
                if (emit) { *(gv4p)(hbase + offc + bj * 128) = pack8(x0 * gn[bj][0], x1 * gn[bj][1]);
                    sq += (x0[0] * x0[0] + x0[1] * x0[1]) + (x0[2] * x0[2] + x0[3] * x0[3]) + (x1[0] * x1[0] + x1[1] * x1[1]) + (x1[2] * x1[2] + x1[3] * x1[3]); }
            }
            if (emit) { sq += shx(sq, 16, lane_e); sq += shx(sq, 32, lane_e); if (fq == 0) atomicAdd((float*)(rss + ai * 128 + m * 16), sq); }
            asm volatile("" ::: "memory");
#pragma unroll
            for (int bj = 0; bj < 2; ++bj) { cur[bj][0] = nxt[bj][0]; cur[bj][1] = nxt[bj][1]; }
        }
    } else {
        float rs[8]; f32x4 cs[2][2];
        if constexpr (MODE == M_Q || MODE == M_K) {
#pragma unroll
            for (int g = 0; g < 8; ++g) rs[g] = ((gcfp)e.f0)[row0 + (g >> 2) * 128 + (g & 3) * 16] * (MODE == M_Q ? QSCALE : 1.0f);
        }
        if constexpr (MODE == M_VT || MODE == M_POOL) {
#pragma unroll
            for (int bj = 0; bj < 2; ++bj) { cs[bj][0] = *(gcf4p)(e.f0 + col0 + bj * 128); cs[bj][1] = *(gcf4p)(e.f0 + col0 + bj * 128 + 4); }
        }
        if constexpr (MODE == M_RELU2 || MODE == M_PS) {
            const int bi = row0 < ML ? (row0 >> 12) : 16;
#pragma unroll
            for (int g = 0; g < 8; ++g) rs[g] = 1.0f / sqrtf(((gcfp)e.f0)[row0 + (g >> 2) * 128 + (g & 3) * 16] * (1.f / DM) + EPS);
#pragma unroll
            for (int bj = 0; bj < 2; ++bj) { cs[bj][0] = *(gcf4p)(e.f1 + (size_t)bi * e.goff + col0 + bj * 128); cs[bj][1] = *(gcf4p)(e.f1 + (size_t)bi * e.goff + col0 + bj * 128 + 4); }
        }
#pragma unroll
        for (int ai = 0; ai < 2; ++ai)
#pragma unroll
            for (int m = 0; m < 4; ++m)
#pragma unroll
                for (int bj = 0; bj < 2; ++bj) {
                    f32x4 sA = zero4, sB = zero4;
                    if constexpr (MODE == M_Q || MODE == M_K) sA[0] = rs[ai * 4 + m];
                    if constexpr (MODE == M_VT || MODE == M_POOL) { sA = cs[bj][0]; sB = cs[bj][1]; }
                    if constexpr (MODE == M_RELU2 || MODE == M_PS) { const float rr = rs[ai * 4 + m];
                        store8<MODE>(e, row0 + ai * 128 + m * 16, col0 + bj * 128, acc[ai][bj][m][0] * rr + cs[bj][0], acc[ai][bj][m][1] * rr + cs[bj][1], sA, sB); }
                    else
                    store8<MODE>(e, row0 + ai * 128 + m * 16, col0 + bj * 128, acc[ai][bj][m][0], acc[ai][bj][m][1], sA, sB);
                }
    }
}
struct Epi {
    int mode; EpiArgs e;
    __device__ __forceinline__ void operator()(const f32x4 (&acc)[2][2][4][2], const pg8::Unit& u, int wr, int wc, int fr, int fq) const {
        switch (mode) {
            case M_P: epi_loops<M_P>(e, acc, u, wr, wc, fr, fq); break;
            case M_UT: epi_loops<M_UT>(e, acc, u, wr, wc, fr, fq); break;
            case M_Q: epi_loops<M_Q>(e, acc, u, wr, wc, fr, fq); break;
            case M_K: epi_loops<M_K>(e, acc, u, wr, wc, fr, fq); break;
            case M_VT: epi_loops<M_VT>(e, acc, u, wr, wc, fr, fq); break;
            case M_POOL: epi_loops<M_POOL>(e, acc, u, wr, wc, fr, fq); break;
            case M_DFTC: epi_loops<M_DFTC>(e, acc, u, wr, wc, fr, fq); break;
            case M_RES: epi_loops<M_RES>(e, acc, u, wr, wc, fr, fq); break;
            case M_PS: epi_loops<M_PS>(e, acc, u, wr, wc, fr, fq); break;
            case M_F32: epi_loops<M_F32>(e, acc, u, wr, wc, fr, fq); break;
            default: epi_loops<M_RELU2>(e, acc, u, wr, wc, fr, fq); break;
        }
    }
};

struct Args { const float* in[21]; float* out; unsigned char* ws; int ph_lo, ph_hi; };
typedef const __attribute__((address_space(4))) Args* KArgs;

__device__ __forceinline__ void transpose_item(const float* W, int K, int N, bf16_t* WT, LAS float* scr, int item, int lane) {
    const int nblk = N / 32, kb = item / nblk, nb = item % nblk, k0 = 64 * kb, n0 = 32 * nb;
#pragma unroll 8
    for (int i = 0; i < 32; ++i) { const int kk = 2 * i + (lane >> 5); scr[kk * 33 + (lane & 31)] = W[(size_t)(k0 + kk) * N + n0 + (lane & 31)]; }
    asm volatile("s_waitcnt lgkmcnt(0)" ::: "memory");
    const int c = lane & 7;
#pragma unroll
    for (int j = 0; j < 4; ++j) { const int n = (lane >> 3) + 8 * j; const LAS float* s = scr + (8 * c) * 33 + n;
        u32x4 o; o.x = pk2(s[0 * 33], s[1 * 33]); o.y = pk2(s[2 * 33], s[3 * 33]); o.z = pk2(s[4 * 33], s[5 * 33]); o.w = pk2(s[6 * 33], s[7 * 33]);
        *(u32x4*)(WT + (size_t)(n0 + n) * K + k0 + 8 * c) = o; }
    asm volatile("s_waitcnt lgkmcnt(0)" ::: "memory");
}

__device__ __forceinline__ void phase_setup(KArgs ap, unsigned char* ws, LAS unsigned char* lds, int tid, int lane, int wave, const int BX, const int G) {
    {
        LAS float* S = (LAS float*)lds;
        LAS float* part = (LAS float*)(lds + 17 * 1024 * 4);
        float* mod = (float*)(ws + WS_MOD);
        if (BX < 192) {
            for (int i = tid; i < 17 * 1024; i += 512) { const int r = i >> 10, k = i & 1023; const float v = r < 16 ? ap->in[1][r * 1024 + k] : ap->in[3][k]; S[i] = v / (1.f + expf(-v)); }
        }
        __syncthreads();
        for (int item = BX; item < 192; item += G) {
            const int l = item / 96, n0 = (item % 96) * 64;
            const float* W = ap->in[4] + (size_t)l * 1024 * 6144 + n0 + lane;
            float acc[17];
#pragma unroll
            for (int r = 0; r < 17; ++r) acc[r] = 0.f;
            for (int k = wave * 128; k < wave * 128 + 128; k += 4) {
                const float w0 = W[(size_t)k * 6144], w1 = W[(size_t)(k + 1) * 6144], w2 = W[(size_t)(k + 2) * 6144], w3 = W[(size_t)(k + 3) * 6144];
#pragma unroll
                for (int r = 0; r < 17; ++r) { const f32x4 s = *(const LAS f32x4*)(S + r * 1024 + k); acc[r] += s[0] * w0 + s[1] * w1 + s[2] * w2 + s[3] * w3; }
            }
#pragma unroll
            for (int r = 0; r < 17; ++r) part[(wave * 17 + r) * 64 + lane] = acc[r];
            __syncthreads();
            for (int i = tid; i < 17 * 64; i += 512) { const int r = i >> 6, j = i & 63; float s = ap->in[5][l * 6144 + n0 + j];
#pragma unroll
                for (int w = 0; w < 8; ++w) s += part[(w * 17 + r) * 64 + j];
                mod[(size_t)(l * 17 + r) * 6144 + n0 + j] = s; }
            __syncthreads();
        }
    }
    {
        LAS float* scr = (LAS float*)(lds + wave * 16384);
        const int gw = BX * 8 + wave, NGW = G * 8;
        constexpr int I_IN = 16 * 53, I_OUT = 16 * 32, I_1 = 16 * 128, I_2 = 64 * 32, I_L = I_IN + I_OUT + I_1 + I_2;
        for (int it = gw; it < 2 * I_L; it += NGW) {
            const int l = it / I_L; int r = it % I_L; unsigned char* wl = ws + l * WL;
            if (r < I_IN) { transpose_item(ap->in[8] + (size_t)l * 1024 * 1696, 1024, 1696, (bf16_t*)(wl + O_WIN), scr, r, lane); continue; } r -= I_IN;
            if (r < I_OUT) { transpose_item(ap->in[17] + (size_t)l * 1024 * 1024, 1024, 1024, (bf16_t*)(wl + O_WOUT), scr, r, lane); continue; } r -= I_OUT;
            if (r < I_1) { transpose_item(ap->in[18] + (size_t)l * 1024 * 4096, 1024, 4096, (bf16_t*)(wl + O_W1), scr, r, lane); continue; } r -= I_1;
            transpose_item(ap->in[19] + (size_t)l * 4096 * 1024, 4096, 1024, (bf16_t*)(wl + O_W2), scr, r, lane);
        }
    }
    {
        const int gt = BX * 512 + tid, NGT = G * 512;
        for (int l = 0; l < 2; ++l) {
            unsigned char* wl = ws + l * WL;
            { unsigned* z = (unsigned*)((bf16_t*)(wl + O_WIN) + (size_t)1696 * 1024); for (int i = gt; i < 96 * 1024 / 2; i += NGT) z[i] = 0u; }
            { bf16_t* o = (bf16_t*)(wl + O_WUQ); const float* w = ap->in[14] + (size_t)l * 256 * 384; const float* gq = ap->in[13] + l * 256;
              for (int i = gt; i < 512 * 256; i += NGT) { const int n = i >> 8, k = i & 255; o[i] = (bf16_t)(n < 384 ? f2bf(gq[k] * w[k * 384 + n]) : 0u); } }
            { bf16_t* ok = (bf16_t*)(wl + O_WK); bf16_t* ov = (bf16_t*)(wl + O_WV); const float* w = ap->in[16] + (size_t)l * 128 * 512; const float* gk = ap->in[15] + l * 128;
              for (int i = gt; i < 256 * 128; i += NGT) { const int n = i >> 7, k = i & 127, h = n >> 6, d = n & 63; const float gg = gk[k];
                  ok[i] = (bf16_t)f2bf(gg * w[k * 512 + h * 128 + d]); ov[i] = (bf16_t)f2bf(gg * w[k * 512 + h * 128 + 64 + d]); } }
            { bf16_t* o = (bf16_t*)(wl + O_WF); const float* fw = ap->in[9] + (size_t)l * 256 * 256;
              for (int i = gt; i < 512 * 256; i += NGT) { const int r = i >> 8, kin = i & 255, part = r >> 8, n = r & 255, h = kin >> 6, c = kin & 63; float s = 0.f;
                  for (int k2 = 0; k2 < 64; ++k2) { const float ang = (float)((c * k2) & 63) * (1.f / 32.f); const float tr = part ? sinpif(ang) : cospif(ang); s += tr * fw[(h * 64 + k2) * 256 + n]; }
                  o[i] = (bf16_t)f2bf(s); } }
            { bf16_t* o = (bf16_t*)(wl + O_POOL); const float* pw = ap->in[11] + (size_t)l * 4 * 64 * 64;
              for (int i = gt; i < 256 * 256; i += NGT) { const int r = i >> 8, k = i & 255, g = r >> 6, n = r & 63; o[i] = (bf16_t)((k >> 6) == g ? f2bf(pw[(g * 64 + (k & 63)) * 64 + n]) : 0u); } }
        }
        { float* tab = (float*)(ws + WS_ROPE); for (int i = gt; i < 512; i += NGT) { float sn, cs; sincosf((float)(i >> 3) * invfreq(i & 7), &sn, &cs); tab[2 * i] = cs; tab[2 * i + 1] = sn; } }
        { u32x4* z = (u32x4*)(ws + WS_RSS); for (int i = gt; i < (int)(3 * RSS_STRIDE / 16); i += NGT) z[i] = (u32x4){0u, 0u, 0u, 0u}; }
        { u32x4* o = (u32x4*)(ws + WS_DFT);
          for (int i = gt; i < 2 * 2048 * 512; i += NGT) { const int part = i >> 20, ii = i & ((1 << 20) - 1), row = ii >> 9, t0 = (ii & 511) * 8; float v[8];
#pragma unroll
              for (int e = 0; e < 8; ++e) { const float ang = (float)(((row + 1) * (t0 + e)) & 4095) * (1.f / 2048.f); v[e] = part ? sinpif(ang) : cospif(ang); }
              u32x4 w; w.x = pk2(v[0], v[1]); w.y = pk2(v[2], v[3]); w.z = pk2(v[4], v[5]); w.w = pk2(v[6], v[7]); o[i] = w; } }
        { u32x4* o = (u32x4*)(ws + WS_DFTC);
          for (int i = gt; i < 256 * 64; i += NGT) { const int row = i >> 6, j0 = (i & 63) * 8; float v[8];
#pragma unroll
              for (int e = 0; e < 8; ++e) { const int j = j0 + e, t = j & 255; const float ang = (float)((row * t) & 255) * (1.f / 128.f); v[e] = (j >> 8) ? -sinpif(ang) : cospif(ang); }
              u32x4 w; w.x = pk2(v[0], v[1]); w.y = pk2(v[2], v[3]); w.z = pk2(v[4], v[5]); w.w = pk2(v[6], v[7]); o[i] = w; } }
    }
}

__device__ __forceinline__ void phase_vectors(KArgs ap, unsigned char* ws, LAS unsigned char* lds, int tid, int lane, int wave, const int BX, const int G) {
    const float* mod = (const float*)(ws + WS_MOD);
    float* vec = (float*)(ws + WS_VEC);
    { const int gt = BX * 512 + tid, NGT = G * 512;
      for (int i = gt; i < 2 * 17 * 1024; i += NGT) { const int l = i / (17 * 1024), r = (i >> 10) % 17, k = i & 1023; vec[V_GN2 + i] = ap->in[7][l * 1024 + k] * (1.0f + mod[(size_t)(l * 17 + r) * 6144 + 4096 + k]); }
      for (int i = gt; i < 17 * 1024; i += NGT) { const int r = i >> 10, k = i & 1023; vec[V_GN1 + i] = ap->in[6][1024 + k] * (1.0f + mod[(size_t)(17 + r) * 6144 + 1024 + k]); } }
    LAS float* S = (LAS float*)lds;
    LAS float* part = (LAS float*)(lds + 17 * 1024 * 4);
    for (int item = BX; item < 156; item += G) {
        const bool up = item < 128;
        const int l = up ? item / 64 : 1, n0 = up ? (item % 64) * 64 : (item - 128) * 64, N = up ? 4096 : 1696, soff = up ? 3072 : 0;
        const float* Wb = up ? ap->in[18] + (size_t)l * 1024 * 4096 : ap->in[8] + (size_t)1024 * 1696;
        __syncthreads();
        for (int i = tid; i < 17 * 1024; i += 512) { const int r = i >> 10, k = i & 1023; S[i] = mod[(size_t)(l * 17 + r) * 6144 + soff + k]; }
        __syncthreads();
        const bool cv = n0 + lane < N;
        const float* W = Wb + n0 + (cv ? lane : 0);
        float acc[17];
#pragma unroll
        for (int r = 0; r < 17; ++r) acc[r] = 0.f;
        for (int k = wave * 128; k < wave * 128 + 128; k += 4) {
            const float w0 = W[(size_t)k * N], w1 = W[(size_t)(k + 1) * N], w2 = W[(size_t)(k + 2) * N], w3 = W[(size_t)(k + 3) * N];
#pragma unroll
            for (int r = 0; r < 17; ++r) { const f32x4 sv = *(const LAS f32x4*)(S + r * 1024 + k); acc[r] += sv[0] * w0 + sv[1] * w1 + sv[2] * w2 + sv[3] * w3; }
        }
#pragma unroll
        for (int r = 0; r < 17; ++r) part[(wave * 17 + r) * 64 + lane] = cv ? acc[r] : 0.f;
        __syncthreads();
        for (int i = tid; i < 17 * 64; i += 512) { const int r = i >> 6, j = i & 63; float sum = 0.f;
#pragma unroll
            for (int w = 0; w < 8; ++w) sum += part[(w * 17 + r) * 64 + j];
            if (up) vec[V_CB2 + (size_t)(l * 17 + r) * 4096 + n0 + j] = sum; else vec[V_CB1 + (size_t)r * 1792 + n0 + j] = sum; }
    }
    __syncthreads();
}
constexpr int RPI = 4;
__device__ __forceinline__ void phase_norm_mod(const float* xl, const float* xc, const float* g, const float* mod, int shoff, int scoff, bf16_t* H, int nrows, int lane, int wave, const int BX, const int G) {
    const int gw = BX * 8 + wave, NGW = G * 8;
    for (int row0 = gw; row0 < nrows; row0 += NGW * RPI) {
        f32x4 v[RPI][4]; float ss[RPI];
#pragma unroll
        for (int i = 0; i < RPI; ++i) { const int row = row0 + i * NGW; ss[i] = 0.f;
            if (row < nrows) { const float* src = row < ML ? xl + (size_t)row * DM : xc + (size_t)(row - ML) * DM;
#pragma unroll
                for (int j = 0; j < 4; ++j) v[i][j] = *(const f32x4*)(src + lane * 4 + 256 * j); }
            else {
#pragma unroll
                for (int j = 0; j < 4; ++j) v[i][j] = (f32x4){0.f, 0.f, 0.f, 0.f}; } }
#pragma unroll
        for (int i = 0; i < RPI; ++i) {
#pragma unroll
            for (int j = 0; j < 4; ++j) ss[i] += (v[i][j][0] * v[i][j][0] + v[i][j][1] * v[i][j][1]) + (v[i][j][2] * v[i][j][2] + v[i][j][3] * v[i][j][3]); }
#pragma unroll
        for (int o = 1; o < 64; o <<= 1) {
#pragma unroll
            for (int i = 0; i < RPI; ++i) ss[i] += shx(ss[i], o, lane); }
#pragma unroll
        for (int i = 0; i < RPI; ++i) { const int row = row0 + i * NGW;
            if (row < nrows) {
                const float rr = 1.0f / sqrtf(ss[i] * (1.f / DM) + EPS);
                const float* mv = mod + (size_t)(row < ML ? (row >> 12) : 16) * 6144;
#pragma unroll
                for (int j = 0; j < 4; ++j) { const int col = lane * 4 + 256 * j;
                    const f32x4 gg = *(const f32x4*)(g + col), sc = *(const f32x4*)(mv + scoff + col), sh = *(const f32x4*)(mv + shoff + col);
                    const f32x4 o = (v[i][j] * rr * gg) * (sc + 1.0f) + sh;
                    u32x2 w; w.x = cvt_pk_bf16(o[0], o[1]); w.y = cvt_pk_bf16(o[2], o[3]);
                    *(u32x2*)(H + (size_t)row * DM + col) = w; } } }
    }
}
__device__ __forceinline__ void phase_final_norm(float* x, const float* g, int lane, int wave, const int BX, const int G) {
    const int gw = BX * 8 + wave, NGW = G * 8;
    for (int row0 = gw; row0 < ML; row0 += NGW * RPI) {
        f32x4 v[RPI][4]; float ss[RPI];
#pragma unroll
        for (int i = 0; i < RPI; ++i) { const int row = row0 + i * NGW; ss[i] = 0.f;
#pragma unroll
            for (int j = 0; j < 4; ++j) v[i][j] = *(const f32x4*)(x + (size_t)row * DM + lane * 4 + 256 * j); }
#pragma unroll
        for (int i = 0; i < RPI; ++i) {
#pragma unroll
            for (int j = 0; j < 4; ++j) ss[i] += (v[i][j][0] * v[i][j][0] + v[i][j][1] * v[i][j][1]) + (v[i][j][2] * v[i][j][2] + v[i][j][3] * v[i][j][3]); }
#pragma unroll
        for (int o = 1; o < 64; o <<= 1) {
#pragma unroll
            for (int i = 0; i < RPI; ++i) ss[i] += shx(ss[i], o, lane); }
#pragma unroll
        for (int i = 0; i < RPI; ++i) { const int row = row0 + i * NGW;
            const float rr = 1.0f / sqrtf(ss[i] * (1.f / DM) + EPS);
#pragma unroll
            for (int j = 0; j < 4; ++j) { const int col = lane * 4 + 256 * j; const f32x4 gg = *(const f32x4*)(g + col); *(f32x4*)(x + (size_t)row * DM + col) = v[i][j] * rr * gg; } }
    }
}

__device__ __forceinline__ void phase_token_local(const bf16_t* P, float* rq, float* rkv, bf16_t* Kc, bf16_t* MIX, bf16_t* POOLIN, const float* conv_w, const float* ropetab, int tid, int lane, int wave, const int BX, const int G) {
    const int gw = BX * 8 + wave, NGW = G * 8;
    for (int row0 = gw; row0 < MT; row0 += NGW * RPI) {
        u32x2 cq[RPI]; unsigned ck[RPI]; float sq[RPI], sk[RPI];
#pragma unroll
        for (int i = 0; i < RPI; ++i) { const int row = min(row0 + i * NGW, MT - 1); const GAS bf16_t* pr = (const GAS bf16_t*)P + (size_t)row * LDP;
            cq[i] = *(const GAS u32x2*)(pr + 1280 + lane * 4); ck[i] = *(const GAS unsigned*)(pr + 1536 + lane * 2); }
#pragma unroll
        for (int i = 0; i < RPI; ++i) { const float a0 = bflo(cq[i].x), a1 = bfhi(cq[i].x), a2 = bflo(cq[i].y), a3 = bfhi(cq[i].y), k0 = bflo(ck[i]), k1 = bfhi(ck[i]);
            sq[i] = (a0 * a0 + a1 * a1) + (a2 * a2 + a3 * a3); sk[i] = k0 * k0 + k1 * k1; }
#pragma unroll
        for (int o = 1; o < 64; o <<= 1) {
#pragma unroll
            for (int i = 0; i < RPI; ++i) { sq[i] += shx(sq[i], o, lane); sk[i] += shx(sk[i], o, lane); } }
#pragma unroll
        for (int i = 0; i < RPI; ++i) { const int row = row0 + i * NGW;
            if (row < MT && lane == 0) { ((GAS float*)rq)[row] = 1.0f / sqrtf(sq[i] * (1.f / 256.f) + EPS); ((GAS float*)rkv)[row] = 1.0f / sqrtf(sk[i] * (1.f / 128.f) + EPS); } }
    }
    {
        const int gt0 = BX * 512 + tid, NGT0 = G * 512;
        for (int e = gt0; e < MT * 4; e += NGT0) {
            const int row = e >> 2, L = e & 3;
            const bool lat = row < ML; int b, t, key;
            if (lat) { b = row >> 12; t = row & 4095; key = CTX + t; } else { const int rr = row - ML; b = rr >> 8; t = rr & 255; key = t; }
            const GAS bf16_t* pr = (const GAS bf16_t*)P + (size_t)row * LDP + 1664;
            const u32x4 own = *(const GAS u32x4*)(pr + 8 * L), par = *(const GAS u32x4*)(pr + 8 * (L ^ 1));
            u32x4 outw = own;
            if (lat) {
                const int ipos = (L & 2) ? (t & 63) : (t >> 6);
                const GAS f32x4* tb = (const GAS f32x4*)(ropetab + ipos * 16);
                const f32x4 t0 = tb[0], t1 = tb[1], t2 = tb[2], t3 = tb[3];
                const float sg = (L & 1) ? 1.0f : -1.0f;
                float xo[8] = {bflo(own.x), bfhi(own.x), bflo(own.y), bfhi(own.y), bflo(own.z), bfhi(own.z), bflo(own.w), bfhi(own.w)};
                float xp[8] = {bflo(par.x), bfhi(par.x), bflo(par.y), bfhi(par.y), bflo(par.z), bfhi(par.z), bflo(par.w), bfhi(par.w)};
                float cs[8] = {t0[0], t0[2], t1[0], t1[2], t2[0], t2[2], t3[0], t3[2]}, sn[8] = {t0[1], t0[3], t1[1], t1[3], t2[1], t2[3], t3[1], t3[3]};
                float o[8];
#pragma unroll
                for (int j = 0; j < 8; ++j) o[j] = xo[j] * cs[j] + sg * xp[j] * sn[j];
                outw.x = pk2(o[0], o[1]); outw.y = pk2(o[2], o[3]); outw.z = pk2(o[4], o[5]); outw.w = pk2(o[6], o[7]);
            }
#pragma unroll
            for (int h = 0; h < 4; ++h) *(GAS u32x4*)((GAS bf16_t*)Kc + (size_t)((b * 4 + h) * NKEY + key) * QKD + 64 + 8 * L) = outw;
        }
    }
    const int rpb = (MT + G - 1) / G;
    const int rbeg = BX * rpb, rend = min(rbeg + rpb, MT);
    const int c16 = tid & 63, ch = c16 * 4;
    const f32x4 cw0 = *(const f32x4*)(conv_w + ch), cw1 = *(const f32x4*)(conv_w + 256 + ch), cw2 = *(const f32x4*)(conv_w + 512 + ch);
    const int hw = 1 << (c16 >> 4);
    for (int row = rbeg + (tid >> 6); row < rend; row += 8) {
        int t, n; if (row < ML) { t = row & 4095; n = SEQ; } else { t = (row - ML) & 255; n = CTX; }
        const bf16_t* pr = P + (size_t)row * LDP;
        const u32x2 bg = *(const u32x2*)(pr + 256 + ch), cg = *(const u32x2*)(pr + 512 + ch), xi = *(const u32x2*)(pr + 768 + ch);
        const bool hp = t > 0, hn = t < n - 1;
        const bf16_t* pp = hp ? pr - LDP : pr; const bf16_t* pn = hn ? pr + LDP : pr;
        const u32x2 c0 = *(const u32x2*)(pp + 512 + ch), x0 = *(const u32x2*)(pp + 768 + ch), c2 = *(const u32x2*)(pn + 512 + ch), x2 = *(const u32x2*)(pn + 768 + ch);
        const bf16_t* pq = pr + 1024 + ch;
        u32x2 tap[16];
#pragma unroll
        for (int k = 0; k < 16; ++k) { const int d = k - 8; const bool ok = (d >= -hw) && (d < hw) && (t + d >= 0) && (t + d < n);
            tap[k] = *(const u32x2*)(pq + (ptrdiff_t)(ok ? d : 0) * LDP); if (!ok) tap[k] = (u32x2){0u, 0u}; }
        const u32x2 u0 = *(const u32x2*)pq;
        {
            const f32x4 z = (f32x4){bflo(cg.x) * bflo(xi.x), bfhi(cg.x) * bfhi(xi.x), bflo(cg.y) * bflo(xi.y), bfhi(cg.y) * bfhi(xi.y)};
            const f32x4 zp = (f32x4){bflo(c0.x) * bflo(x0.x), bfhi(c0.x) * bfhi(x0.x), bflo(c0.y) * bflo(x0.y), bfhi(c0.y) * bfhi(x0.y)};
            const f32x4 zn = (f32x4){bflo(c2.x) * bflo(x2.x), bfhi(c2.x) * bfhi(x2.x), bflo(c2.y) * bflo(x2.y), bfhi(c2.y) * bfhi(x2.y)};
            const f32x4 y = z * cw1 + zp * (hp ? cw0 : cw0 * 0.f) + zn * (hn ? cw2 : cw2 * 0.f);
            u32x2 w; w.x = cvt_pk_bf16(bflo(bg.x) * y[0], bfhi(bg.x) * y[1]); w.y = cvt_pk_bf16(bflo(bg.y) * y[2], bfhi(bg.y) * y[3]);
            *(u32x2*)(MIX + (size_t)row * DM + 256 + ch) = w;
        }
        {
            f32x4 sacc = (f32x4){0.f, 0.f, 0.f, 0.f};
#pragma unroll
            for (int k = 0; k < 16; ++k) sacc += (f32x4){bflo(tap[k].x), bfhi(tap[k].x), bflo(tap[k].y), bfhi(tap[k].y)};
            const int lo = max(t - hw, 0), hi = min(t + hw - 1, n - 1);
            const float ic = 1.0f / (float)(hi - lo + 1);
            u32x2 w; w.x = cvt_pk_bf16(sacc[0] * ic - bflo(u0.x), sacc[1] * ic - bfhi(u0.x)); w.y = cvt_pk_bf16(sacc[2] * ic - bflo(u0.y), sacc[3] * ic - bfhi(u0.y));
            *(u32x2*)(POOLIN + (size_t)row * 256 + ch) = w;
        }
    }
}

__device__ __forceinline__ void phase_dft_combine(unsigned char* ws, int tid, int lane, int wave, const int BX, const int G) {
    const GAS float* PT = (const GAS float*)(ws + WS_PT); const GAS float* QT = (const GAS float*)(ws + WS_QT);
    GAS bf16_t* MIX = (GAS bf16_t*)(ws + WS_MIX);
    const int gt = BX * 512 + tid, NGT = G * 512;
    for (int i = gt; i < 2048 * 512; i += NGT) {
        const int r = i >> 9, col = (i & 511) * 8, b = col >> 8, n = col & 255, k1 = r + 1;
        const f32x4 p0 = *(const GAS f32x4*)(PT + (size_t)r * 4096 + col), p1 = *(const GAS f32x4*)(PT + (size_t)r * 4096 + col + 4);
        const f32x4 q0 = *(const GAS f32x4*)(QT + (size_t)r * 4096 + col), q1 = *(const GAS f32x4*)(QT + (size_t)r * 4096 + col + 4);
        const float sc = 1.f / 512.f;
        *(gv4p)(MIX + (size_t)(b * SEQ + k1) * DM + n) = pack8((p0 - q0) * sc, (p1 - q1) * sc);
        *(gv4p)(MIX + (size_t)(b * SEQ + 4096 - k1) * DM + n) = pack8((p0 + q0) * sc, (p1 + q1) * sc);
    }
    const GAS bf16_t* UT = (const GAS bf16_t*)(ws + WS_UT);
    const int gw = BX * 8 + wave, NGW = G * 8;
    for (int rowi = gw; rowi < 4096; rowi += NGW) {
        const GAS u32x4* src = (const GAS u32x4*)(UT + (size_t)rowi * 8192) + lane;
        float sacc = 0.f;
#pragma unroll
        for (int c = 0; c < 8; ++c) { const u32x4 w = src[c * 64]; sacc += (bflo(w.x) + bfhi(w.x)) + (bflo(w.y) + bfhi(w.y)) + (bflo(w.z) + bfhi(w.z)) + (bflo(w.w) + bfhi(w.w)); }
        sacc = wave_sum(sacc, lane);
        if (lane == 0) { const int b = rowi >> 8, n = rowi & 255; MIX[(size_t)(b * SEQ) * DM + n] = (bf16_t)f2bf(sacc * (1.f / 512.f)); }
    }
}

constexpr int KROW = 208, VROW = 144, KBUF = 64 * KROW, VBUF = 64 * VROW, ABUF = KBUF + VBUF;
__device__ __forceinline__ void attn_unit(LAS unsigned char* lds, const bf16_t* Qb, const bf16_t* Kb, const bf16_t* Vtb, int nk, bf16_t* Ob, bool rope, int tok0, const int tid, const float* ropetab) {
    const int lane = tid & 63, r = lane & 31, hi = lane >> 5, wid = tid >> 6;
    bf16x8 qf[6];
    const bf16_t* qrow = Qb + (size_t)(wid * 32 + r) * 384 + 8 * hi;
#pragma unroll
    for (int d0 = 0; d0 < 6; ++d0) qf[d0] = *(const bf16x8*)(qrow + d0 * 16);
    if (rope) {
        const int t = tok0 + wid * 32 + r;
#pragma unroll
        for (int d0 = 4; d0 < 6; ++d0) {
            const int ipos = d0 == 4 ? (t >> 6) : (t & 63);
            bf16x8 o;
#pragma unroll
            for (int j = 0; j < 8; ++j) {
                const float own = bf1((bf16_t)qf[d0][j]);
                const float partner = shx(own, 32, lane);
                const f32x2 csn = *(const GAS f32x2*)(ropetab + (ipos * 8 + j) * 2); const float cs = csn[0], sn = csn[1];
                o[j] = (short)f2bf(own * cs + (hi ? partner : -partner) * sn);
            }
            qf[d0] = o;
        }
    }
    const int kc0 = tid, kc1 = tid + 512;
    const int kr0 = kc0 / 12, kcc0 = kc0 % 12, kr1 = kc1 / 12, kcc1 = kc1 % 12;
    const bool k1v = kc1 < 768;
    const int vr = tid >> 3, vcc = tid & 7;
    const bf16_t* kg0 = Kb + (size_t)kr0 * QKD + kcc0 * 8;
    const bf16_t* kg1 = Kb + (size_t)kr1 * QKD + kcc1 * 8;
    const bf16_t* vg = Vtb + (size_t)vr * NKEY + vcc * 8;
    const int kl0 = kr0 * KROW + kcc0 * 16, kl1 = kr1 * KROW + kcc1 * 16, vl = KBUF + vr * VROW + vcc * 16;
    const int NT = nk >> 6;
    u32x4 sk0, sk1 = (u32x4){0u, 0u, 0u, 0u}, sv;
    sk0 = *(const u32x4*)kg0; if (k1v) sk1 = *(const u32x4*)kg1; sv = *(const u32x4*)vg;
    *(LAS u32x4*)(lds + kl0) = sk0; if (k1v) *(LAS u32x4*)(lds + kl1) = sk1; *(LAS u32x4*)(lds + vl) = sv;
    __syncthreads();
    f32x16 ot0, ot1;
#pragma unroll
    for (int i = 0; i < 16; ++i) { ot0[i] = 0.f; ot1[i] = 0.f; }
    float m_run = -1e30f, l_run = 0.f;
    for (int tI = 0; tI < NT; ++tI) {
        LAS unsigned char* cur = lds + (tI & 1) * ABUF;
        LAS unsigned char* nxt = lds + ((tI + 1) & 1) * ABUF;
        const bool more = tI + 1 < NT;
        if (more) { const size_t ko = (size_t)(tI + 1) * 64 * QKD; sk0 = *(const u32x4*)(kg0 + ko); if (k1v) sk1 = *(const u32x4*)(kg1 + ko); sv = *(const u32x4*)(vg + (tI + 1) * 64); }
        f32x16 s0, s1;
#pragma unroll
        for (int i = 0; i < 16; ++i) { s0[i] = 0.f; s1[i] = 0.f; }
        __builtin_amdgcn_s_setprio(1);
#pragma unroll
        for (int d0 = 0; d0 < 6; ++d0) {
            const bf16x8 a0 = *(const LAS bf16x8*)(cur + r * KROW + d0 * 32 + hi * 16);
            const bf16x8 a1 = *(const LAS bf16x8*)(cur + (32 + r) * KROW + d0 * 32 + hi * 16);
            s0 = __builtin_amdgcn_mfma_f32_32x32x16_bf16(a0, qf[d0], s0, 0, 0, 0);
            s1 = __builtin_amdgcn_mfma_f32_32x32x16_bf16(a1, qf[d0], s1, 0, 0, 0);
        }
        __builtin_amdgcn_s_setprio(0);
        float mx = s0[0];
#pragma unroll
        for (int i = 1; i < 16; ++i) mx = fmaxf(mx, s0[i]);
#pragma unroll
        for (int i = 0; i < 16; ++i) mx = fmaxf(mx, s1[i]);
        mx = fmaxf(mx, shx(mx, 32, lane));
        const float m_new = fmaxf(m_run, mx);
        const float alpha = __builtin_amdgcn_exp2f(m_run - m_new);
        m_run = m_new;
        float ps = 0.f;
#pragma unroll
        for (int i = 0; i < 16; ++i) { s0[i] = __builtin_amdgcn_exp2f(s0[i] - m_new); s1[i] = __builtin_amdgcn_exp2f(s1[i] - m_new); ps += s0[i] + s1[i]; }
        l_run = l_run * alpha + ps;
#pragma unroll
        for (int i = 0; i < 16; ++i) { ot0[i] *= alpha; ot1[i] *= alpha; }
        bf16x8 pb[4];
#pragma unroll
        for (int s = 0; s < 4; ++s) {
            u32x4 w;
            if (s < 2) { w.x = cvt_pk_bf16(s0[8 * s + 0], s0[8 * s + 1]); w.y = cvt_pk_bf16(s0[8 * s + 2], s0[8 * s + 3]); w.z = cvt_pk_bf16(s0[8 * s + 4], s0[8 * s + 5]); w.w = cvt_pk_bf16(s0[8 * s + 6], s0[8 * s + 7]); }
            else { const int q = s - 2; w.x = cvt_pk_bf16(s1[8 * q + 0], s1[8 * q + 1]); w.y = cvt_pk_bf16(s1[8 * q + 2], s1[8 * q + 3]); w.z = cvt_pk_bf16(s1[8 * q + 4], s1[8 * q + 5]); w.w = cvt_pk_bf16(s1[8 * q + 6], s1[8 * q + 7]); }
            pb[s] = __builtin_bit_cast(bf16x8, w);
        }
#pragma unroll
        for (int s = 0; s < 4; ++s) {
            const int ko = (16 * s + 8 * hi) * 2;
            const bf16x8 a0 = *(const LAS bf16x8*)(cur + KBUF + r * VROW + ko), a1 = *(const LAS bf16x8*)(cur + KBUF + (32 + r) * VROW + ko);
            __builtin_amdgcn_s_setprio(1);
            ot0 = __builtin_amdgcn_mfma_f32_32x32x16_bf16(a0, pb[s], ot0, 0, 0, 0);
            ot1 = __builtin_amdgcn_mfma_f32_32x32x16_bf16(a1, pb[s], ot1, 0, 0, 0);
            __builtin_amdgcn_s_setprio(0);
        }
        if (more) { *(LAS u32x4*)(nxt + kl0) = sk0; if (k1v) *(LAS u32x4*)(nxt + kl1) = sk1; *(LAS u32x4*)(nxt + vl) = sv; }
        __syncthreads();
    }
    const float lt = l_run + shx(l_run, 32, lane);
    const float il = 1.0f / lt;
    bf16_t* orow = Ob + (size_t)(wid * 32 + r) * DM;
#pragma unroll
    for (int g = 0; g < 4; ++g) {
        u32x2 w0, w1;
        w0.x = cvt_pk_bf16(ot0[4 * g] * il, ot0[4 * g + 1] * il); w0.y = cvt_pk_bf16(ot0[4 * g + 2] * il, ot0[4 * g + 3] * il);
        w1.x = cvt_pk_bf16(ot1[4 * g] * il, ot1[4 * g + 1] * il); w1.y = cvt_pk_bf16(ot1[4 * g + 2] * il, ot1[4 * g + 3] * il);
        *(u32x2*)(orow + 8 * g + 4 * hi) = w0;
        *(u32x2*)(orow + 32 + 8 * g + 4 * hi) = w1;
    }
}
__device__ __forceinline__ void phase_attention(LAS unsigned char* lds, unsigned char* ws, bool with_ctx, const int tid, const int bx, const int G) {
    const int vcu = (G % 8 == 0) ? (bx % 8) * (G / 8) + bx / 8 : bx;
    const bf16_t* Q = (const bf16_t*)(ws + WS_Q); const bf16_t* Qc = (const bf16_t*)(ws + WS_QC);
    const bf16_t* Kc = (const bf16_t*)(ws + WS_KC); const bf16_t* Vt = (const bf16_t*)(ws + WS_VT);
    bf16_t* MIX = (bf16_t*)(ws + WS_MIX);
    const int nunits = 1024 + (with_ctx ? 64 : 0);
    for (int u = vcu; u < nunits; u += G) {
        if (u < 1024) {
            const int bh = u >> 4, qb = u & 15, b = bh >> 2, h = bh & 3;
            attn_unit(lds, Q + (size_t)(b * SEQ + qb * 256) * 384 + h * QKD, Kc + (size_t)bh * NKEY * QKD, Vt + (size_t)bh * 64 * NKEY, NKEY,
                      MIX + (size_t)(b * SEQ + qb * 256) * DM + 768 + h * 64, true, qb * 256, tid, (const float*)(ws + WS_ROPE));
        } else {
            const int bh = u - 1024, b = bh >> 2, h = bh & 3;
            attn_unit(lds, Qc + (size_t)(b * CTX) * 384 + h * QKD, Kc + (size_t)bh * NKEY * QKD, Vt + (size_t)bh * 64 * NKEY, CTX,
                      MIX + (size_t)(ML + b * CTX) * DM + 768 + h * 64, false, 0, tid, (const float*)(ws + WS_ROPE));
        }
    }
}

struct Job { pg8::Gemm g; Epi e; };
__device__ __forceinline__ bool get_job(KArgs ap, unsigned char* ws, float* outp, int l, int kind, int j, Job& J) {
    unsigned char* wl = ws + (size_t)l * WL;
    const int Mx = l == 0 ? MT : ML;
    bf16_t* P = (bf16_t*)(ws + WS_P); bf16_t* MIX = (bf16_t*)(ws + WS_MIX); bf16_t* H = (bf16_t*)(ws + WS_H);
    const float* rq = (const float*)(ws + WS_RQ); const float* rkv = (const float*)(ws + WS_RKV);
    const float* mod = (const float*)(ws + WS_MOD) + (size_t)l * 17 * 6144;
    float* xc = (float*)(ws + WS_XC);
    J.e.e = EpiArgs{nullptr, nullptr, nullptr, nullptr, nullptr, nullptr, 0, 0};
    if (kind == 0) { if (j) return false;
        J.g = pg8::Gemm{H, (const bf16_t*)(wl + O_WIN), MT, LDP, DM, DM, DM}; J.e.mode = l == 0 ? M_P : M_PS; J.e.e.o0 = P; J.e.e.ld = LDP;
        J.e.e.f0 = (const float*)(ws + WS_RSS + 2 * RSS_STRIDE); J.e.e.f1 = (const float*)(ws + WS_VEC) + V_CB1; J.e.e.goff = LDP; return true; }
    if (kind == 1) { if (j) return false;
        J.g = pg8::Gemm{(const bf16_t*)(wl + O_WF), P, 512, Mx, 256, 256, LDP}; J.e.mode = M_UT; J.e.e.o0 = (bf16_t*)(ws + WS_UT); J.e.e.o1 = (bf16_t*)(ws + WS_UTC); return true; }
    if (kind == 2) {
        switch (j) {
            case 0: J.g = pg8::Gemm{(const bf16_t*)(ws + WS_DFT), (const bf16_t*)(ws + WS_UT), 2048, 4096, 4096, 4096, 8192}; J.e.mode = M_F32; J.e.e.o0 = (bf16_t*)(ws + WS_PT); return true;
            case 6: J.g = pg8::Gemm{(const bf16_t*)(ws + WS_DFT) + (size_t)2048 * 4096, (const bf16_t*)(ws + WS_UT) + 4096, 2048, 4096, 4096, 4096, 8192}; J.e.mode = M_F32; J.e.e.o0 = (bf16_t*)(ws + WS_QT); return true;
            case 1: J.g = pg8::Gemm{P + 1280, (const bf16_t*)(wl + O_WUQ), Mx, 512, 256, LDP, 256}; J.e.mode = M_Q; J.e.e.o0 = (bf16_t*)(ws + WS_Q); J.e.e.o1 = (bf16_t*)(ws + WS_QC); J.e.e.f0 = rq; return true;
            case 2: J.g = pg8::Gemm{P + 1536, (const bf16_t*)(wl + O_WK), MT, 256, 128, LDP, 128}; J.e.mode = M_K; J.e.e.o0 = (bf16_t*)(ws + WS_KC); J.e.e.f0 = rkv; return true;
            case 3: J.g = pg8::Gemm{(const bf16_t*)(wl + O_WV), P + 1536, 256, MT, 128, 128, LDP}; J.e.mode = M_VT; J.e.e.o0 = (bf16_t*)(ws + WS_VT); J.e.e.f0 = rkv; return true;
            case 4: J.g = pg8::Gemm{(const bf16_t*)(ws + WS_POOLIN), (const bf16_t*)(wl + O_POOL), Mx, 256, 256, 256, 256}; J.e.mode = M_POOL; J.e.e.o0 = MIX; J.e.e.f0 = ap->in[12] + l * 256; return true;
            case 5: if (l != 0) return false;
                J.g = pg8::Gemm{(const bf16_t*)(ws + WS_DFTC), (const bf16_t*)(ws + WS_UTC), 256, 4096, 512, 512, 512}; J.e.mode = M_DFTC; J.e.e.o0 = MIX; return true;
            default: return false;
        }
    }
    if (kind == 4 || kind == 7) { if (j) return false;
        if (kind == 4) J.g = pg8::Gemm{MIX, (const bf16_t*)(wl + O_WOUT), Mx, DM, DM, DM, DM};
        else J.g = pg8::Gemm{(const bf16_t*)(ws + WS_ACT), (const bf16_t*)(wl + O_W2), Mx, DM, DFF, DFF, DFF};
        J.e.mode = M_RES; J.e.e.o1 = (bf16_t*)mod; J.e.e.goff = kind == 4 ? 2048 : 5120;
        J.e.e.f0 = (l == 0 && kind == 4) ? ap->in[0] : outp; J.e.e.f1 = (l == 0 && kind == 4) ? ap->in[2] : xc; J.e.e.x0 = outp; J.e.e.x1 = xc;
        J.e.e.ld = kind == 4 ? 1 + l : (l == 0 ? 3 : 0); return true; }
    if (kind == 6) { if (j) return false;
        J.g = pg8::Gemm{H, (const bf16_t*)(wl + O_W1), Mx, DFF, DM, DM, DM}; J.e.mode = M_RELU2; J.e.e.o0 = (bf16_t*)(ws + WS_ACT); J.e.e.ld = DFF;
        J.e.e.f0 = (const float*)(ws + WS_RSS + (size_t)l * RSS_STRIDE); J.e.e.f1 = (const float*)(ws + WS_VEC) + V_CB2 + l * 17 * 4096; J.e.e.goff = DFF; return true; }
    return false;
}

#define XB_TMO      128
#define XB_XCNT(j)  (256  + 64 * (j))
#define XB_XSUB(j)  (1280 + 64 * (j))
#define XB_XGEN(j)  (2304 + 64 * (j))
#define XB_TOP      3328
#define XB_TOPGEN   3392
#define XCD_BAR_WORDS 3456
#define XB_SPIN_CAP (1u << 18)
__device__ __forceinline__ unsigned xb_ld(unsigned* p)              { return __hip_atomic_load(p, __ATOMIC_RELAXED, __HIP_MEMORY_SCOPE_AGENT); }
__device__ __forceinline__ unsigned xb_add(unsigned* p, unsigned v) { return __hip_atomic_fetch_add(p, v, __ATOMIC_RELAXED, __HIP_MEMORY_SCOPE_AGENT); }
__device__ __forceinline__ unsigned xb_xcc_id() { return (unsigned)__builtin_amdgcn_s_getreg((3 << 11) | 20) & 0xFu; }
#define XB_SPIN(cond, bar) do { unsigned _sp = 0; while (cond) { __builtin_amdgcn_s_sleep(1); \
    if ((++_sp & 255u) == 0u) { if (xb_ld(&(bar)[XB_TMO])) break; if (_sp > XB_SPIN_CAP) { atomicAdd(&(bar)[XB_TMO], 1u); break; } } } } while (0)
struct XcdBarrier { unsigned* bar; unsigned x; volatile LAS unsigned* st; };
__device__ __forceinline__ XcdBarrier xcd_barrier_post(unsigned* bar, volatile LAS unsigned* st) {
    XcdBarrier b; b.bar = bar; b.x = xb_xcc_id(); b.st = st;
    if (threadIdx.x == 0) (void)xb_add(&bar[XB_XCNT(b.x)], 1u);
    return b;
}
__device__ __forceinline__ void xcd_barrier_complete(unsigned* bar, unsigned x, unsigned& nloc, unsigned& nx) {
    const unsigned G = gridDim.x * gridDim.y * gridDim.z;
    unsigned sum, cnt, mine, sp = 0u;
    for (;;) {
        sum = 0u; cnt = 0u; mine = 0u;
#pragma unroll
        for (unsigned j = 0; j < 16; ++j) { const unsigned c = xb_ld(&bar[XB_XCNT(j)]); sum += c; cnt += (c > 0u) ? 1u : 0u; mine = (j == x) ? c : mine; }
        if (sum == G) break;
        __builtin_amdgcn_s_sleep(1);
        if ((++sp & 255u) == 0u) { if (xb_ld(&bar[XB_TMO])) break; if (sp > XB_SPIN_CAP) { atomicAdd(&bar[XB_TMO], 1u); break; } }
    }
    nloc = mine > 0u ? mine : 1u; nx = cnt > 0u ? cnt : 1u;
}
__device__ __forceinline__ void xcd_barrier(const XcdBarrier& b) {
    asm volatile("s_waitcnt vmcnt(0)" ::: "memory");
    __syncthreads();
    if (threadIdx.x == 0) {
        unsigned* bar = b.bar;
        __builtin_amdgcn_s_waitcnt(0);
        unsigned nloc = b.st[0], nx = b.st[1];
        if (nloc == 0u) { xcd_barrier_complete(bar, b.x, nloc, nx); b.st[0] = nloc; b.st[1] = nx; }
        const unsigned old = xb_add(&bar[XB_XSUB(b.x)], 1u);
        const unsigned gen = old / nloc;
        if (old + 1u == (gen + 1u) * nloc) {
            __builtin_amdgcn_fence(__ATOMIC_RELEASE, "agent");
            asm volatile("s_waitcnt vmcnt(0)" ::: "memory");
            const unsigned og = xb_add(&bar[XB_TOP], 1u);
            const unsigned tg = og / nx;
            if (og + 1u == (tg + 1u) * nx) xb_add(&bar[XB_TOPGEN], 1u);
            else XB_SPIN(xb_ld(&bar[XB_TOPGEN]) == tg, bar);
            __builtin_amdgcn_fence(__ATOMIC_ACQUIRE, "agent");
            xb_add(&bar[XB_XGEN(b.x)], 1u);
            asm volatile("s_waitcnt vmcnt(0)" ::: "memory");
        } else {
            XB_SPIN(xb_ld(&bar[XB_XGEN(b.x)]) == gen, bar);
            __builtin_amdgcn_fence(__ATOMIC_ACQUIRE, "agent");
            asm volatile("s_waitcnt vmcnt(0)" ::: "memory");
        }
    }
    __syncthreads();
}

constexpr int LDS_BYTES = 147456;
constexpr int N_PHASES = 2 + 9 * 2;
template <int PH> __device__ __forceinline__ void run_phase(LAS unsigned char* lds) {
    int tid = threadIdx.x; asm volatile("" : "+v"(tid));
    int BX = blockIdx.x, G = gridDim.x; asm volatile("" : "+s"(BX), "+s"(G));
    const int lane = tid & 63, wave = __builtin_amdgcn_readfirstlane(tid >> 6);
    KArgs ap = (KArgs)__builtin_amdgcn_kernarg_segment_ptr(); asm volatile("" : "+s"(ap));
    unsigned char* ws = ap->ws; float* outp = ap->out;
    if constexpr (PH == 0) {
        phase_setup(ap, ws, lds, tid, lane, wave, BX, G);
    } else if constexpr (PH == 1) {
        phase_vectors(ap, ws, lds, tid, lane, wave, BX, G);
        phase_norm_mod(ap->in[0], ap->in[2], ap->in[6], (const float*)(ws + WS_MOD), 0, 1024, (bf16_t*)(ws + WS_H), MT, lane, wave, BX, G);
    } else {
        constexpr int l = (PH - 2) / 9, kind = (PH - 2) % 9;
        const float* mod = (const float*)(ws + WS_MOD) + (size_t)l * 17 * 6144;
        if constexpr (kind == 1) phase_token_local((const bf16_t*)(ws + WS_P), (float*)(ws + WS_RQ), (float*)(ws + WS_RKV), (bf16_t*)(ws + WS_KC), (bf16_t*)(ws + WS_MIX), (bf16_t*)(ws + WS_POOLIN), ap->in[10] + l * 768, (const float*)(ws + WS_ROPE), tid, lane, wave, BX, G);
        if constexpr (kind == 3) { phase_dft_combine(ws, tid, lane, wave, BX, G); phase_attention(lds, ws, l == 0, tid, BX, G); }
        else if constexpr (kind == 5) { }
        else if constexpr (kind == 8) {
            if constexpr (l == 0) { }
            else phase_final_norm(outp, ap->in[20], lane, wave, BX, G);
        } else {
            Job J; int lr = l, kr = kind; asm volatile("" : "+s"(lr), "+s"(kr));
            for (int j = 0;; ++j) {
                KArgs ap2 = ap; unsigned char* ws2 = ws; float* out2 = outp; int tid2 = tid, BX2 = BX, G2 = G;
                asm volatile("" : "+s"(ap2), "+s"(ws2), "+s"(out2), "+v"(tid2), "+s"(BX2), "+s"(G2));
                if (kr == 2 && j > 6) break;
                const int jj = kr == 2 ? (j == 0 ? 0 : j == 1 ? 6 : j - 1) : j;
                if (!get_job(ap2, ws2, out2, lr, kr, jj, J)) break;
                const int rot = kr == 2 ? (jj == 6 ? 128 : jj == 2 ? 32 : jj == 3 ? 48 : jj == 4 ? 64 : jj == 5 ? 80 : 0) : 0;
                pg8::StaticOrder S; S.init(J.g.M, J.g.N, G2, (BX2 + rot) % G2);
                pg8::gemm_phase<Epi>(lds, J.g, S, J.e, tid2);
            }
        }
    }
}
__global__ void __launch_bounds__(512, 2) fwd_megakernel(Args a) {
    extern __shared__ __attribute__((aligned(16))) unsigned char lds_raw[];
    LAS unsigned char* lds = (LAS unsigned char*)lds_raw;
    cg::grid_group grid = cg::this_grid();
    const int ph_lo = a.ph_lo, ph_hi = a.ph_hi;
    for (int u = threadIdx.x; u < (LDS_BYTES - 131072) / 4; u += 512) ((LAS unsigned*)(lds + 131072))[u] = 0u;
    __syncthreads();
    const XcdBarrier bar = xcd_barrier_post((unsigned*)(a.ws + WS_CTL), (volatile LAS unsigned*)(lds + 131072 + 64));
#ifndef EXP_SYNC
#define EXP_SYNC 0
#endif
#ifndef EXP_REP
#define EXP_REP(k) 0
#endif
#define PH_EMPTY(k) ((k) == 7 || (k) == 16 || (k) == 10)
#define PHASE(k) if (!PH_EMPTY(k) && ph_lo <= (k) && (k) < ph_hi) { run_phase<k>(lds); if (EXP_REP(k)) { grid.sync(); run_phase<k>(lds); } if ((k) + 1 < ph_hi) { if ((k) == 0) grid.sync(); else xcd_barrier(bar); if (EXP_SYNC) xcd_barrier(bar); } }
    PHASE(0) PHASE(1) PHASE(2) PHASE(3) PHASE(4) PHASE(5) PHASE(6) PHASE(7) PHASE(8) PHASE(9) PHASE(10)
    PHASE(11) PHASE(12) PHASE(13) PHASE(14) PHASE(15) PHASE(16) PHASE(17) PHASE(18) PHASE(19)
#undef PHASE
}

#ifndef MK_MULTI_LAUNCH
#define MK_MULTI_LAUNCH 0
#endif
extern "C" void kernel_launch(void* const* d_in, const int* in_sizes, int n_in, void* d_out, int out_size, void* d_ws, size_t ws_size, hipStream_t stream) {
    static int grid = 0;
    if (grid == 0) {
        int dev = 0, cus = 0, per_cu = 0;
        hipGetDevice(&dev);
        hipDeviceGetAttribute(&cus, hipDeviceAttributeMultiprocessorCount, dev);
        hipFuncSetAttribute((const void*)fwd_megakernel, hipFuncAttributeMaxDynamicSharedMemorySize, LDS_BYTES);
        hipOccupancyMaxActiveBlocksPerMultiprocessor(&per_cu, (const void*)fwd_megakernel, 512, LDS_BYTES);
        (void)hipGetLastError();
        if (cus <= 0) cus = 256;
        grid = cus;
        if (per_cu < 1) fprintf(stderr, "kernel_launch: occupancy query says %d blocks/CU\n", per_cu);
        if (ws_size < WS_END) { fprintf(stderr, "kernel_launch: workspace too small (%zu < %zu)\n", ws_size, (size_t)WS_END); grid = -1; }
    }
    if (grid < 0) return;
    if (hipMemsetAsync((char*)d_ws + WS_CTL, 0, CTL_BYTES, stream) != hipSuccess) { fprintf(stderr, "kernel_launch: memset of barrier words failed\n"); return; }
    Args a{};
    for (int i = 0; i < 21; ++i) a.in[i] = (const float*)d_in[i];
    a.out = (float*)d_out; a.ws = (unsigned char*)d_ws;
#if MK_MULTI_LAUNCH
    for (int ph = 0; ph < N_PHASES; ++ph) { a.ph_lo = ph; a.ph_hi = ph + 1; hipLaunchKernelGGL(fwd_megakernel, dim3(grid), dim3(512), LDS_BYTES, stream, a); }
#else
    a.ph_lo = 0; a.ph_hi = N_PHASES;
    void* args[] = {&a};
    hipError_t e = hipLaunchCooperativeKernel((const void*)fwd_megakernel, dim3(grid), dim3(512), args, LDS_BYTES, stream);
    if (e != hipSuccess) fprintf(stderr, "cooperative launch failed: %s (grid %d)\n", hipGetErrorString(e), grid);
#endif
}
```

```cpp
#include <hip/hip_runtime.h>
#include <hip/hip_cooperative_groups.h>
#include <cstdio>
#include <cstdint>
namespace cg = cooperative_groups;

#define LAS __attribute__((address_space(3)))
typedef unsigned short bf16_t;
typedef short bf16x8 __attribute__((ext_vector_type(8)));
typedef short s16x4 __attribute__((ext_vector_type(4)));
typedef float f32x4 __attribute__((ext_vector_type(4)));
typedef float f32x2 __attribute__((ext_vector_type(2)));
typedef float f32x16 __attribute__((ext_vector_type(16)));
typedef unsigned u32x4 __attribute__((ext_vector_type(4)));
typedef unsigned u32x2 __attribute__((ext_vector_type(2)));

constexpr int NB = 16, SEQ = 4096, DM = 1024, CTX = 256, ML = NB * SEQ, MC = NB * CTX, MT = ML + MC;
constexpr int LDP = 1792, DFF = 4096, NKEY = SEQ + CTX, NHEAD = 4, QKD = 96;
constexpr float EPS = 1e-6f;
constexpr float QSCALE = 0.10206207261596577f * 1.4426950408889634f;

constexpr size_t MiB = 1u << 20;
constexpr size_t WL = 24 * MiB;
constexpr size_t O_WIN = 0, O_WOUT = 3670016, O_W1 = 5767168, O_W2 = 14155776, O_WUQ = 22544384, O_WK = 22806528, O_WV = 22872064, O_WF = 22937600, O_POOL = 23199744;
constexpr size_t WS_CTL = 48 * MiB + 832 * 1024, CTL_BYTES = 16384;
constexpr size_t WS_MOD = 48 * MiB, WS_RQ = 49 * MiB, WS_RKV = 49 * MiB + 512 * 1024, WS_DFTC = 50 * MiB, WS_DFT = 51 * MiB, WS_XC = 115 * MiB, WS_H = 131 * MiB, WS_OV = 267 * MiB;
constexpr size_t WS_P = WS_OV, WS_MIX = WS_OV + 238 * MiB, WS_UT = WS_OV + 374 * MiB, WS_UTC = WS_OV + 438 * MiB, WS_Q = WS_OV + 442 * MiB, WS_QC = WS_OV + 490 * MiB,
                 WS_KC = WS_OV + 493 * MiB, WS_VT = WS_OV + 544 * MiB, WS_POOLIN = WS_OV + 578 * MiB, WS_ACT = WS_OV, WS_RSS = WS_OV + 613 * MiB, RSS_STRIDE = 512 * 1024, WS_VEC = WS_OV + 615 * MiB, WS_PT = WS_OV + 617 * MiB, WS_QT = WS_OV + 649 * MiB, WS_END = WS_OV + 681 * MiB;
constexpr size_t WS_ROPE = WS_VEC + 1 * MiB;
constexpr int V_GN2 = 0, V_CB2 = 2 * 17 * 1024, V_GN1 = V_CB2 + 2 * 17 * 4096, V_CB1 = V_GN1 + 17 * 1024;

__device__ __forceinline__ unsigned cvt_pk_bf16(float lo, float hi) { unsigned r; asm volatile("v_cvt_pk_bf16_f32 %0, %1, %2" : "=v"(r) : "v"(lo), "v"(hi)); return r; }
__device__ __forceinline__ unsigned f2bf(float f) { unsigned u = __builtin_bit_cast(unsigned, f); return (u + 0x7fffu + ((u >> 16) & 1u)) >> 16; }
__device__ __forceinline__ unsigned pk2(float lo, float hi) { return f2bf(lo) | (f2bf(hi) << 16); }
__device__ __forceinline__ float bflo(unsigned w) { return __uint_as_float(w << 16); }
__device__ __forceinline__ float bfhi(unsigned w) { return __uint_as_float(w & 0xffff0000u); }
__device__ __forceinline__ float bf1(bf16_t b) { return __uint_as_float((unsigned)b << 16); }
__device__ __forceinline__ float shx(float v, int mask, int lane) { return __builtin_bit_cast(float, __builtin_amdgcn_ds_bpermute((lane ^ mask) << 2, __builtin_bit_cast(int, v))); }
__device__ __forceinline__ float wave_sum(float v, int lane) {
#pragma unroll
    for (int o = 1; o < 64; o <<= 1) v += shx(v, o, lane);
    return v;
}
__device__ __forceinline__ float invfreq(int j) {
    return j == 0 ? 1.0f : j == 1 ? 0.31622776601683794f : j == 2 ? 0.1f : j == 3 ? 0.031622776601683794f : j == 4 ? 0.01f : j == 5 ? 0.0031622776601683794f : j == 6 ? 0.001f : 0.00031622776601683794f;
}

namespace pg8 {
constexpr int BM = 256, BK = 64, HALF = 128, HTB = HALF * BK * 2, STAGE_BYTES = 8 * HTB, NXCD = 8, WGM = 8;
__host__ __device__ __forceinline__ int lds_byte(int r, int c) { const int st = (r >> 4) * 2 + (c >> 5), rr = r & 15, cc = c & 31, ob = rr * 64 + cc * 2; return st * 1024 + (ob ^ (((ob >> 9) & 1) << 5)); }
__host__ __device__ __forceinline__ void stage_rc(int b, int& R, int& C) { const int st = b / 1024, sb = b % 1024, swz = sb ^ (((sb >> 9) & 1) << 5); R = (st >> 1) * 16 + swz / 64; C = (st & 1) * 32 + (swz % 64) / 2; }
__host__ __device__ __forceinline__ int perm32(int rho) { const int n = rho >> 4, i = rho & 15; return 8 * (i >> 2) + 4 * n + (i & 3); }
struct Unit { int pm, pn; };
__device__ __forceinline__ const char* uptr(const char* p) { const unsigned long long v = (unsigned long long)p; const unsigned lo = __builtin_amdgcn_readfirstlane((unsigned)v), hi = __builtin_amdgcn_readfirstlane((unsigned)(v >> 32)); return (const char*)(((unsigned long long)hi << 32) | lo); }
struct Gemm { const bf16_t* A; const bf16_t* Bt; int M, N, K, lda, ldb; };
struct StaticOrder {
    int nM, nN, nwg, G, c;
    __device__ void init(int M, int N, int G_, int c_) { nM = M / BM; nN = N / BM; nwg = nM * nN; G = G_; c = c_; }
    __device__ bool next(int i, Unit& u) const {
        const long L = (long)i * G + c; if (L >= nwg) return false;
        int wgid = (int)L; { const int q = nwg / NXCD, r = nwg % NXCD, xcd = wgid % NXCD, off = wgid / NXCD; wgid = (xcd < r ? xcd * (q + 1) : r * (q + 1) + (xcd - r) * q) + off; }
        const int nig = WGM * nN, gid = wgid / nig, fm = gid * WGM, gsz = (nM - fm) < WGM ? (nM - fm) : WGM;
        u.pm = fm + ((wgid % nig) % gsz); u.pn = (wgid % nig) / gsz; return true;
    }
};

template <class Epi>
__device__ __forceinline__ void gemm_phase(LAS unsigned char* lds, const Gemm g, const StaticOrder& S, const Epi& E, const int tid) {
    const int wid = __builtin_amdgcn_readfirstlane(tid >> 6), lane = tid & 63, wr = wid >> 2, wc = wid & 3, fr = lane & 15, fq = lane >> 4;
    const int K = g.K, nt = K / BK;
    unsigned voffA[2], voffB[2];
#pragma unroll
    for (int i = 0; i < 2; ++i) { int R, C; stage_rc(tid * 16 + i * 8192, R, C); const int Rb = (R & ~31) + perm32(R & 31);
        voffA[i] = (unsigned)(R * g.lda + C) * 2u; voffB[i] = (unsigned)(Rb * g.ldb + C) * 2u; }
    const size_t kstep = (size_t)(BK * 2);
    const size_t hsA = (size_t)HALF * g.lda * 2, hsB = (size_t)HALF * g.ldb * 2;
    const size_t tsA = 2 * hsA, tsB = 2 * hsB;
    const unsigned ldsw = (unsigned)wid * 1024u;
    const int aoff = lds_byte(wr * 64 + fr, fq * 8), boff = lds_byte(wc * 32 + fr, fq * 8);
#define PG8_SA(b, h) (((b) * 2 + (h)) * HTB)
#define PG8_SB(b, h) ((4 + (b) * 2 + (h)) * HTB)
#define PG8_STAGE(bufoff, gbase, voff) do { const char* _gb = uptr((const char*)(gbase)); _Pragma("unroll") for (int _i = 0; _i < 2; ++_i) \
        __builtin_amdgcn_global_load_lds((const unsigned*)(_gb + (voff)[_i]), (LAS unsigned*)(lds + (bufoff) + ldsw + _i * 8192), 16, 0, 0); } while (0)
#define PG8_LDA(dst, b, h) do { _Pragma("unroll") for (int m = 0; m < 4; ++m) _Pragma("unroll") for (int k = 0; k < 2; ++k) dst[m][k] = *(const LAS bf16x8*)(lds + PG8_SA(b, h) + aoff + m * 2048 + k * 1024); } while (0)
#define PG8_LDB(dst, b, h) do { _Pragma("unroll") for (int n = 0; n < 2; ++n) _Pragma("unroll") for (int k = 0; k < 2; ++k) dst[n][k] = *(const LAS bf16x8*)(lds + PG8_SB(b, h) + boff + n * 2048 + k * 1024); } while (0)
#define PG8_MMA(ai, bj, At, Bt) do { __builtin_amdgcn_s_setprio(1); _Pragma("unroll") for (int m = 0; m < 4; ++m) _Pragma("unroll") for (int n = 0; n < 2; ++n) _Pragma("unroll") for (int k = 0; k < 2; ++k) \
        acc[ai][bj][m][n] = __builtin_amdgcn_mfma_f32_16x16x32_bf16(Bt[n][k], At[m][k], acc[ai][bj][m][n], 0, 0, 0); __builtin_amdgcn_s_setprio(0); } while (0)
#define PG8_WAIT_V(n) asm volatile("s_waitcnt vmcnt(" #n ")" ::: "memory")
#define PG8_WAIT_L(n) asm volatile("s_waitcnt lgkmcnt(" #n ")" ::: "memory")
#define PG8_BAR __builtin_amdgcn_s_barrier()
#define PG8_SCHED __builtin_amdgcn_sched_barrier(0)
    Unit cur, nxt; int ui = 0;
    if (!S.next(0, cur)) return;
    f32x4 acc[2][2][4][2];
#pragma unroll
    for (int a = 0; a < 2; ++a)
#pragma unroll
        for (int b = 0; b < 2; ++b)
#pragma unroll
            for (int m = 0; m < 4; ++m)
#pragma unroll
                for (int n = 0; n < 2; ++n) acc[a][b][m][n] = (f32x4){0.f, 0.f, 0.f, 0.f};
    bf16x8 At[4][2], B0[2][2], B1[2][2];
    const char* cA = (const char*)g.A + (size_t)cur.pm * tsA; const char* cB = (const char*)g.Bt + (size_t)cur.pn * tsB;
    PG8_STAGE(PG8_SB(0, 0), cB, voffB); PG8_STAGE(PG8_SB(0, 1), cB + hsB, voffB); PG8_STAGE(PG8_SA(0, 0), cA, voffA); PG8_STAGE(PG8_SA(0, 1), cA + hsA, voffA);
    if (wr == 1) PG8_BAR;
    PG8_WAIT_V(2); PG8_BAR;
    PG8_STAGE(PG8_SB(1, 0), cB + kstep, voffB); PG8_STAGE(PG8_SA(1, 0), cA + kstep, voffA); PG8_STAGE(PG8_SB(1, 1), cB + hsB + kstep, voffB);
    PG8_WAIT_V(6); PG8_BAR;
    for (;;) {
        const bool has_next = S.next(ui + 1, nxt);
        const char* nA = has_next ? (const char*)g.A + (size_t)nxt.pm * tsA : cA; const char* nB = has_next ? (const char*)g.Bt + (size_t)nxt.pn * tsB : cB;
        for (int t = 0; t < nt; t += 2) {
            const bool last = (t == nt - 2);
            const char* a1 = cA + (size_t)(t + 1) * kstep;
            const char* a2 = last ? nA : cA + (size_t)(t + 2) * kstep; const char* b2 = last ? nB : cB + (size_t)(t + 2) * kstep;
            const char* a3 = a2 + kstep; const char* b3 = b2 + kstep;
            PG8_LDB(B0, 0, 0); PG8_LDB(B1, 0, 1); PG8_SCHED; PG8_LDA(At, 0, 0); PG8_STAGE(PG8_SA(1, 1), a1 + hsA, voffA);
            PG8_WAIT_V(8); PG8_WAIT_L(0); PG8_BAR; PG8_MMA(0, 0, At, B0); PG8_MMA(0, 1, At, B1); PG8_BAR; PG8_SCHED;
            PG8_LDA(At, 0, 1); PG8_STAGE(PG8_SB(0, 0), b2, voffB); PG8_STAGE(PG8_SB(0, 1), b2 + hsB, voffB); PG8_STAGE(PG8_SA(0, 0), a2, voffA);
            PG8_WAIT_V(8); PG8_WAIT_L(0); PG8_BAR; PG8_MMA(1, 0, At, B0); PG8_MMA(1, 1, At, B1); PG8_BAR; PG8_SCHED;
            PG8_LDB(B0, 1, 0); PG8_LDB(B1, 1, 1); PG8_SCHED; PG8_LDA(At, 1, 0); PG8_STAGE(PG8_SA(0, 1), a2 + hsA, voffA);
            PG8_WAIT_V(8); PG8_WAIT_L(0); PG8_BAR; PG8_MMA(0, 0, At, B0); PG8_MMA(0, 1, At, B1); PG8_BAR; PG8_SCHED;
            PG8_LDA(At, 1, 1); PG8_STAGE(PG8_SB(1, 0), b3, voffB); PG8_STAGE(PG8_SB(1, 1), b3 + hsB, voffB); PG8_STAGE(PG8_SA(1, 0), a3, voffA);
            PG8_WAIT_V(8); PG8_WAIT_L(0); PG8_BAR; PG8_MMA(1, 0, At, B0); PG8_MMA(1, 1, At, B1); PG8_BAR; PG8_SCHED;
        }
        if (wr == 0) PG8_BAR;
        E(acc, cur, wr, wc, fr, fq);
        if (!has_next) break;
#pragma unroll
        for (int a = 0; a < 2; ++a)
#pragma unroll
            for (int b = 0; b < 2; ++b)
#pragma unroll
                for (int m = 0; m < 4; ++m)
#pragma unroll
                    for (int n = 0; n < 2; ++n) acc[a][b][m][n] = (f32x4){0.f, 0.f, 0.f, 0.f};
        cur = nxt; cA = nA; cB = nB; ++ui;
        if (wr == 1) PG8_BAR;
    }
    PG8_WAIT_V(0);
    PG8_BAR;
#undef PG8_SA
#undef PG8_SB
#undef PG8_STAGE
#undef PG8_LDA
#undef PG8_LDB
#undef PG8_MMA
#undef PG8_WAIT_V
#undef PG8_WAIT_L
#undef PG8_BAR
#undef PG8_SCHED
}
}

enum { M_P = 0, M_UT = 1, M_Q = 2, M_K = 3, M_VT = 4, M_POOL = 5, M_DFT = 6, M_DFTC = 7, M_RES = 8, M_RELU2 = 9, M_PS = 10, M_F32 = 11 };
struct EpiArgs {
    bf16_t* o0; bf16_t* o1;
    const float* f0; const float* f1;
    float* x0; float* x1;
    int ld; int goff;
};
__device__ __forceinline__ u32x4 pack8(const f32x4& a, const f32x4& b) { u32x4 w; w.x = cvt_pk_bf16(a[0], a[1]); w.y = cvt_pk_bf16(a[2], a[3]); w.z = cvt_pk_bf16(b[0], b[1]); w.w = cvt_pk_bf16(b[2], b[3]); return w; }

#define GAS __attribute__((address_space(1)))
typedef GAS u32x4* gv4p; typedef GAS f32x4* gf4p; typedef const GAS f32x4* gcf4p; typedef const GAS float* gcfp;
template <int MODE> __device__ __forceinline__ void store8(const EpiArgs& e, int row, int col, f32x4 v0, f32x4 v1, const f32x4 sA, const f32x4 sB) {
    if constexpr (MODE == M_P || MODE == M_PS) {
        *(gv4p)(e.o0 + (size_t)row * e.ld + col) = pack8(v0, v1);
    } else if constexpr (MODE == M_UT) {
        const int part = row >> 8, n = row & 255;
        bf16_t* dst;
        if (col < ML) { const int b = col >> 12, t = col & 4095; dst = e.o0 + ((size_t)(b * 256 + n) * 8192 + part * 4096 + t); }
        else { const int cc = col - ML, b = cc >> 8, t = cc & 255; dst = e.o1 + ((size_t)(b * 256 + n) * 512 + part * 256 + t); }
        *(gv4p)dst = pack8(v0, v1);
    } else if constexpr (MODE == M_Q) {
        if (col < 384) {
            const float s = sA[0];
            bf16_t* dst = row < ML ? e.o0 + (size_t)row * 384 + col : e.o1 + (size_t)(row - ML) * 384 + col;
            *(gv4p)dst = pack8(v0 * s, v1 * s);
        }
    } else if constexpr (MODE == M_K) {
        const int h = col >> 6, d = col & 63; const float s = sA[0];
        int b, key; if (row < ML) { b = row >> 12; key = CTX + (row & 4095); } else { const int rr = row - ML; b = rr >> 8; key = rr & 255; }
        *(gv4p)(e.o0 + ((size_t)((b * 4 + h) * NKEY + key) * QKD + d)) = pack8(v0 * s, v1 * s);
    } else if constexpr (MODE == M_VT) {
        int b, key; if (col < ML) { b = col >> 12; key = CTX + (col & 4095); } else { const int cc = col - ML; b = cc >> 8; key = cc & 255; }
        *(gv4p)(e.o0 + ((size_t)(b * 256 + row) * NKEY + key)) = pack8(v0 * sA, v1 * sB);
    } else if constexpr (MODE == M_POOL) {
        *(gv4p)(e.o0 + (size_t)row * DM + 512 + col) = pack8(v0 * sA, v1 * sB);
    } else if constexpr (MODE == M_DFT) {
        const int b = col >> 8, n = col & 255;
        *(gv4p)(e.o0 + (size_t)(b * SEQ + row) * DM + n) = pack8(v0 * (1.f / 512.f), v1 * (1.f / 512.f));
    } else if constexpr (MODE == M_F32) {
        GAS float* d = (GAS float*)e.o0 + (size_t)row * 4096 + col; *(gf4p)d = v0; *(gf4p)(d + 4) = v1;
    } else if constexpr (MODE == M_DFTC) {
        const int b = col >> 8, n = col & 255;
        *(gv4p)(e.o0 + (size_t)(ML + b * CTX + row) * DM + n) = pack8(v0 * (1.f / 128.f), v1 * (1.f / 128.f));
    } else if constexpr (MODE == M_RELU2) {
#pragma unroll
        for (int i = 0; i < 4; ++i) { const float a = fmaxf(v0[i], 0.f), b = fmaxf(v1[i], 0.f); v0[i] = a * a; v1[i] = b * b; }
        *(gv4p)(e.o0 + (size_t)row * e.ld + col) = pack8(v0, v1);
    }
}
template <int MODE> __device__ __forceinline__ void epi_loops(const EpiArgs& e, const f32x4 (&acc)[2][2][4][2], const pg8::Unit& u, int wr, int wc, int fr, int fq) {
    const int row0 = u.pm * 256 + wr * 64 + fr, col0 = u.pn * 256 + wc * 32 + 8 * fq;
    const f32x4 zero4 = (f32x4){0.f, 0.f, 0.f, 0.f};
    if constexpr (MODE == M_RES) {
        const int bi = row0 < ML ? (row0 >> 12) : 16;
        gcfp gp = (gcfp)((const float*)e.o1 + (size_t)bi * 6144 + e.goff + col0);
        f32x4 gt[2][2];
#pragma unroll
        for (int bj = 0; bj < 2; ++bj) { gt[bj][0] = *(gcf4p)(gp + bj * 128); gt[bj][1] = *(gcf4p)(gp + bj * 128 + 4); }
        const bool lat = row0 < ML;
        gcfp sbase = lat ? (gcfp)(e.f0 + (size_t)row0 * DM + col0) : (gcfp)(e.f1 + (size_t)(row0 - ML) * DM + col0);
        GAS float* dbase = lat ? (GAS float*)(e.x0 + (size_t)row0 * DM + col0) : (GAS float*)(e.x1 + (size_t)(row0 - ML) * DM + col0);
        const int emit = e.ld;
        unsigned char* wsb = (unsigned char*)e.x1 - WS_XC;
        const float* vec = (const float*)(wsb + WS_VEC);
        gcfp gnp = (gcfp)(vec + (emit == 3 ? V_GN1 : V_GN2 + (emit == 2 ? 17 * 1024 : 0)) + bi * 1024 + col0);
        GAS float* rss = (GAS float*)(wsb + WS_RSS + (size_t)(emit > 0 ? emit - 1 : 0) * RSS_STRIDE) + row0;
        GAS bf16_t* hbase = (GAS bf16_t*)(wsb + WS_H) + (size_t)row0 * DM + col0;
        f32x4 gn[2][2];
#pragma unroll
        for (int bj = 0; bj < 2; ++bj) { gn[bj][0] = emit ? *(gcf4p)(gnp + bj * 128) : zero4; gn[bj][1] = emit ? *(gcf4p)(gnp + bj * 128 + 4) : zero4; }
        const int lane_e = fq * 16 + fr;
        f32x4 cur[2][2], nxt[2][2];
#pragma unroll
        for (int bj = 0; bj < 2; ++bj) { cur[bj][0] = *(gcf4p)(sbase + bj * 128); cur[bj][1] = *(gcf4p)(sbase + bj * 128 + 4); }
#pragma unroll
        for (int g = 0; g < 8; ++g) {
            const int ai = g >> 2, m = g & 3;
            if (g + 1 < 8) { const int a2 = (g + 1) >> 2, m2 = (g + 1) & 3; const size_t off = (size_t)(a2 * 128 + m2 * 16) * DM;
#pragma unroll
                for (int bj = 0; bj < 2; ++bj) { nxt[bj][0] = *(gcf4p)(sbase + off + bj * 128); nxt[bj][1] = *(gcf4p)(sbase + off + bj * 128 + 4); } }
            const size_t offc = (size_t)(ai * 128 + m * 16) * DM;
            float sq = 0.f;
#pragma unroll
            for (int bj = 0; bj < 2; ++bj) {
                const f32x4 x0 = cur[bj][0] + gt[bj][0] * acc[ai][bj][m][0], x1 = cur[bj][1] + gt[bj][1] * acc[ai][bj][m][1];
                *(gf4p)(dbase + offc + bj * 128) = x0; *(gf4p)(dbase + offc + bj * 128 + 4) = x1;
                if (emit) { *(gv4p)(hbase + offc + bj * 128) = pack8(x0 * gn[bj][0], x1 * gn[bj][1]);
                    sq += (x0[0] * x0[0] + x0[1] * x0[1]) + (x0[2] * x0[2] + x0[3] * x0[3]) + (x1[0] * x1[0] + x1[1] * x1[1]) + (x1[2] * x1[2] + x1[3] * x1[3]); }
            }
            if (emit) { sq += shx(sq, 16, lane_e); sq += shx(sq, 32, lane_e); if (fq == 0) atomicAdd((float*)(rss + ai * 128 + m * 16), sq); }
            asm volatile("" ::: "memory");
#pragma unroll
            for (int bj = 0; bj < 2; ++bj) { cur[bj][0] = nxt[bj][0]; cur[bj][1] = nxt[bj][1]; }
        }
    } else {
        float rs[8]; f32x4 cs[2][2];
        if constexpr (MODE == M_Q || MODE == M_K) {
#pragma unroll
            for (int g = 0; g < 8; ++g) rs[g] = ((gcfp)e.f0)[row0 + (g >> 2) * 128 + (g & 3) * 16] * (MODE == M_Q ? QSCALE : 1.0f);
        }
        if constexpr (MODE == M_VT || MODE == M_POOL) {
#pragma unroll
            for (int bj = 0; bj < 2; ++bj) { cs[bj][0] = *(gcf4p)(e.f0 + col0 + bj * 128); cs[bj][1] = *(gcf4p)(e.f0 + col0 + bj * 128 + 4); }
        }
        if constexpr (MODE == M_RELU2 || MODE == M_PS) {
            const int bi = row0 < ML ? (row0 >> 12) : 16;
#pragma unroll
            for (int g = 0; g < 8; ++g) rs[g] = 1.0f / sqrtf(((gcfp)e.f0)[row0 + (g >> 2) * 128 + (g & 3) * 16] * (1.f / DM) + EPS);
#pragma unroll
            for (int bj = 0; bj < 2; ++bj) { cs[bj][0] = *(gcf4p)(e.f1 + (size_t)bi * e.goff + col0 + bj * 128); cs[bj][1] = *(gcf4p)(e.f1 + (size_t)bi * e.goff + col0 + bj * 128 + 4); }
        }
#pragma unroll
        for (int ai = 0; ai < 2; ++ai)
#pragma unroll
            for (int m = 0; m < 4; ++m)
#pragma unroll
                for (int bj = 0; bj < 2; ++bj) {
                    f32x4 sA = zero4, sB = zero4;
                    if constexpr (MODE == M_Q || MODE == M_K) sA[0] = rs[ai * 4 + m];
                    if constexpr (MODE == M_VT || MODE == M_POOL) { sA = cs[bj][0]; sB = cs[bj][1]; }
                    if constexpr (MODE == M_RELU2 || MODE == M_PS) { const float rr = rs[ai * 4 + m];
                        store8<MODE>(e, row0 + ai * 128 + m * 16, col0 + bj * 128, acc[ai][bj][m][0] * rr + cs[bj][0], acc[ai][bj][m][1] * rr + cs[bj][1], sA, sB); }
                    else
                    store8<MODE>(e, row0 + ai * 128 + m * 16, col0 + bj * 128, acc[ai][bj][m][0], acc[ai][bj][m][1], sA, sB);
                }
    }
}
struct Epi {
    int mode; EpiArgs e;
    __device__ __forceinline__ void operator()(const f32x4 (&acc)[2][2][4][2], const pg8::Unit& u, int wr, int wc, int fr, int fq) const {
        switch (mode) {
            case M_P: epi_loops<M_P>(e, acc, u, wr, wc, fr, fq); break;
            case M_UT: epi_loops<M_UT>(e, acc, u, wr, wc, fr, fq); break;
            case M_Q: epi_loops<M_Q>(e, acc, u, wr, wc, fr, fq); break;
            case M_K: epi_loops<M_K>(e, acc, u, wr, wc, fr, fq); break;
            case M_VT: epi_loops<M_VT>(e, acc, u, wr, wc, fr, fq); break;
            case M_POOL: epi_loops<M_POOL>(e, acc, u, wr, wc, fr, fq); break;
            case M_DFTC: epi_loops<M_DFTC>(e, acc, u, wr, wc, fr, fq); break;
            case M_RES: epi_loops<M_RES>(e, acc, u, wr, wc, fr, fq); break;
            case M_PS: epi_loops<M_PS>(e, acc, u, wr, wc, fr, fq); break;
            case M_F32: epi_loops<M_F32>(e, acc, u, wr, wc, fr, fq); break;
            default: epi_loops<M_RELU2>(e, acc, u, wr, wc, fr, fq); break;
        }
    }
};

struct Args { const float* in[21]; float* out; unsigned char* ws; int ph_lo, ph_hi; };
typedef const __attribute__((address_space(4))) Args* KArgs;

__device__ __forceinline__ void transpose_item(const float* W, int K, int N, bf16_t* WT, LAS float* scr, int item, int lane) {
    const int nblk = N / 32, kb = item / nblk, nb = item % nblk, k0 = 64 * kb, n0 = 32 * nb;
#pragma unroll 8
    for (int i = 0; i < 32; ++i) { const int kk = 2 * i + (lane >> 5); scr[kk * 33 + (lane & 31)] = W[(size_t)(k0 + kk) * N + n0 + (lane & 31)]; }
    asm volatile("s_waitcnt lgkmcnt(0)" ::: "memory");
    const int c = lane & 7;
#pragma unroll
    for (int j = 0; j < 4; ++j) { const int n = (lane >> 3) + 8 * j; const LAS float* s = scr + (8 * c) * 33 + n;
        u32x4 o; o.x = pk2(s[0 * 33], s[1 * 33]); o.y = pk2(s[2 * 33], s[3 * 33]); o.z = pk2(s[4 * 33], s[5 * 33]); o.w = pk2(s[6 * 33], s[7 * 33]);
        *(u32x4*)(WT + (size_t)(n0 + n) * K + k0 + 8 * c) = o; }
    asm volatile("s_waitcnt lgkmcnt(0)" ::: "memory");
}

__device__ __forceinline__ void phase_setup(KArgs ap, unsigned char* ws, LAS unsigned char* lds, int tid, int lane, int wave, const int BX, const int G) {
    {
        LAS float* S = (LAS float*)lds;
        LAS float* part = (LAS float*)(lds + 17 * 1024 * 4);
        float* mod = (float*)(ws + WS_MOD);
        if (BX < 192) {
            for (int i = tid; i < 17 * 1024; i += 512) { const int r = i >> 10, k = i & 1023; const float v = r < 16 ? ap->in[1][r * 1024 + k] : ap->in[3][k]; S[i] = v / (1.f + expf(-v)); }
        }
        __syncthreads();
        for (int item = BX; item < 192; item += G) {
            const int l = item / 96, n0 = (item % 96) * 64;
            const float* W = ap->in[4] + (size_t)l * 1024 * 6144 + n0 + lane;
            float acc[17];
#pragma unroll
            for (int r = 0; r < 17; ++r) acc[r] = 0.f;
            for (int k = wave * 128; k < wave * 128 + 128; k += 4) {
                const float w0 = W[(size_t)k * 6144], w1 = W[(size_t)(k + 1) * 6144], w2 = W[(size_t)(k + 2) * 6144], w3 = W[(size_t)(k + 3) * 6144];
#pragma unroll
                for (int r = 0; r < 17; ++r) { const f32x4 s = *(const LAS f32x4*)(S + r * 1024 + k); acc[r] += s[0] * w0 + s[1] * w1 + s[2] * w2 + s[3] * w3; }
            }
#pragma unroll
            for (int r = 0; r < 17; ++r) part[(wave * 17 + r) * 64 + lane] = acc[r];
            __syncthreads();
            for (int i = tid; i < 17 * 64; i += 512) { const int r = i >> 6, j = i & 63; float s = ap->in[5][l * 6144 + n0 + j];
#pragma unroll
                for (int w = 0; w < 8; ++w) s += part[(w * 17 + r) * 64 + j];
                mod[(size_t)(l * 17 + r) * 6144 + n0 + j] = s; }
            __syncthreads();
        }
    }
    {
        LAS float* scr = (LAS float*)(lds + wave * 16384);
        const int gw = BX * 8 + wave, NGW = G * 8;
        constexpr int I_IN = 16 * 53, I_OUT = 16 * 32, I_1 = 16 * 128, I_2 = 64 * 32, I_L = I_IN + I_OUT + I_1 + I_2;
        for (int it = gw; it < 2 * I_L; it += NGW) {
            const int l = it / I_L; int r = it % I_L; unsigned char* wl = ws + l * WL;
            if (r < I_IN) { transpose_item(ap->in[8] + (size_t)l * 1024 * 1696, 1024, 1696, (bf16_t*)(wl + O_WIN), scr, r, lane); continue; } r -= I_IN;
            if (r < I_OUT) { transpose_item(ap->in[17] + (size_t)l * 1024 * 1024, 1024, 1024, (bf16_t*)(wl + O_WOUT), scr, r, lane); continue; } r -= I_OUT;
            if (r < I_1) { transpose_item(ap->in[18] + (size_t)l * 1024 * 4096, 1024, 4096, (bf16_t*)(wl + O_W1), scr, r, lane); continue; } r -= I_1;
            transpose_item(ap->in[19] + (size_t)l * 4096 * 1024, 4096, 1024, (bf16_t*)(wl + O_W2), scr, r, lane);
        }
    }
    {
        const int gt = BX * 512 + tid, NGT = G * 512;
        for (int l = 0; l < 2; ++l) {
            unsigned char* wl = ws + l * WL;
            { unsigned* z = (unsigned*)((bf16_t*)(wl + O_WIN) + (size_t)1696 * 1024); for (int i = gt; i < 96 * 1024 / 2; i += NGT) z[i] = 0u; }
            { bf16_t* o = (bf16_t*)(wl + O_WUQ); const float* w = ap->in[14] + (size_t)l * 256 * 384; const float* gq = ap->in[13] + l * 256;
              for (int i = gt; i < 512 * 256; i += NGT) { const int n = i >> 8, k = i & 255; o[i] = (bf16_t)(n < 384 ? f2bf(gq[k] * w[k * 384 + n]) : 0u); } }
            { bf16_t* ok = (bf16_t*)(wl + O_WK); bf16_t* ov = (bf16_t*)(wl + O_WV); const float* w = ap->in[16] + (size_t)l * 128 * 512; const float* gk = ap->in[15] + l * 128;
              for (int i = gt; i < 256 * 128; i += NGT) { const int n = i >> 7, k = i & 127, h = n >> 6, d = n & 63; const float gg = gk[k];
                  ok[i] = (bf16_t)f2bf(gg * w[k * 512 + h * 128 + d]); ov[i] = (bf16_t)f2bf(gg * w[k * 512 + h * 128 + 64 + d]); } }
            { bf16_t* o = (bf16_t*)(wl + O_WF); const float* fw = ap->in[9] + (size_t)l * 256 * 256;
              for (int i = gt; i < 512 * 256; i += NGT) { const int r = i >> 8, kin = i & 255, part = r >> 8, n = r & 255, h = kin >> 6, c = kin & 63; float s = 0.f;
                  for (int k2 = 0; k2 < 64; ++k2) { const float ang = (float)((c * k2) & 63) * (1.f / 32.f); const float tr = part ? sinpif(ang) : cospif(ang); s += tr * fw[(h * 64 + k2) * 256 + n]; }
                  o[i] = (bf16_t)f2bf(s); } }
            { bf16_t* o = (bf16_t*)(wl + O_POOL); const float* pw = ap->in[11] + (size_t)l * 4 * 64 * 64;
              for (int i = gt; i < 256 * 256; i += NGT) { const int r = i >> 8, k = i & 255, g = r >> 6, n = r & 63; o[i] = (bf16_t)((k >> 6) == g ? f2bf(pw[(g * 64 + (k & 63)) * 64 + n]) : 0u); } }
        }
        { float* tab = (float*)(ws + WS_ROPE); for (int i = gt; i < 512; i += NGT) { float sn, cs; sincosf((float)(i >> 3) * invfreq(i & 7), &sn, &cs); tab[2 * i] = cs; tab[2 * i + 1] = sn; } }
        { u32x4* z = (u32x4*)(ws + WS_RSS); for (int i = gt; i < (int)(3 * RSS_STRIDE / 16); i += NGT) z[i] = (u32x4){0u, 0u, 0u, 0u}; }
        { u32x4* o = (u32x4*)(ws + WS_DFT);
          for (int i = gt; i < 2 * 2048 * 512; i += NGT) { const int part = i >> 20, ii = i & ((1 << 20) - 1), row = ii >> 9, t0 = (ii & 511) * 8; float v[8];
#pragma unroll
              for (int e = 0; e < 8; ++e) { const float ang = (float)(((row + 1) * (t0 + e)) & 4095) * (1.f / 2048.f); v[e] = part ? sinpif(ang) : cospif(ang); }
              u32x4 w; w.x = pk2(v[0], v[1]); w.y = pk2(v[2], v[3]); w.z = pk2(v[4], v[5]); w.w = pk2(v[6], v[7]); o[i] = w; } }
        { u32x4* o = (u32x4*)(ws + WS_DFTC);
          for (int i = gt; i < 256 * 64; i += NGT) { const int row = i >> 6, j0 = (i & 63) * 8; float v[8];
#pragma unroll
              for (int e = 0; e < 8; ++e) { const int j = j0 + e, t = j & 255; const float ang = (float)((row * t) & 255) * (1.f / 128.f); v[e] = (j >> 8) ? -sinpif(ang) : cospif(ang); }
              u32x4 w; w.x = pk2(v[0], v[1]); w.y = pk2(v[2], v[3]); w.z = pk2(v[4], v[5]); w.w = pk2(v[6], v[7]); o[i] = w; } }
    }
}

__device__ __forceinline__ void phase_vectors(KArgs ap, unsigned char* ws, LAS unsigned char* lds, int tid, int lane, int wave, const int BX, const int G) {
    const float* mod = (const float*)(ws + WS_MOD);
    float* vec = (float*)(ws + WS_VEC);
    { const int gt = BX * 512 + tid, NGT = G * 512;
      for (int i = gt; i < 2 * 17 * 1024; i += NGT) { const int l = i / (17 * 1024), r = (i >> 10) % 17, k = i & 1023; vec[V_GN2 + i] = ap->in[7][l * 1024 + k] * (1.0f + mod[(size_t)(l * 17 + r) * 6144 + 4096 + k]); }
      for (int i = gt; i < 17 * 1024; i += NGT) { const int r = i >> 10, k = i & 1023; vec[V_GN1 + i] = ap->in[6][1024 + k] * (1.0f + mod[(size_t)(17 + r) * 6144 + 1024 + k]); } }
    LAS float* S = (LAS float*)lds;
    LAS float* part = (LAS float*)(lds + 17 * 1024 * 4);
    for (int item = BX; item < 156; item += G) {
        const bool up = item < 128;
        const int l = up ? item / 64 : 1, n0 = up ? (item % 64) * 64 : (item - 128) * 64, N = up ? 4096 : 1696, soff = up ? 3072 : 0;
        const float* Wb = up ? ap->in[18] + (size_t)l * 1024 * 4096 : ap->in[8] + (size_t)1024 * 1696;
        __syncthreads();
        for (int i = tid; i < 17 * 1024; i += 512) { const int r = i >> 10, k = i & 1023; S[i] = mod[(size_t)(l * 17 + r) * 6144 + soff + k]; }
        __syncthreads();
        const bool cv = n0 + lane < N;
        const float* W = Wb + n0 + (cv ? lane : 0);
        float acc[17];
#pragma unroll
        for (int r = 0; r < 17; ++r) acc[r] = 0.f;
        for (int k = wave * 128; k < wave * 128 + 128; k += 4) {
            const float w0 = W[(size_t)k * N], w1 = W[(size_t)(k + 1) * N], w2 = W[(size_t)(k + 2) * N], w3 = W[(size_t)(k + 3) * N];
#pragma unroll
            for (int r = 0; r < 17; ++r) { const f32x4 sv = *(const LAS f32x4*)(S + r * 1024 + k); acc[r] += sv[0] * w0 + sv[1] * w1 + sv[2] * w2 + sv[3] * w3; }
        }
#pragma unroll
        for (int r = 0; r < 17; ++r) part[(wave * 17 + r) * 64 + lane] = cv ? acc[r] : 0.f;
        __syncthreads();
        for (int i = tid; i < 17 * 64; i += 512) { const int r = i >> 6, j = i & 63; float sum = 0.f;
#pragma unroll
            for (int w = 0; w < 8; ++w) sum += part[(w * 17 + r) * 64 + j];
            if (up) vec[V_CB2 + (size_t)(l * 17 + r) * 4096 + n0 + j] = sum; else vec[V_CB1 + (size_t)r * 1792 + n0 + j] = sum; }
    }
    __syncthreads();
}
constexpr int RPI = 4;
__device__ __forceinline__ void phase_norm_mod(const float* xl, const float* xc, const float* g, const float* mod, int shoff, int scoff, bf16_t* H, int nrows, int lane, int wave, const int BX, const int G) {
    const int gw = BX * 8 + wave, NGW = G * 8;
    for (int row0 = gw; row0 < nrows; row0 += NGW * RPI) {
        f32x4 v[RPI][4]; float ss[RPI];
#pragma unroll
        for (int i = 0; i < RPI; ++i) { const int row = row0 + i * NGW; ss[i] = 0.f;
            if (row < nrows) { const float* src = row < ML ? xl + (size_t)row * DM : xc + (size_t)(row - ML) * DM;
#pragma unroll
                for (int j = 0; j < 4; ++j) v[i][j] = *(const f32x4*)(src + lane * 4 + 256 * j); }
            else {
#pragma unroll
                for (int j = 0; j < 4; ++j) v[i][j] = (f32x4){0.f, 0.f, 0.f, 0.f}; } }
#pragma unroll
        for (int i = 0; i < RPI; ++i) {
#pragma unroll
            for (int j = 0; j < 4; ++j) ss[i] += (v[i][j][0] * v[i][j][0] + v[i][j][1] * v[i][j][1]) + (v[i][j][2] * v[i][j][2] + v[i][j][3] * v[i][j][3]); }
#pragma unroll
        for (int o = 1; o < 64; o <<= 1) {
#pragma unroll
            for (int i = 0; i < RPI; ++i) ss[i] += shx(ss[i], o, lane); }
#pragma unroll
        for (int i = 0; i < RPI; ++i) { const int row = row0 + i * NGW;
            if (row < nrows) {
                const float rr = 1.0f / sqrtf(ss[i] * (1.f / DM) + EPS);
                const float* mv = mod + (size_t)(row < ML ? (row >> 12) : 16) * 6144;
#pragma unroll
                for (int j = 0; j < 4; ++j) { const int col = lane * 4 + 256 * j;
                    const f32x4 gg = *(const f32x4*)(g + col), sc = *(const f32x4*)(mv + scoff + col), sh = *(const f32x4*)(mv + shoff + col);
                    const f32x4 o = (v[i][j] * rr * gg) * (sc + 1.0f) + sh;
                    u32x2 w; w.x = cvt_pk_bf16(o[0], o[1]); w.y = cvt_pk_bf16(o[2], o[3]);
                    *(u32x2*)(H + (size_t)row * DM + col) = w; } } }
    }
}
__device__ __forceinline__ void phase_final_norm(float* x, const float* g, int lane, int wave, const int BX, const int G) {
    const int gw = BX * 8 + wave, NGW = G * 8;
    for (int row0 = gw; row0 < ML; row0 += NGW * RPI) {
        f32x4 v[RPI][4]; float ss[RPI];
#pragma unroll
        for (int i = 0; i < RPI; ++i) { const int row = row0 + i * NGW; ss[i] = 0.f;
#pragma unroll
            for (int j = 0; j < 4; ++j) v[i][j] = *(const f32x4*)(x + (size_t)row * DM + lane * 4 + 256 * j); }
#pragma unroll
        for (int i = 0; i < RPI; ++i) {
#pragma unroll
            for (int j = 0; j < 4; ++j) ss[i] += (v[i][j][0] * v[i][j][0] + v[i][j][1] * v[i][j][1]) + (v[i][j][2] * v[i][j][2] + v[i][j][3] * v[i][j][3]); }
#pragma unroll
        for (int o = 1; o < 64; o <<= 1) {
#pragma unroll
            for (int i = 0; i < RPI; ++i) ss[i] += shx(ss[i], o, lane); }
#pragma unroll
        for (int i = 0; i < RPI; ++i) { const int row = row0 + i * NGW;
            const float rr = 1.0f / sqrtf(ss[i] * (1.f / DM) + EPS);
#pragma unroll
            for (int j = 0; j < 4; ++j) { const int col = lane * 4 + 256 * j; const f32x4 gg = *(const f32x4*)(g + col); *(f32x4*)(x + (size_t)row * DM + col) = v[i][j] * rr * gg; } }
    }
}

__device__ __forceinline__ void phase_token_local(const bf16_t* P, float* rq, float* rkv, bf16_t* Kc, bf16_t* MIX, bf16_t* POOLIN, const float* conv_w, const float* ropetab, int tid, int lane, int wave, const int BX, const int G) {
    const int gw = BX * 8 + wave, NGW = G * 8;
    for (int row0 = gw; row0 < MT; row0 += NGW * RPI) {
        u32x2 cq[RPI]; unsigned ck[RPI]; float sq[RPI], sk[RPI];
#pragma unroll
        for (int i = 0; i < RPI; ++i) { const int row = min(row0 + i * NGW, MT - 1); const GAS bf16_t* pr = (const GAS bf16_t*)P + (size_t)row * LDP;
            cq[i] = *(const GAS u32x2*)(pr + 1280 + lane * 4); ck[i] = *(const GAS unsigned*)(pr + 1536 + lane * 2); }
#pragma unroll
        for (int i = 0; i < RPI; ++i) { const float a0 = bflo(cq[i].x), a1 = bfhi(cq[i].x), a2 = bflo(cq[i].y), a3 = bfhi(cq[i].y), k0 = bflo(ck[i]), k1 = bfhi(ck[i]);
            sq[i] = (a0 * a0 + a1 * a1) + (a2 * a2 + a3 * a3); sk[i] = k0 * k0 + k1 * k1; }
#pragma unroll
        for (int o = 1; o < 64; o <<= 1) {
#pragma unroll
            for (int i = 0; i < RPI; ++i) { sq[i] += shx(sq[i], o, lane); sk[i] += shx(sk[i], o, lane); } }
#pragma unroll
        for (int i = 0; i < RPI; ++i) { const int row = row0 + i * NGW;
            if (row < MT && lane == 0) { ((GAS float*)rq)[row] = 1.0f / sqrtf(sq[i] * (1.f / 256.f) + EPS); ((GAS float*)rkv)[row] = 1.0f / sqrtf(sk[i] * (1.f / 128.f) + EPS); } }
    }
    {
        const int gt0 = BX * 512 + tid, NGT0 = G * 512;
        for (int e = gt0; e < MT * 4; e += NGT0) {
            const int row = e >> 2, L = e & 3;
            const bool lat = row < ML; int b, t, key;
            if (lat) { b = row >> 12; t = row & 4095; key = CTX + t; } else { const int rr = row - ML; b = rr >> 8; t = rr & 255; key = t; }
            const GAS bf16_t* pr = (const GAS bf16_t*)P + (size_t)row * LDP + 1664;
            const u32x4 own = *(const GAS u32x4*)(pr + 8 * L), par = *(const GAS u32x4*)(pr + 8 * (L ^ 1));
            u32x4 outw = own;
            if (lat) {
                const int ipos = (L & 2) ? (t & 63) : (t >> 6);
                const GAS f32x4* tb = (const GAS f32x4*)(ropetab + ipos * 16);
                const f32x4 t0 = tb[0], t1 = tb[1], t2 = tb[2], t3 = tb[3];
                const float sg = (L & 1) ? 1.0f : -1.0f;
                float xo[8] = {bflo(own.x), bfhi(own.x), bflo(own.y), bfhi(own.y), bflo(own.z), bfhi(own.z), bflo(own.w), bfhi(own.w)};
                float xp[8] = {bflo(par.x), bfhi(par.x), bflo(par.y), bfhi(par.y), bflo(par.z), bfhi(par.z), bflo(par.w), bfhi(par.w)};
                float cs[8] = {t0[0], t0[2], t1[0], t1[2], t2[0], t2[2], t3[0], t3[2]}, sn[8] = {t0[1], t0[3], t1[1], t1[3], t2[1], t2[3], t3[1], t3[3]};
                float o[8];
#pragma unroll
                for (int j = 0; j < 8; ++j) o[j] = xo[j] * cs[j] + sg * xp[j] * sn[j];
                outw.x = pk2(o[0], o[1]); outw.y = pk2(o[2], o[3]); outw.z = pk2(o[4], o[5]); outw.w = pk2(o[6], o[7]);
            }
#pragma unroll
            for (int h = 0; h < 4; ++h) *(GAS u32x4*)((GAS bf16_t*)Kc + (size_t)((b * 4 + h) * NKEY + key) * QKD + 64 + 8 * L) = outw;
        }
    }
    const int rpb = (MT + G - 1) / G;
    const int rbeg = BX * rpb, rend = min(rbeg + rpb, MT);
    const int c16 = tid & 63, ch = c16 * 4;
    const f32x4 cw0 = *(const f32x4*)(conv_w + ch), cw1 = *(const f32x4*)(conv_w + 256 + ch), cw2 = *(const f32x4*)(conv_w + 512 + ch);
    const int hw = 1 << (c16 >> 4);
    for (int row = rbeg + (tid >> 6); row < rend; row += 8) {
        int t, n; if (row < ML) { t = row & 4095; n = SEQ; } else { t = (row - ML) & 255; n = CTX; }
        const bf16_t* pr = P + (size_t)row * LDP;
        const u32x2 bg = *(const u32x2*)(pr + 256 + ch), cg = *(const u32x2*)(pr + 512 + ch), xi = *(const u32x2*)(pr + 768 + ch);
        const bool hp = t > 0, hn = t < n - 1;
        const bf16_t* pp = hp ? pr - LDP : pr; const bf16_t* pn = hn ? pr + LDP : pr;
        const u32x2 c0 = *(const u32x2*)(pp + 512 + ch), x0 = *(const u32x2*)(pp + 768 + ch), c2 = *(const u32x2*)(pn + 512 + ch), x2 = *(const u32x2*)(pn + 768 + ch);
        const bf16_t* pq = pr + 1024 + ch;
        u32x2 tap[16];
#pragma unroll
        for (int k = 0; k < 16; ++k) { const int d = k - 8; const bool ok = (d >= -hw) && (d < hw) && (t + d >= 0) && (t + d < n);
            tap[k] = *(const u32x2*)(pq + (ptrdiff_t)(ok ? d : 0) * LDP); if (!ok) tap[k] = (u32x2){0u, 0u}; }
        const u32x2 u0 = *(const u32x2*)pq;
        {
            const f32x4 z = (f32x4){bflo(cg.x) * bflo(xi.x), bfhi(cg.x) * bfhi(xi.x), bflo(cg.y) * bflo(xi.y), bfhi(cg.y) * bfhi(xi.y)};
            const f32x4 zp = (f32x4){bflo(c0.x) * bflo(x0.x), bfhi(c0.x) * bfhi(x0.x), bflo(c0.y) * bflo(x0.y), bfhi(c0.y) * bfhi(x0.y)};
            const f32x4 zn = (f32x4){bflo(c2.x) * bflo(x2.x), bfhi(c2.x) * bfhi(x2.x), bflo(c2.y) * bflo(x2.y), bfhi(c2.y) * bfhi(x2.y)};
            const f32x4 y = z * cw1 + zp * (hp ? cw0 : cw0 * 0.f) + zn * (hn ? cw2 : cw2 * 0.f);
            u32x2 w; w.x = cvt_pk_bf16(bflo(bg.x) * y[0], bfhi(bg.x) * y[1]); w.y = cvt_pk_bf16(bflo(bg.y) * y[2], bfhi(bg.y) * y[3]);
            *(u32x2*)(MIX + (size_t)row * DM + 256 + ch) = w;
        }
        {
            f32x4 sacc = (f32x4){0.f, 0.f, 0.f, 0.f};
#pragma unroll
            for (int k = 0; k < 16; ++k) sacc += (f32x4){bflo(tap[k].x), bfhi(tap[k].x), bflo(tap[k].y), bfhi(tap[k].y)};
            const int lo = max(t - hw, 0), hi = min(t + hw - 1, n - 1);
            const float ic = 1.0f / (float)(hi - lo + 1);
            u32x2 w; w.x = cvt_pk_bf16(sacc[0] * ic - bflo(u0.x), sacc[1] * ic - bfhi(u0.x)); w.y = cvt_pk_bf16(sacc[2] * ic - bflo(u0.y), sacc[3] * ic - bfhi(u0.y));
            *(u32x2*)(POOLIN + (size_t)row * 256 + ch) = w;
        }
    }
}

__device__ __forceinline__ void phase_dft_combine(unsigned char* ws, int tid, int lane, int wave, const int BX, const int G) {
    const GAS float* PT = (const GAS float*)(ws + WS_PT); const GAS float* QT = (const GAS float*)(ws + WS_QT);
    GAS bf16_t* MIX = (GAS bf16_t*)(ws + WS_MIX);
    const int gt = BX * 512 + tid, NGT = G * 512;
    for (int i = gt; i < 2048 * 512; i += NGT) {
        const int r = i >> 9, col = (i & 511) * 8, b = col >> 8, n = col & 255, k1 = r + 1;
        const f32x4 p0 = *(const GAS f32x4*)(PT + (size_t)r * 4096 + col), p1 = *(const GAS f32x4*)(PT + (size_t)r * 4096 + col + 4);
        const f32x4 q0 = *(const GAS f32x4*)(QT + (size_t)r * 4096 + col), q1 = *(const GAS f32x4*)(QT + (size_t)r * 4096 + col + 4);
        const float sc = 1.f / 512.f;
        *(gv4p)(MIX + (size_t)(b * SEQ + k1) * DM + n) = pack8((p0 - q0) * sc, (p1 - q1) * sc);
        *(gv4p)(MIX + (size_t)(b * SEQ + 4096 - k1) * DM + n) = pack8((p0 + q0) * sc, (p1 + q1) * sc);
    }
    const GAS bf16_t* UT = (const GAS bf16_t*)(ws + WS_UT);
    const int gw = BX * 8 + wave, NGW = G * 8;
    for (int rowi = gw; rowi < 4096; rowi += NGW) {
        const GAS u32x4* src = (const GAS u32x4*)(UT + (size_t)rowi * 8192) + lane;
        float sacc = 0.f;
#pragma unroll
        for (int c = 0; c < 8; ++c) { const u32x4 w = src[c * 64]; sacc += (bflo(w.x) + bfhi(w.x)) + (bflo(w.y) + bfhi(w.y)) + (bflo(w.z) + bfhi(w.z)) + (bflo(w.w) + bfhi(w.w)); }
        sacc = wave_sum(sacc, lane);
        if (lane == 0) { const int b = rowi >> 8, n = rowi & 255; MIX[(size_t)(b * SEQ) * DM + n] = (bf16_t)f2bf(sacc * (1.f / 512.f)); }
    }
}

constexpr int KROW = 208, VROW = 144, KBUF = 64 * KROW, VBUF = 64 * VROW, ABUF = KBUF + VBUF;
__device__ __forceinline__ void attn_unit(LAS unsigned char* lds, const bf16_t* Qb, const bf16_t* Kb, const bf16_t* Vtb, int nk, bf16_t* Ob, bool rope, int tok0, const int tid, const float* ropetab) {
    const int lane = tid & 63, r = lane & 31, hi = lane >> 5, wid = tid >> 6;
    bf16x8 qf[6];
    const bf16_t* qrow = Qb + (size_t)(wid * 32 + r) * 384 + 8 * hi;
#pragma unroll
    for (int d0 = 0; d0 < 6; ++d0) qf[d0] = *(const bf16x8*)(qrow + d0 * 16);
    if (rope) {
        const int t = tok0 + wid * 32 + r;
#pragma unroll
        for (int d0 = 4; d0 < 6; ++d0) {
            const int ipos = d0 == 4 ? (t >> 6) : (t & 63);
            bf16x8 o;
#pragma unroll
            for (int j = 0; j < 8; ++j) {
                const float own = bf1((bf16_t)qf[d0][j]);
                const float partner = shx(own, 32, lane);
                const f32x2 csn = *(const GAS f32x2*)(ropetab + (ipos * 8 + j) * 2); const float cs = csn[0], sn = csn[1];
                o[j] = (short)f2bf(own * cs + (hi ? partner : -partner) * sn);
            }
            qf[d0] = o;
        }
    }
    const int kc0 = tid, kc1 = tid + 512;
    const int kr0 = kc0 / 12, kcc0 = kc0 % 12, kr1 = kc1 / 12, kcc1 = kc1 % 12;
    const bool k1v = kc1 < 768;
    const int vr = tid >> 3, vcc = tid & 7;
    const bf16_t* kg0 = Kb + (size_t)kr0 * QKD + kcc0 * 8;
    const bf16_t* kg1 = Kb + (size_t)kr1 * QKD + kcc1 * 8;
    const bf16_t* vg = Vtb + (size_t)vr * NKEY + vcc * 8;
    const int kl0 = kr0 * KROW + kcc0 * 16, kl1 = kr1 * KROW + kcc1 * 16, vl = KBUF + vr * VROW + vcc * 16;
    const int NT = nk >> 6;
    u32x4 sk0, sk1 = (u32x4){0u, 0u, 0u, 0u}, sv;
    sk0 = *(const u32x4*)kg0; if (k1v) sk1 = *(const u32x4*)kg1; sv = *(const u32x4*)vg;
    *(LAS u32x4*)(lds + kl0) = sk0; if (k1v) *(LAS u32x4*)(lds + kl1) = sk1; *(LAS u32x4*)(lds + vl) = sv;
    __syncthreads();
    f32x16 ot0, ot1;
#pragma unroll
    for (int i = 0; i < 16; ++i) { ot0[i] = 0.f; ot1[i] = 0.f; }
    float m_run = -1e30f, l_run = 0.f;
    for (int tI = 0; tI < NT; ++tI) {
        LAS unsigned char* cur = lds + (tI & 1) * ABUF;
        LAS unsigned char* nxt = lds + ((tI + 1) & 1) * ABUF;
        const bool more = tI + 1 < NT;
        if (more) { const size_t ko = (size_t)(tI + 1) * 64 * QKD; sk0 = *(const u32x4*)(kg0 + ko); if (k1v) sk1 = *(const u32x4*)(kg1 + ko); sv = *(const u32x4*)(vg + (tI + 1) * 64); }
        f32x16 s0, s1;
#pragma unroll
        for (int i = 0; i < 16; ++i) { s0[i] = 0.f; s1[i] = 0.f; }
        __builtin_amdgcn_s_setprio(1);
#pragma unroll
        for (int d0 = 0; d0 < 6; ++d0) {
            const bf16x8 a0 = *(const LAS bf16x8*)(cur + r * KROW + d0 * 32 + hi * 16);
            const bf16x8 a1 = *(const LAS bf16x8*)(cur + (32 + r) * KROW + d0 * 32 + hi * 16);
            s0 = __builtin_amdgcn_mfma_f32_32x32x16_bf16(a0, qf[d0], s0, 0, 0, 0);
            s1 = __builtin_amdgcn_mfma_f32_32x32x16_bf16(a1, qf[d0], s1, 0, 0, 0);
        }
        __builtin_amdgcn_s_setprio(0);
        float mx = s0[0];
#pragma unroll
        for (int i = 1; i < 16; ++i) mx = fmaxf(mx, s0[i]);
#pragma unroll
        for (int i = 0; i < 16; ++i) mx = fmaxf(mx, s1[i]);
        mx = fmaxf(mx, shx(mx, 32, lane));
        const float m_new = fmaxf(m_run, mx);
        const float alpha = __builtin_amdgcn_exp2f(m_run - m_new);
        m_run = m_new;
        float ps = 0.f;
#pragma unroll
        for (int i = 0; i < 16; ++i) { s0[i] = __builtin_amdgcn_exp2f(s0[i] - m_new); s1[i] = __builtin_amdgcn_exp2f(s1[i] - m_new); ps += s0[i] + s1[i]; }
        l_run = l_run * alpha + ps;
#pragma unroll
        for (int i = 0; i < 16; ++i) { ot0[i] *= alpha; ot1[i] *= alpha; }
        bf16x8 pb[4];
#pragma unroll
        for (int s = 0; s < 4; ++s) {
            u32x4 w;
            if (s < 2) { w.x = cvt_pk_bf16(s0[8 * s + 0], s0[8 * s + 1]); w.y = cvt_pk_bf16(s0[8 * s + 2], s0[8 * s + 3]); w.z = cvt_pk_bf16(s0[8 * s + 4], s0[8 * s + 5]); w.w = cvt_pk_bf16(s0[8 * s + 6], s0[8 * s + 7]); }
            else { const int q = s - 2; w.x = cvt_pk_bf16(s1[8 * q + 0], s1[8 * q + 1]); w.y = cvt_pk_bf16(s1[8 * q + 2], s1[8 * q + 3]); w.z = cvt_pk_bf16(s1[8 * q + 4], s1[8 * q + 5]); w.w = cvt_pk_bf16(s1[8 * q + 6], s1[8 * q + 7]); }
            pb[s] = __builtin_bit_cast(bf16x8, w);
        }
#pragma unroll
        for (int s = 0; s < 4; ++s) {
            const int ko = (16 * s + 4 * hi) * 2;
            const s16x4 l0 = *(const LAS s16x4*)(cur + KBUF + r * VROW + ko), h0 = *(const LAS s16x4*)(cur + KBUF + r * VROW + ko + 16);
            const s16x4 l1 = *(const LAS s16x4*)(cur + KBUF + (32 + r) * VROW + ko), h1 = *(const LAS s16x4*)(cur + KBUF + (32 + r) * VROW + ko + 16);
            const bf16x8 a0 = __builtin_shufflevector(l0, h0, 0, 1, 2, 3, 4, 5, 6, 7), a1 = __builtin_shufflevector(l1, h1, 0, 1, 2, 3, 4, 5, 6, 7);
            __builtin_amdgcn_s_setprio(1);
            ot0 = __builtin_amdgcn_mfma_f32_32x32x16_bf16(a0, pb[s], ot0, 0, 0, 0);
            ot1 = __builtin_amdgcn_mfma_f32_32x32x16_bf16(a1, pb[s], ot1, 0, 0, 0);
            __builtin_amdgcn_s_setprio(0);
        }
        if (more) { *(LAS u32x4*)(nxt + kl0) = sk0; if (k1v) *(LAS u32x4*)(nxt + kl1) = sk1; *(LAS u32x4*)(nxt + vl) = sv; }
        __syncthreads();
    }
    const float lt = l_run + shx(l_run, 32, lane);
    const float il = 1.0f / lt;
    bf16_t* orow = Ob + (size_t)(wid * 32 + r) * DM;
#pragma unroll
    for (int g = 0; g < 4; ++g) {
        u32x2 w0, w1;
        w0.x = cvt_pk_bf16(ot0[4 * g] * il, ot0[4 * g + 1] * il); w0.y = cvt_pk_bf16(ot0[4 * g + 2] * il, ot0[4 * g + 3] * il);
        w1.x = cvt_pk_bf16(ot1[4 * g] * il, ot1[4 * g + 1] * il); w1.y = cvt_pk_bf16(ot1[4 * g + 2] * il, ot1[4 * g + 3] * il);
        *(u32x2*)(orow + 8 * g + 4 * hi) = w0;
        *(u32x2*)(orow + 32 + 8 * g + 4 * hi) = w1;
    }
}
__device__ __forceinline__ void phase_attention(LAS unsigned char* lds, unsigned char* ws, bool with_ctx, const int tid, const int bx, const int G) {
    const int vcu = (G % 8 == 0) ? (bx % 8) * (G / 8) + bx / 8 : bx;
    const bf16_t* Q = (const bf16_t*)(ws + WS_Q); const bf16_t* Qc = (const bf16_t*)(ws + WS_QC);
    const bf16_t* Kc = (const bf16_t*)(ws + WS_KC); const bf16_t* Vt = (const bf16_t*)(ws + WS_VT);
    bf16_t* MIX = (bf16_t*)(ws + WS_MIX);
    const int nunits = 1024 + (with_ctx ? 64 : 0);
    for (int u = vcu; u < nunits; u += G) {
        if (u < 1024) {
            const int bh = u >> 4, qb = u & 15, b = bh >> 2, h = bh & 3;
            attn_unit(lds, Q + (size_t)(b * SEQ + qb * 256) * 384 + h * QKD, Kc + (size_t)bh * NKEY * QKD, Vt + (size_t)bh * 64 * NKEY, NKEY,
                      MIX + (size_t)(b * SEQ + qb * 256) * DM + 768 + h * 64, true, qb * 256, tid, (const float*)(ws + WS_ROPE));
        } else {
            const int bh = u - 1024, b = bh >> 2, h = bh & 3;
            attn_unit(lds, Qc + (size_t)(b * CTX) * 384 + h * QKD, Kc + (size_t)bh * NKEY * QKD, Vt + (size_t)bh * 64 * NKEY, CTX,
                      MIX + (size_t)(ML + b * CTX) * DM + 768 + h * 64, false, 0, tid, (const float*)(ws + WS_ROPE));
        }
    }
}

struct Job { pg8::Gemm g; Epi e; };
__device__ __forceinline__ bool get_job(KArgs ap, unsigned char* ws, float* outp, int l, int kind, int j, Job& J) {
    unsigned char* wl = ws + (size_t)l * WL;
    const int Mx = l == 0 ? MT : ML;
    bf16_t* P = (bf16_t*)(ws + WS_P); bf16_t* MIX = (bf16_t*)(ws + WS_MIX); bf16_t* H = (bf16_t*)(ws + WS_H);
    const float* rq = (const float*)(ws + WS_RQ); const float* rkv = (const float*)(ws + WS_RKV);
    const float* mod = (const float*)(ws + WS_MOD) + (size_t)l * 17 * 6144;
    float* xc = (float*)(ws + WS_XC);
    J.e.e = EpiArgs{nullptr, nullptr, nullptr, nullptr, nullptr, nullptr, 0, 0};
    if (kind == 0) { if (j) return false;
        J.g = pg8::Gemm{H, (const bf16_t*)(wl + O_WIN), MT, LDP, DM, DM, DM}; J.e.mode = l == 0 ? M_P : M_PS; J.e.e.o0 = P; J.e.e.ld = LDP;
        J.e.e.f0 = (const float*)(ws + WS_RSS + 2 * RSS_STRIDE); J.e.e.f1 = (const float*)(ws + WS_VEC) + V_CB1; J.e.e.goff = LDP; return true; }
    if (kind == 1) { if (j) return false;
        J.g = pg8::Gemm{(const bf16_t*)(wl + O_WF), P, 512, Mx, 256, 256, LDP}; J.e.mode = M_UT; J.e.e.o0 = (bf16_t*)(ws + WS_UT); J.e.e.o1 = (bf16_t*)(ws + WS_UTC); return true; }
    if (kind == 2) {
        switch (j) {
            case 0: J.g = pg8::Gemm{(const bf16_t*)(ws + WS_DFT), (const bf16_t*)(ws + WS_UT), 2048, 4096, 4096, 4096, 8192}; J.e.mode = M_F32; J.e.e.o0 = (bf16_t*)(ws + WS_PT); return true;
            case 6: J.g = pg8::Gemm{(const bf16_t*)(ws + WS_DFT) + (size_t)2048 * 4096, (const bf16_t*)(ws + WS_UT) + 4096, 2048, 4096, 4096, 4096, 8192}; J.e.mode = M_F32; J.e.e.o0 = (bf16_t*)(ws + WS_QT); return true;
            case 1: J.g = pg8::Gemm{P + 1280, (const bf16_t*)(wl + O_WUQ), Mx, 512, 256, LDP, 256}; J.e.mode = M_Q; J.e.e.o0 = (bf16_t*)(ws + WS_Q); J.e.e.o1 = (bf16_t*)(ws + WS_QC); J.e.e.f0 = rq; return true;
            case 2: J.g = pg8::Gemm{P + 1536, (const bf16_t*)(wl + O_WK), MT, 256, 128, LDP, 128}; J.e.mode = M_K; J.e.e.o0 = (bf16_t*)(ws + WS_KC); J.e.e.f0 = rkv; return true;
            case 3: J.g = pg8::Gemm{(const bf16_t*)(wl + O_WV), P + 1536, 256, MT, 128, 128, LDP}; J.e.mode = M_VT; J.e.e.o0 = (bf16_t*)(ws + WS_VT); J.e.e.f0 = rkv; return true;
            case 4: J.g = pg8::Gemm{(const bf16_t*)(ws + WS_POOLIN), (const bf16_t*)(wl + O_POOL), Mx, 256, 256, 256, 256}; J.e.mode = M_POOL; J.e.e.o0 = MIX; J.e.e.f0 = ap->in[12] + l * 256; return true;
            case 5: if (l != 0) return false;
                J.g = pg8::Gemm{(const bf16_t*)(ws + WS_DFTC), (const bf16_t*)(ws + WS_UTC), 256, 4096, 512, 512, 512}; J.e.mode = M_DFTC; J.e.e.o0 = MIX; return true;
            default: return false;
        }
    }
    if (kind == 4 || kind == 7) { if (j) return false;
        if (kind == 4) J.g = pg8::Gemm{MIX, (const bf16_t*)(wl + O_WOUT), Mx, DM, DM, DM, DM};
        else J.g = pg8::Gemm{(const bf16_t*)(ws + WS_ACT), (const bf16_t*)(wl + O_W2), Mx, DM, DFF, DFF, DFF};
        J.e.mode = M_RES; J.e.e.o1 = (bf16_t*)mod; J.e.e.goff = kind == 4 ? 2048 : 5120;
        J.e.e.f0 = (l == 0 && kind == 4) ? ap->in[0] : outp; J.e.e.f1 = (l == 0 && kind == 4) ? ap->in[2] : xc; J.e.e.x0 = outp; J.e.e.x1 = xc;
        J.e.e.ld = kind == 4 ? 1 + l : (l == 0 ? 3 : 0); return true; }
    if (kind == 6) { if (j) return false;
        J.g = pg8::Gemm{H, (const bf16_t*)(wl + O_W1), Mx, DFF, DM, DM, DM}; J.e.mode = M_RELU2; J.e.e.o0 = (bf16_t*)(ws + WS_ACT); J.e.e.ld = DFF;
        J.e.e.f0 = (const float*)(ws + WS_RSS + (size_t)l * RSS_STRIDE); J.e.e.f1 = (const float*)(ws + WS_VEC) + V_CB2 + l * 17 * 4096; J.e.e.goff = DFF; return true; }
    return false;
}

#define XB_TMO      128
#define XB_XCNT(j)  (256  + 64 * (j))
#define XB_XSUB(j)  (1280 + 64 * (j))
#define XB_XGEN(j)  (2304 + 64 * (j))
#define XB_TOP      3328
#define XB_TOPGEN   3392
#define XCD_BAR_WORDS 3456
#define XB_SPIN_CAP (1u << 18)
__device__ __forceinline__ unsigned xb_ld(unsigned* p)              { return __hip_atomic_load(p, __ATOMIC_RELAXED, __HIP_MEMORY_SCOPE_AGENT); }
__device__ __forceinline__ unsigned xb_add(unsigned* p, unsigned v) { return __hip_atomic_fetch_add(p, v, __ATOMIC_RELAXED, __HIP_MEMORY_SCOPE_AGENT); }
__device__ __forceinline__ unsigned xb_xcc_id() { return (unsigned)__builtin_amdgcn_s_getreg((3 << 11) | 20) & 0xFu; }
#define XB_SPIN(cond, bar) do { unsigned _sp = 0; while (cond) { __builtin_amdgcn_s_sleep(1); \
    if ((++_sp & 255u) == 0u) { if (xb_ld(&(bar)[XB_TMO])) break; if (_sp > XB_SPIN_CAP) { atomicAdd(&(bar)[XB_TMO], 1u); break; } } } } while (0)
struct XcdBarrier { unsigned* bar; unsigned x; volatile LAS unsigned* st; };
__device__ __forceinline__ XcdBarrier xcd_barrier_post(unsigned* bar, volatile LAS unsigned* st) {
    XcdBarrier b; b.bar = bar; b.x = xb_xcc_id(); b.st = st;
    if (threadIdx.x == 0) (void)xb_add(&bar[XB_XCNT(b.x)], 1u);
    return b;
}
__device__ __forceinline__ void xcd_barrier_complete(unsigned* bar, unsigned x, unsigned& nloc, unsigned& nx) {
    const unsigned G = gridDim.x * gridDim.y * gridDim.z;
    unsigned sum, cnt, mine, sp = 0u;
    for (;;) {
        sum = 0u; cnt = 0u; mine = 0u;
#pragma unroll
        for (unsigned j = 0; j < 16; ++j) { const unsigned c = xb_ld(&bar[XB_XCNT(j)]); sum += c; cnt += (c > 0u) ? 1u : 0u; mine = (j == x) ? c : mine; }
        if (sum == G) break;
        __builtin_amdgcn_s_sleep(1);
        if ((++sp & 255u) == 0u) { if (xb_ld(&bar[XB_TMO])) break; if (sp > XB_SPIN_CAP) { atomicAdd(&bar[XB_TMO], 1u); break; } }
    }
    nloc = mine > 0u ? mine : 1u; nx = cnt > 0u ? cnt : 1u;
}
__device__ __forceinline__ void xcd_barrier(const XcdBarrier& b) {
    asm volatile("s_waitcnt vmcnt(0)" ::: "memory");
    __syncthreads();
    if (threadIdx.x == 0) {
        unsigned* bar = b.bar;
        __builtin_amdgcn_s_waitcnt(0);
        unsigned nloc = b.st[0], nx = b.st[1];
        if (nloc == 0u) { xcd_barrier_complete(bar, b.x, nloc, nx); b.st[0] = nloc; b.st[1] = nx; }
        const unsigned old = xb_add(&bar[XB_XSUB(b.x)], 1u);
        const unsigned gen = old / nloc;
        if (old + 1u == (gen + 1u) * nloc) {
            __builtin_amdgcn_fence(__ATOMIC_RELEASE, "agent");
            asm volatile("s_waitcnt vmcnt(0)" ::: "memory");
            const unsigned og = xb_add(&bar[XB_TOP], 1u);
            const unsigned tg = og / nx;
            if (og + 1u == (tg + 1u) * nx) xb_add(&bar[XB_TOPGEN], 1u);
            else XB_SPIN(xb_ld(&bar[XB_TOPGEN]) == tg, bar);
            __builtin_amdgcn_fence(__ATOMIC_ACQUIRE, "agent");
            xb_add(&bar[XB_XGEN(b.x)], 1u);
            asm volatile("s_waitcnt vmcnt(0)" ::: "memory");
        } else {
            XB_SPIN(xb_ld(&bar[XB_XGEN(b.x)]) == gen, bar);
            __builtin_amdgcn_fence(__ATOMIC_ACQUIRE, "agent");
            asm volatile("s_waitcnt vmcnt(0)" ::: "memory");
        }
    }
    __syncthreads();
}

constexpr int LDS_BYTES = 147456;
constexpr int N_PHASES = 2 + 9 * 2;
template <int PH> __device__ __forceinline__ void run_phase(LAS unsigned char* lds) {
    int tid = threadIdx.x; asm volatile("" : "+v"(tid));
    int BX = blockIdx.x, G = gridDim.x; asm volatile("" : "+s"(BX), "+s"(G));
    const int lane = tid & 63, wave = __builtin_amdgcn_readfirstlane(tid >> 6);
    KArgs ap = (KArgs)__builtin_amdgcn_kernarg_segment_ptr(); asm volatile("" : "+s"(ap));
    unsigned char* ws = ap->ws; float* outp = ap->out;
    if constexpr (PH == 0) {
        phase_setup(ap, ws, lds, tid, lane, wave, BX, G);
    } else if constexpr (PH == 1) {
        phase_vectors(ap, ws, lds, tid, lane, wave, BX, G);
        phase_norm_mod(ap->in[0], ap->in[2], ap->in[6], (const float*)(ws + WS_MOD), 0, 1024, (bf16_t*)(ws + WS_H), MT, lane, wave, BX, G);
    } else {
        constexpr int l = (PH - 2) / 9, kind = (PH - 2) % 9;
        const float* mod = (const float*)(ws + WS_MOD) + (size_t)l * 17 * 6144;
        if constexpr (kind == 1) phase_token_local((const bf16_t*)(ws + WS_P), (float*)(ws + WS_RQ), (float*)(ws + WS_RKV), (bf16_t*)(ws + WS_KC), (bf16_t*)(ws + WS_MIX), (bf16_t*)(ws + WS_POOLIN), ap->in[10] + l * 768, (const float*)(ws + WS_ROPE), tid, lane, wave, BX, G);
        if constexpr (kind == 3) { phase_dft_combine(ws, tid, lane, wave, BX, G); phase_attention(lds, ws, l == 0, tid, BX, G); }
        else if constexpr (kind == 5) { }
        else if constexpr (kind == 8) {
            if constexpr (l == 0) { }
            else phase_final_norm(outp, ap->in[20], lane, wave, BX, G);
        } else {
            Job J; int lr = l, kr = kind; asm volatile("" : "+s"(lr), "+s"(kr));
            for (int j = 0;; ++j) {
                KArgs ap2 = ap; unsigned char* ws2 = ws; float* out2 = outp; int tid2 = tid, BX2 = BX, G2 = G;
                asm volatile("" : "+s"(ap2), "+s"(ws2), "+s"(out2), "+v"(tid2), "+s"(BX2), "+s"(G2));
                if (kr == 2 && j > 6) break;
                const int jj = kr == 2 ? (j == 0 ? 0 : j == 1 ? 6 : j - 1) : j;
                if (!get_job(ap2, ws2, out2, lr, kr, jj, J)) break;
                const int rot = kr == 2 ? (jj == 6 ? 128 : jj == 2 ? 32 : jj == 3 ? 48 : jj == 4 ? 64 : jj == 5 ? 80 : 0) : 0;
                pg8::StaticOrder S; S.init(J.g.M, J.g.N, G2, (BX2 + rot) % G2);
                pg8::gemm_phase<Epi>(lds, J.g, S, J.e, tid2);
            }
        }
    }
}
__global__ void __launch_bounds__(512, 2) fwd_megakernel(Args a) {
    extern __shared__ __attribute__((aligned(16))) unsigned char lds_raw[];
    LAS unsigned char* lds = (LAS unsigned char*)lds_raw;
    cg::grid_group grid = cg::this_grid();
    const int ph_lo = a.ph_lo, ph_hi = a.ph_hi;
    for (int u = threadIdx.x; u < (LDS_BYTES - 131072) / 4; u += 512) ((LAS unsigned*)(lds + 131072))[u] = 0u;
    __syncthreads();
    if (blockIdx.x == 0) for (int u = threadIdx.x; u < (int)(CTL_BYTES / 4); u += 512) ((unsigned*)(a.ws + WS_CTL))[u] = 0u;
    XcdBarrier bar; bar.bar = (unsigned*)(a.ws + WS_CTL); bar.x = 0; bar.st = (volatile LAS unsigned*)(lds + 131072 + 64);
#ifndef EXP_SYNC
#define EXP_SYNC 0
#endif
#ifndef EXP_REP
#define EXP_REP(k) 0
#endif
#define PH_EMPTY(k) ((k) == 7 || (k) == 16 || (k) == 10)
#define PHASE(k) if (!PH_EMPTY(k) && ph_lo <= (k) && (k) < ph_hi) { run_phase<k>(lds); if (EXP_REP(k)) { grid.sync(); run_phase<k>(lds); } if ((k) + 1 < ph_hi) { if ((k) == 0) { grid.sync(); bar = xcd_barrier_post((unsigned*)(a.ws + WS_CTL), (volatile LAS unsigned*)(lds + 131072 + 64)); } else xcd_barrier(bar); if (EXP_SYNC) xcd_barrier(bar); } }
    PHASE(0) PHASE(1) PHASE(2) PHASE(3) PHASE(4) PHASE(5) PHASE(6) PHASE(7) PHASE(8) PHASE(9) PHASE(10)
    PHASE(11) PHASE(12) PHASE(13) PHASE(14) PHASE(15) PHASE(16) PHASE(17) PHASE(18) PHASE(19)
#undef PHASE
}

#ifndef MK_MULTI_LAUNCH
#define MK_MULTI_LAUNCH 0
#endif
extern "C" void kernel_launch(void* const* d_in, const int* in_sizes, int n_in, void* d_out, int out_size, void* d_ws, size_t ws_size, hipStream_t stream) {
    static int grid = 0;
    if (grid == 0) {
        int dev = 0, cus = 0, per_cu = 0;
        hipGetDevice(&dev);
        hipDeviceGetAttribute(&cus, hipDeviceAttributeMultiprocessorCount, dev);
        hipFuncSetAttribute((const void*)fwd_megakernel, hipFuncAttributeMaxDynamicSharedMemorySize, LDS_BYTES);
        hipOccupancyMaxActiveBlocksPerMultiprocessor(&per_cu, (const void*)fwd_megakernel, 512, LDS_BYTES);
        (void)hipGetLastError();
        if (cus <= 0) cus = 256;
        grid = cus;
        if (per_cu < 1) fprintf(stderr, "kernel_launch: occupancy query says %d blocks/CU\n", per_cu);
        if (ws_size < WS_END) { fprintf(stderr, "kernel_launch: workspace too small (%zu < %zu)\n", ws_size, (size_t)WS_END); grid = -1; }
    }
    if (grid < 0) return;
    Args a{};
    for (int i = 0; i < 21; ++i) a.in[i] = (const float*)d_in[i];
    a.out = (float*)d_out; a.ws = (unsigned char*)d_ws;
#if MK_MULTI_LAUNCH
    for (int ph = 0; ph < N_PHASES; ++ph) { a.ph_lo = ph; a.ph_hi = ph + 1; hipLaunchKernelGGL(fwd_megakernel, dim3(grid), dim3(512), LDS_BYTES, stream, a); }
#else
    a.ph_lo = 0; a.ph_hi = N_PHASES;
    void* args[] = {&a};
    hipError_t e = hipLaunchCooperativeKernel((const void*)fwd_megakernel, dim3(grid), dim3(512), args, LDS_BYTES, stream);
    if (e != hipSuccess) fprintf(stderr, "cooperative launch failed: %s (grid %d)\n", hipGetErrorString(e), grid);
#endif
}
```

```cpp
#include <hip/hip_runtime.h>
#include <hip/hip_cooperative_groups.h>
#include <cstdio>
#include <cstdint>
namespace cg = cooperative_groups;

#define LAS __attribute__((address_space(3)))
typedef unsigned short bf16_t;
typedef short bf16x8 __attribute__((ext_vector_type(8)));
typedef short s16x4 __attribute__((ext_vector_type(4)));
typedef float f32x4 __attribute__((ext_vector_type(4)));
typedef float f32x2 __attribute__((ext_vector_type(2)));
typedef float f32x16 __attribute__((ext_vector_type(16)));
typedef unsigned u32x4 __attribute__((ext_vector_type(4)));
typedef unsigned u32x2 __attribute__((ext_vector_type(2)));

constexpr int NB = 16, SEQ = 4096, DM = 1024, CTX = 256, ML = NB * SEQ, MC = NB * CTX, MT = ML + MC;
constexpr int LDP = 1792, DFF = 4096, NKEY = SEQ + CTX, NHEAD = 4, QKD = 96;
constexpr float EPS = 1e-6f;
constexpr float QSCALE = 0.10206207261596577f * 1.4426950408889634f;

constexpr size_t MiB = 1u << 20;
constexpr size_t WL = 24 * MiB;
constexpr size_t O_WIN = 0, O_WOUT = 3670016, O_W1 = 5767168, O_W2 = 14155776, O_WUQ = 22544384, O_WK = 22806528, O_WV = 22872064, O_WF = 22937600, O_POOL = 23199744;
constexpr size_t WS_CTL = 48 * MiB + 832 * 1024, CTL_BYTES = 16384;
constexpr size_t WS_MOD = 48 * MiB, WS_RQ = 49 * MiB, WS_RKV = 49 * MiB + 512 * 1024, WS_DFTC = 50 * MiB, WS_DFT = 51 * MiB, WS_XC = 115 * MiB, WS_H = 131 * MiB, WS_OV = 267 * MiB;
constexpr size_t WS_P = WS_OV, WS_MIX = WS_OV + 238 * MiB, WS_UT = WS_OV + 374 * MiB, WS_UTC = WS_OV + 438 * MiB, WS_Q = WS_OV + 442 * MiB, WS_QC = WS_OV + 490 * MiB,
                 WS_KC = WS_OV + 493 * MiB, WS_VT = WS_OV + 544 * MiB, WS_POOLIN = WS_OV + 578 * MiB, WS_ACT = WS_OV, WS_RSS = WS_OV + 613 * MiB, RSS_STRIDE = 512 * 1024, WS_VEC = WS_OV + 615 * MiB, WS_PT = WS_OV + 617 * MiB, WS_QT = WS_OV + 649 * MiB, WS_END = WS_OV + 681 * MiB;
constexpr size_t WS_ROPE = WS_VEC + 1 * MiB;
constexpr int V_GN2 = 0, V_CB2 = 2 * 17 * 1024, V_GN1 = V_CB2 + 2 * 17 * 4096, V_CB1 = V_GN1 + 17 * 1024;

__device__ __forceinline__ unsigned cvt_pk_bf16(float lo, float hi) { unsigned r; asm volatile("v_cvt_pk_bf16_f32 %0, %1, %2" : "=v"(r) : "v"(lo), "v"(hi)); return r; }
__device__ __forceinline__ unsigned f2bf(float f) { unsigned u = __builtin_bit_cast(unsigned, f); return (u + 0x7fffu + ((u >> 16) & 1u)) >> 16; }
__device__ __forceinline__ unsigned pk2(float lo, float hi) { return f2bf(lo) | (f2bf(hi) << 16); }
__device__ __forceinline__ float bflo(unsigned w) { return __uint_as_float(w << 16); }
__device__ __forceinline__ float bfhi(unsigned w) { return __uint_as_float(w & 0xffff0000u); }
__device__ __forceinline__ float bf1(bf16_t b) { return __uint_as_float((unsigned)b << 16); }
__device__ __forceinline__ float shx(float v, int mask, int lane) { return __builtin_bit_cast(float, __builtin_amdgcn_ds_bpermute((lane ^ mask) << 2, __builtin_bit_cast(int, v))); }
__device__ __forceinline__ float wave_sum(float v, int lane) {
#pragma unroll
    for (int o = 1; o < 64; o <<= 1) v += shx(v, o, lane);
    return v;
}
__device__ __forceinline__ float invfreq(int j) {
    return j == 0 ? 1.0f : j == 1 ? 0.31622776601683794f : j == 2 ? 0.1f : j == 3 ? 0.031622776601683794f : j == 4 ? 0.01f : j == 5 ? 0.0031622776601683794f : j == 6 ? 0.001f : 0.00031622776601683794f;
}

namespace pg8 {
constexpr int BM = 256, BK = 64, HALF = 128, HTB = HALF * BK * 2, STAGE_BYTES = 8 * HTB, NXCD = 8, WGM = 8;
__host__ __device__ __forceinline__ int lds_byte(int r, int c) { const int st = (r >> 4) * 2 + (c >> 5), rr = r & 15, cc = c & 31, ob = rr * 64 + cc * 2; return st * 1024 + (ob ^ (((ob >> 9) & 1) << 5)); }
__host__ __device__ __forceinline__ void stage_rc(int b, int& R, int& C) { const int st = b / 1024, sb = b % 1024, swz = sb ^ (((sb >> 9) & 1) << 5); R = (st >> 1) * 16 + swz / 64; C = (st & 1) * 32 + (swz % 64) / 2; }
__host__ __device__ __forceinline__ int perm32(int rho) { const int n = rho >> 4, i = rho & 15; return 8 * (i >> 2) + 4 * n + (i & 3); }
struct Unit { int pm, pn; };
__device__ __forceinline__ const char* uptr(const char* p) { const unsigned long long v = (unsigned long long)p; const unsigned lo = __builtin_amdgcn_readfirstlane((unsigned)v), hi = __builtin_amdgcn_readfirstlane((unsigned)(v >> 32)); return (const char*)(((unsigned long long)hi << 32) | lo); }
struct Gemm { const bf16_t* A; const bf16_t* Bt; int M, N, K, lda, ldb; };
struct StaticOrder {
    int nM, nN, nwg, G, c;
    __device__ void init(int M, int N, int G_, int c_) { nM = M / BM; nN = N / BM; nwg = nM * nN; G = G_; c = c_; }
    __device__ bool next(int i, Unit& u) const {
        const long L = (long)i * G + c; if (L >= nwg) return false;
        int wgid = (int)L; { const int q = nwg / NXCD, r = nwg % NXCD, xcd = wgid % NXCD, off = wgid / NXCD; wgid = (xcd < r ? xcd * (q + 1) : r * (q + 1) + (xcd - r) * q) + off; }
        const int nig = WGM * nN, gid = wgid / nig, fm = gid * WGM, gsz = (nM - fm) < WGM ? (nM - fm) : WGM;
        u.pm = fm + ((wgid % nig) % gsz); u.pn = (wgid % nig) / gsz; return true;
    }
};

template <class Epi>
__device__ __forceinline__ void gemm_phase(LAS unsigned char* lds, const Gemm g, const StaticOrder& S, const Epi& E, const int tid) {
    const int wid = __builtin_amdgcn_readfirstlane(tid >> 6), lane = tid & 63, wr = wid >> 2, wc = wid & 3, fr = lane & 15, fq = lane >> 4;
    const int K = g.K, nt = K / BK;
    unsigned voffA[2], voffB[2];
#pragma unroll
    for (int i = 0; i < 2; ++i) { int R, C; stage_rc(tid * 16 + i * 8192, R, C); const int Rb = (R & ~31) + perm32(R & 31);
        voffA[i] = (unsigned)(R * g.lda + C) * 2u; voffB[i] = (unsigned)(Rb * g.ldb + C) * 2u; }
    const size_t kstep = (size_t)(BK * 2);
    const size_t hsA = (size_t)HALF * g.lda * 2, hsB = (size_t)HALF * g.ldb * 2;
    const size_t tsA = 2 * hsA, tsB = 2 * hsB;
    const unsigned ldsw = (unsigned)wid * 1024u;
    const int aoff = lds_byte(wr * 64 + fr, fq * 8), boff = lds_byte(wc * 32 + fr, fq * 8);
#define PG8_SA(b, h) (((b) * 2 + (h)) * HTB)
#define PG8_SB(b, h) ((4 + (b) * 2 + (h)) * HTB)
#define PG8_STAGE(bufoff, gbase, voff) do { const char* _gb = uptr((const char*)(gbase)); _Pragma("unroll") for (int _i = 0; _i < 2; ++_i) \
        __builtin_amdgcn_global_load_lds((const unsigned*)(_gb + (voff)[_i]), (LAS unsigned*)(lds + (bufoff) + ldsw + _i * 8192), 16, 0, 0); } while (0)
#define PG8_LDA(dst, b, h) do { _Pragma("unroll") for (int m = 0; m < 4; ++m) _Pragma("unroll") for (int k = 0; k < 2; ++k) dst[m][k] = *(const LAS bf16x8*)(lds + PG8_SA(b, h) + aoff + m * 2048 + k * 1024); } while (0)
#define PG8_LDB(dst, b, h) do { _Pragma("unroll") for (int n = 0; n < 2; ++n) _Pragma("unroll") for (int k = 0; k < 2; ++k) dst[n][k] = *(const LAS bf16x8*)(lds + PG8_SB(b, h) + boff + n * 2048 + k * 1024); } while (0)
#define PG8_MMA(ai, bj, At, Bt) do { __builtin_amdgcn_s_setprio(1); _Pragma("unroll") for (int m = 0; m < 4; ++m) _Pragma("unroll") for (int n = 0; n < 2; ++n) _Pragma("unroll") for (int k = 0; k < 2; ++k) \
        acc[ai][bj][m][n] = __builtin_amdgcn_mfma_f32_16x16x32_bf16(Bt[n][k], At[m][k], acc[ai][bj][m][n], 0, 0, 0); __builtin_amdgcn_s_setprio(0); } while (0)
#define PG8_WAIT_V(n) asm volatile("s_waitcnt vmcnt(" #n ")" ::: "memory")
#define PG8_WAIT_L(n) asm volatile("s_waitcnt lgkmcnt(" #n ")" ::: "memory")
#define PG8_BAR __builtin_amdgcn_s_barrier()
#define PG8_SCHED __builtin_amdgcn_sched_barrier(0)
    Unit cur, nxt; int ui = 0;
    if (!S.next(0, cur)) return;
    f32x4 acc[2][2][4][2];
#pragma unroll
    for (int a = 0; a < 2; ++a)
#pragma unroll
        for (int b = 0; b < 2; ++b)
#pragma unroll
            for (int m = 0; m < 4; ++m)
#pragma unroll
                for (int n = 0; n < 2; ++n) acc[a][b][m][n] = (f32x4){0.f, 0.f, 0.f, 0.f};
    bf16x8 At[4][2], B0[2][2], B1[2][2];
    const char* cA = (const char*)g.A + (size_t)cur.pm * tsA; const char* cB = (const char*)g.Bt + (size_t)cur.pn * tsB;
    PG8_STAGE(PG8_SB(0, 0), cB, voffB); PG8_STAGE(PG8_SB(0, 1), cB + hsB, voffB); PG8_STAGE(PG8_SA(0, 0), cA, voffA); PG8_STAGE(PG8_SA(0, 1), cA + hsA, voffA);
    if (wr == 1) PG8_BAR;
    PG8_WAIT_V(2); PG8_BAR;
    PG8_STAGE(PG8_SB(1, 0), cB + kstep, voffB); PG8_STAGE(PG8_SA(1, 0), cA + kstep, voffA); PG8_STAGE(PG8_SB(1, 1), cB + hsB + kstep, voffB);
    PG8_WAIT_V(6); PG8_BAR;
    for (;;) {
        const bool has_next = S.next(ui + 1, nxt);
        const char* nA = has_next ? (const char*)g.A + (size_t)nxt.pm * tsA : cA; const char* nB = has_next ? (const char*)g.Bt + (size_t)nxt.pn * tsB : cB;
        for (int t = 0; t < nt; t += 2) {
            const bool last = (t == nt - 2);
            const char* a1 = cA + (size_t)(t + 1) * kstep;
            const char* a2 = last ? nA : cA + (size_t)(t + 2) * kstep; const char* b2 = last ? nB : cB + (size_t)(t + 2) * kstep;
            const char* a3 = a2 + kstep; const char* b3 = b2 + kstep;
            PG8_LDB(B0, 0, 0); PG8_LDB(B1, 0, 1); PG8_SCHED; PG8_LDA(At, 0, 0); PG8_STAGE(PG8_SA(1, 1), a1 + hsA, voffA);
            PG8_WAIT_V(8); PG8_WAIT_L(0); PG8_BAR; PG8_MMA(0, 0, At, B0); PG8_MMA(0, 1, At, B1); PG8_BAR; PG8_SCHED;
            PG8_LDA(At, 0, 1); PG8_STAGE(PG8_SB(0, 0), b2, voffB); PG8_STAGE(PG8_SB(0, 1), b2 + hsB, voffB); PG8_STAGE(PG8_SA(0, 0), a2, voffA);
            PG8_WAIT_V(8); PG8_WAIT_L(0); PG8_BAR; PG8_MMA(1, 0, At, B0); PG8_MMA(1, 1, At, B1); PG8_BAR; PG8_SCHED;
            PG8_LDB(B0, 1, 0); PG8_LDB(B1, 1, 1); PG8_SCHED; PG8_LDA(At, 1, 0); PG8_STAGE(PG8_SA(0, 1), a2 + hsA, voffA);
            PG8_WAIT_V(8); PG8_WAIT_L(0); PG8_BAR; PG8_MMA(0, 0, At, B0); PG8_MMA(0, 1, At, B1); PG8_BAR; PG8_SCHED;
            PG8_LDA(At, 1, 1); PG8_STAGE(PG8_SB(1, 0), b3, voffB); PG8_STAGE(PG8_SB(1, 1), b3 + hsB, voffB); PG8_STAGE(PG8_SA(1, 0), a3, voffA);
            PG8_WAIT_V(8); PG8_WAIT_L(0); PG8_BAR; PG8_MMA(1, 0, At, B0); PG8_MMA(1, 1, At, B1); PG8_BAR; PG8_SCHED;
        }
        if (wr == 0) PG8_BAR;
        E(acc, cur, wr, wc, fr, fq);
        if (!has_next) break;
#pragma unroll
        for (int a = 0; a < 2; ++a)
#pragma unroll
            for (int b = 0; b < 2; ++b)
#pragma unroll
                for (int m = 0; m < 4; ++m)
#pragma unroll
                    for (int n = 0; n < 2; ++n) acc[a][b][m][n] = (f32x4){0.f, 0.f, 0.f, 0.f};
        cur = nxt; cA = nA; cB = nB; ++ui;
        if (wr == 1) PG8_BAR;
    }
    PG8_WAIT_V(0);
    PG8_BAR;
#undef PG8_SA
#undef PG8_SB
#undef PG8_STAGE
#undef PG8_LDA
#undef PG8_LDB
#undef PG8_MMA
#undef PG8_WAIT_V
#undef PG8_WAIT_L
#undef PG8_BAR
#undef PG8_SCHED
}
}

enum { M_P = 0, M_UT = 1, M_Q = 2, M_K = 3, M_VT = 4, M_POOL = 5, M_DFT = 6, M_DFTC = 7, M_RES = 8, M_RELU2 = 9, M_PS = 10, M_F32 = 11 };
struct EpiArgs {
    bf16_t* o0; bf16_t* o1;
    const float* f0; const float* f1;
    float* x0; float* x1;
    int ld; int goff;
};
__device__ __forceinline__ u32x4 pack8(const f32x4& a, const f32x4& b) { u32x4 w; w.x = cvt_pk_bf16(a[0], a[1]); w.y = cvt_pk_bf16(a[2], a[3]); w.z = cvt_pk_bf16(b[0], b[1]); w.w = cvt_pk_bf16(b[2], b[3]); return w; }

#define GAS __attribute__((address_space(1)))
typedef GAS u32x4* gv4p; typedef GAS f32x4* gf4p; typedef const GAS f32x4* gcf4p; typedef const GAS float* gcfp;
template <int MODE> __device__ __forceinline__ void store8(const EpiArgs& e, int row, int col, f32x4 v0, f32x4 v1, const f32x4 sA, const f32x4 sB) {
    if constexpr (MODE == M_P || MODE == M_PS) {
        *(gv4p)(e.o0 + (size_t)row * e.ld + col) = pack8(v0, v1);
    } else if constexpr (MODE == M_UT) {
        const int part = row >> 8, n = row & 255;
        bf16_t* dst;
        if (col < ML) { const int b = col >> 12, t = col & 4095; dst = e.o0 + ((size_t)(b * 256 + n) * 8192 + part * 4096 + t); }
        else { const int cc = col - ML, b = cc >> 8, t = cc & 255; dst = e.o1 + ((size_t)(b * 256 + n) * 512 + part * 256 + t); }
        *(gv4p)dst = pack8(v0, v1);
    } else if constexpr (MODE == M_Q) {
        if (col < 384) {
            const float s = sA[0];
            bf16_t* dst = row < ML ? e.o0 + (size_t)row * 384 + col : e.o1 + (size_t)(row - ML) * 384 + col;
            *(gv4p)dst = pack8(v0 * s, v1 * s);
        }
    } else if constexpr (MODE == M_K) {
        const int h = col >> 6, d = col & 63; const float s = sA[0];
        int b, key; if (row < ML) { b = row >> 12; key = CTX + (row & 4095); } else { const int rr = row - ML; b = rr >> 8; key = rr & 255; }
        *(gv4p)(e.o0 + ((size_t)((b * 4 + h) * NKEY + key) * QKD + d)) = pack8(v0 * s, v1 * s);
    } else if constexpr (MODE == M_VT) {
        int b, key; if (col < ML) { b = col >> 12; key = CTX + (col & 4095); } else { const int cc = col - ML; b = cc >> 8; key = cc & 255; }
        *(gv4p)(e.o0 + ((size_t)(b * 256 + row) * NKEY + key)) = pack8(v0 * sA, v1 * sB);
    } else if constexpr (MODE == M_POOL) {
        *(gv4p)(e.o0 + (size_t)row * DM + 512 + col) = pack8(v0 * sA, v1 * sB);
    } else if constexpr (MODE == M_DFT) {
        const int b = col >> 8, n = col & 255;
        *(gv4p)(e.o0 + (size_t)(b * SEQ + row) * DM + n) = pack8(v0 * (1.f / 512.f), v1 * (1.f / 512.f));
    } else if constexpr (MODE == M_F32) {
        GAS float* d = (GAS float*)e.o0 + (size_t)row * 4096 + col; *(gf4p)d = v0; *(gf4p)(d + 4) = v1;
    } else if constexpr (MODE == M_DFTC) {
        const int b = col >> 8, n = col & 255;
        *(gv4p)(e.o0 + (size_t)(ML + b * CTX + row) * DM + n) = pack8(v0 * (1.f / 128.f), v1 * (1.f / 128.f));
    } else if constexpr (MODE == M_RELU2) {
#pragma unroll
        for (int i = 0; i < 4; ++i) { const float a = fmaxf(v0[i], 0.f), b = fmaxf(v1[i], 0.f); v0[i] = a * a; v1[i] = b * b; }
        *(gv4p)(e.o0 + (size_t)row * e.ld + col) = pack8(v0, v1);
    }
}
template <int MODE> __device__ __forceinline__ void epi_loops(const EpiArgs& e, const f32x4 (&acc)[2][2][4][2], const pg8::Unit& u, int wr, int wc, int fr, int fq) {
    const int row0 = u.pm * 256 + wr * 64 + fr, col0 = u.pn * 256 + wc * 32 + 8 * fq;
    const f32x4 zero4 = (f32x4){0.f, 0.f, 0.f, 0.f};
    if constexpr (MODE == M_RES) {
        const int bi = row0 < ML ? (row0 >> 12) : 16;
        gcfp gp = (gcfp)((const float*)e.o1 + (size_t)bi * 6144 + e.goff + col0);
        f32x4 gt[2][2];
#pragma unroll
        for (int bj = 0; bj < 2; ++bj) { gt[bj][0] = *(gcf4p)(gp + bj * 128); gt[bj][1] = *(gcf4p)(gp + bj * 128 + 4); }
        const bool lat = row0 < ML;
        gcfp sbase = lat ? (gcfp)(e.f0 + (size_t)row0 * DM + col0) : (gcfp)(e.f1 + (size_t)(row0 - ML) * DM + col0);
        GAS float* dbase = lat ? (GAS float*)(e.x0 + (size_t)row0 * DM + col0) : (GAS float*)(e.x1 + (size_t)(row0 - ML) * DM + col0);
        const int emit = e.ld;
        unsigned char* wsb = (unsigned char*)e.x1 - WS_XC;
        const float* vec = (const float*)(wsb + WS_VEC);
        gcfp gnp = (gcfp)(vec + (emit == 3 ? V_GN1 : V_GN2 + (emit == 2 ? 17 * 1024 : 0)) + bi * 1024 + col0);
        GAS float* rss = (GAS float*)(wsb + WS_RSS + (size_t)(emit > 0 ? emit - 1 : 0) * RSS_STRIDE) + row0;
        GAS bf16_t* hbase = (GAS bf16_t*)(wsb + WS_H) + (size_t)row0 * DM + col0;
        f32x4 gn[2][2];
#pragma unroll
        for (int bj = 0; bj < 2; ++bj) { gn[bj][0] = emit ? *(gcf4p)(gnp + bj * 128) : zero4; gn[bj][1] = emit ? *(gcf4p)(gnp + bj * 128 + 4) : zero4; }
        const int lane_e = fq * 16 + fr;
        f32x4 cur[2][2], nxt[2][2];
#pragma unroll
        for (int bj = 0; bj < 2; ++bj) { cur[bj][0] = *(gcf4p)(sbase + bj * 128); cur[bj][1] = *(gcf4p)(sbase + bj * 128 + 4); }
#pragma unroll
        for (int g = 0; g < 8; ++g) {
            const int ai = g >> 2, m = g & 3;
            if (g + 1 < 8) { const int a2 = (g + 1) >> 2, m2 = (g + 1) & 3; const size_t off = (size_t)(a2 * 128 + m2 * 16) * DM;
#pragma unroll
                for (int bj = 0; bj < 2; ++bj) { nxt[bj][0] = *(gcf4p)(sbase + off + bj * 128); nxt[bj][1] = *(gcf4p)(sbase + off + bj * 128 + 4); } }
            const size_t offc = (size_t)(ai * 128 + m * 16) * DM;
            float sq = 0.f;
#pragma unroll
            for (int bj = 0; bj < 2; ++bj) {
                const f32x4 x0 = cur[bj][0] + gt[bj][0] * acc[ai][bj][m][0], x1 = cur[bj][1] + gt[bj][1] * acc[ai][bj][m][1];
                *(gf4p)(dbase + offc + bj * 128) = x0; *(gf4p)(dbase + offc + bj * 128 + 4) = x1;
                if (emit) { *(gv4p)(hbase + offc + bj * 128) = pack8(x0 * gn[bj][0], x1 * gn[bj][1]);
                    sq += (x0[0] * x0[0] + x0[1] * x0[1]) + (x0[2] * x0[2] + x0[3] * x0[3]) + (x1[0] * x1[0] + x1[1] * x1[1]) + (x1[2] * x1[2] + x1[3] * x1[3]); }
            }
            if (emit) { sq += shx(sq, 16, lane_e); sq += shx(sq, 32, lane_e); if (fq == 0) atomicAdd((float*)(rss + ai * 128 + m * 16), sq); }
            asm volatile("" ::: "memory");
#pragma unroll
            for (int bj = 0; bj < 2; ++bj) { cur[bj][0] = nxt[bj][0]; cur[bj][1] = nxt[bj][1]; }
        }
    } else {
        float rs[8]; f32x4 cs[2][2];
        if constexpr (MODE == M_Q || MODE == M_K) {
#pragma unroll
            for (int g = 0; g < 8; ++g) rs[g] = ((gcfp)e.f0)[row0 + (g >> 2) * 128 + (g & 3) * 16] * (MODE == M_Q ? QSCALE : 1.0f);
        }
        if constexpr (MODE == M_VT || MODE == M_POOL) {
#pragma unroll
            for (int bj = 0; bj < 2; ++bj) { cs[bj][0] = *(gcf4p)(e.f0 + col0 + bj * 128); cs[bj][1] = *(gcf4p)(e.f0 + col0 + bj * 128 + 4); }
        }
        if constexpr (MODE == M_RELU2 || MODE == M_PS) {
            const int bi = row0 < ML ? (row0 >> 12) : 16;
#pragma unroll
            for (int g = 0; g < 8; ++g) rs[g] = 1.0f / sqrtf(((gcfp)e.f0)[row0 + (g >> 2) * 128 + (g & 3) * 16] * (1.f / DM) + EPS);
#pragma unroll
            for (int bj = 0; bj < 2; ++bj) { cs[bj][0] = *(gcf4p)(e.f1 + (size_t)bi * e.goff + col0 + bj * 128); cs[bj][1] = *(gcf4p)(e.f1 + (size_t)bi * e.goff + col0 + bj * 128 + 4); }
        }
#pragma unroll
        for (int ai = 0; ai < 2; ++ai)
#pragma unroll
            for (int m = 0; m < 4; ++m)
#pragma unroll
                for (int bj = 0; bj < 2; ++bj) {
                    f32x4 sA = zero4, sB = zero4;
                    if constexpr (MODE == M_Q || MODE == M_K) sA[0] = rs[ai * 4 + m];
                    if constexpr (MODE == M_VT || MODE == M_POOL) { sA = cs[bj][0]; sB = cs[bj][1]; }
                    if constexpr (MODE == M_RELU2 || MODE == M_PS) { const float rr = rs[ai * 4 + m];
                        store8<MODE>(e, row0 + ai * 128 + m * 16, col0 + bj * 128, acc[ai][bj][m][0] * rr + cs[bj][0], acc[ai][bj][m][1] * rr + cs[bj][1], sA, sB); }
                    else
                    store8<MODE>(e, row0 + ai * 128 + m * 16, col0 + bj * 128, acc[ai][bj][m][0], acc[ai][bj][m][1], sA, sB);
                }
    }
}
struct Epi {
    int mode; EpiArgs e;
    __device__ __forceinline__ void operator()(const f32x4 (&acc)[2][2][4][2], const pg8::Unit& u, int wr, int wc, int fr, int fq) const {
        switch (mode) {
            case M_P: epi_loops<M_P>(e, acc, u, wr, wc, fr, fq); break;
            case M_UT: epi_loops<M_UT>(e, acc, u, wr, wc, fr, fq); break;
            case M_Q: epi_loops<M_Q>(e, acc, u, wr, wc, fr, fq); break;
            case M_K: epi_loops<M_K>(e, acc, u, wr, wc, fr, fq); break;
            case M_VT: epi_loops<M_VT>(e, acc, u, wr, wc, fr, fq); break;
            case M_POOL: epi_loops<M_POOL>(e, acc, u, wr, wc, fr, fq); break;
            case M_DFTC: epi_loops<M_DFTC>(e, acc, u, wr, wc, fr, fq); break;
            case M_RES: epi_loops<M_RES>(e, acc, u, wr, wc, fr, fq); break;
            case M_PS: epi_loops<M_PS>(e, acc, u, wr, wc, fr, fq); break;
            case M_F32: epi_loops<M_F32>(e, acc, u, wr, wc, fr, fq); break;
            default: epi_loops<M_RELU2>(e, acc, u, wr, wc, fr, fq); break;
        }
    }
};

struct Args { const float* in[21]; float* out; unsigned char* ws; int ph_lo, ph_hi; };
typedef const __attribute__((address_space(4))) Args* KArgs;

__device__ __forceinline__ void transpose_item(const float* W, int K, int N, bf16_t* WT, LAS float* scr, int item, int lane) {
    const int nblk = N / 32, kb = item / nblk, nb = item % nblk, k0 = 64 * kb, n0 = 32 * nb;
#pragma unroll 8
    for (int i = 0; i < 32; ++i) { const int kk = 2 * i + (lane >> 5); scr[kk * 33 + (lane & 31)] = W[(size_t)(k0 + kk) * N + n0 + (lane & 31)]; }
    asm volatile("s_waitcnt lgkmcnt(0)" ::: "memory");
    const int c = lane & 7;
#pragma unroll
    for (int j = 0; j < 4; ++j) { const int n = (lane >> 3) + 8 * j; const LAS float* s = scr + (8 * c) * 33 + n;
        u32x4 o; o.x = pk2(s[0 * 33], s[1 * 33]); o.y = pk2(s[2 * 33], s[3 * 33]); o.z = pk2(s[4 * 33], s[5 * 33]); o.w = pk2(s[6 * 33], s[7 * 33]);
        *(u32x4*)(WT + (size_t)(n0 + n) * K + k0 + 8 * c) = o; }
    asm volatile("s_waitcnt lgkmcnt(0)" ::: "memory");
}

__device__ __forceinline__ void phase_setup(KArgs ap, unsigned char* ws, LAS unsigned char* lds, int tid, int lane, int wave, const int BX, const int G) {
    {
        LAS float* S = (LAS float*)lds;
        LAS float* part = (LAS float*)(lds + 17 * 1024 * 4);
        float* mod = (float*)(ws + WS_MOD);
        if (BX < 192) {
            for (int i = tid; i < 17 * 1024; i += 512) { const int r = i >> 10, k = i & 1023; const float v = r < 16 ? ap->in[1][r * 1024 + k] : ap->in[3][k]; S[i] = v / (1.f + expf(-v)); }
        }
        __syncthreads();
        for (int item = BX; item < 192; item += G) {
            const int l = item / 96, n0 = (item % 96) * 64;
            const float* W = ap->in[4] + (size_t)l * 1024 * 6144 + n0 + lane;
            float acc[17];
#pragma unroll
            for (int r = 0; r < 17; ++r) acc[r] = 0.f;
            for (int k = wave * 128; k < wave * 128 + 128; k += 4) {
                const float w0 = W[(size_t)k * 6144], w1 = W[(size_t)(k + 1) * 6144], w2 = W[(size_t)(k + 2) * 6144], w3 = W[(size_t)(k + 3) * 6144];
#pragma unroll
                for (int r = 0; r < 17; ++r) { const f32x4 s = *(const LAS f32x4*)(S + r * 1024 + k); acc[r] += s[0] * w0 + s[1] * w1 + s[2] * w2 + s[3] * w3; }
            }
#pragma unroll
            for (int r = 0; r < 17; ++r) part[(wave * 17 + r) * 64 + lane] = acc[r];
            __syncthreads();
            for (int i = tid; i < 17 * 64; i += 512) { const int r = i >> 6, j = i & 63; float s = ap->in[5][l * 6144 + n0 + j];
#pragma unroll
                for (int w = 0; w < 8; ++w) s += part[(w * 17 + r) * 64 + j];
                mod[(size_t)(l * 17 + r) * 6144 + n0 + j] = s; }
            __syncthreads();
        }
    }
    {
        LAS float* scr = (LAS float*)(lds + wave * 16384);
        const int gw = BX * 8 + wave, NGW = G * 8;
        constexpr int I_IN = 16 * 53, I_OUT = 16 * 32, I_1 = 16 * 128, I_2 = 64 * 32, I_L = I_IN + I_OUT + I_1 + I_2;
        for (int it = gw; it < 2 * I_L; it += NGW) {
            const int l = it / I_L; int r = it % I_L; unsigned char* wl = ws + l * WL;
            if (r < I_IN) { transpose_item(ap->in[8] + (size_t)l * 1024 * 1696, 1024, 1696, (bf16_t*)(wl + O_WIN), scr, r, lane); continue; } r -= I_IN;
            if (r < I_OUT) { transpose_item(ap->in[17] + (size_t)l * 1024 * 1024, 1024, 1024, (bf16_t*)(wl + O_WOUT), scr, r, lane); continue; } r -= I_OUT;
            if (r < I_1) { transpose_item(ap->in[18] + (size_t)l * 1024 * 4096, 1024, 4096, (bf16_t*)(wl + O_W1), scr, r, lane); continue; } r -= I_1;
            transpose_item(ap->in[19] + (size_t)l * 4096 * 1024, 4096, 1024, (bf16_t*)(wl + O_W2), scr, r, lane);
        }
    }
    {
        const int gt = BX * 512 + tid, NGT = G * 512;
        for (int l = 0; l < 2; ++l) {
            unsigned char* wl = ws + l * WL;
            { unsigned* z = (unsigned*)((bf16_t*)(wl + O_WIN) + (size_t)1696 * 1024); for (int i = gt; i < 96 * 1024 / 2; i += NGT) z[i] = 0u; }
            { bf16_t* o = (bf16_t*)(wl + O_WUQ); const float* w = ap->in[14] + (size_t)l * 256 * 384; const float* gq = ap->in[13] + l * 256;
              for (int i = gt; i < 512 * 256; i += NGT) { const int n = i >> 8, k = i & 255; o[i] = (bf16_t)(n < 384 ? f2bf(gq[k] * w[k * 384 + n]) : 0u); } }
            { bf16_t* ok = (bf16_t*)(wl + O_WK); bf16_t* ov = (bf16_t*)(wl + O_WV); const float* w = ap->in[16] + (size_t)l * 128 * 512; const float* gk = ap->in[15] + l * 128;
              for (int i = gt; i < 256 * 128; i += NGT) { const int n = i >> 7, k = i & 127, h = n >> 6, d = n & 63; const float gg = gk[k];
                  ok[i] = (bf16_t)f2bf(gg * w[k * 512 + h * 128 + d]); ov[i] = (bf16_t)f2bf(gg * w[k * 512 + h * 128 + 64 + d]); } }
            { bf16_t* o = (bf16_t*)(wl + O_WF); const float* fw = ap->in[9] + (size_t)l * 256 * 256;
              for (int i = gt; i < 512 * 256; i += NGT) { const int r = i >> 8, kin = i & 255, part = r >> 8, n = r & 255, h = kin >> 6, c = kin & 63; float s = 0.f;
                  for (int k2 = 0; k2 < 64; ++k2) { const float ang = (float)((c * k2) & 63) * (1.f / 32.f); const float tr = part ? sinpif(ang) : cospif(ang); s += tr * fw[(h * 64 + k2) * 256 + n]; }
                  o[i] = (bf16_t)f2bf(s); } }
            { bf16_t* o = (bf16_t*)(wl + O_POOL); const float* pw = ap->in[11] + (size_t)l * 4 * 64 * 64;
              for (int i = gt; i < 256 * 256; i += NGT) { const int r = i >> 8, k = i & 255, g = r >> 6, n = r & 63; o[i] = (bf16_t)((k >> 6) == g ? f2bf(pw[(g * 64 + (k & 63)) * 64 + n]) : 0u); } }
        }
        { float* tab = (float*)(ws + WS_ROPE); for (int i = gt; i < 512; i += NGT) { float sn, cs; sincosf((float)(i >> 3) * invfreq(i & 7), &sn, &cs); tab[2 * i] = cs; tab[2 * i + 1] = sn; } }
        { u32x4* z = (u32x4*)(ws + WS_RSS); for (int i = gt; i < (int)(3 * RSS_STRIDE / 16); i += NGT) z[i] = (u32x4){0u, 0u, 0u, 0u}; }
        { u32x4* o = (u32x4*)(ws + WS_DFT);
          for (int i = gt; i < 2 * 2048 * 512; i += NGT) { const int part = i >> 20, ii = i & ((1 << 20) - 1), row = ii >> 9, t0 = (ii & 511) * 8; float v[8];
#pragma unroll
              for (int e = 0; e < 8; ++e) { const float ang = (float)(((row + 1) * (t0 + e)) & 4095) * (1.f / 2048.f); v[e] = part ? sinpif(ang) : cospif(ang); }
              u32x4 w; w.x = pk2(v[0], v[1]); w.y = pk2(v[2], v[3]); w.z = pk2(v[4], v[5]); w.w = pk2(v[6], v[7]); o[i] = w; } }
        { u32x4* o = (u32x4*)(ws + WS_DFTC);
          for (int i = gt; i < 256 * 64; i += NGT) { const int row = i >> 6, j0 = (i & 63) * 8; float v[8];
#pragma unroll
              for (int e = 0; e < 8; ++e) { const int j = j0 + e, t = j & 255; const float ang = (float)((row * t) & 255) * (1.f / 128.f); v[e] = (j >> 8) ? -sinpif(ang) : cospif(ang); }
              u32x4 w; w.x = pk2(v[0], v[1]); w.y = pk2(v[2], v[3]); w.z = pk2(v[4], v[5]); w.w = pk2(v[6], v[7]); o[i] = w; } }
    }
}

__device__ __forceinline__ void phase_vectors(KArgs ap, unsigned char* ws, LAS unsigned char* lds, int tid, int lane, int wave, const int BX, const int G) {
    const float* mod = (const float*)(ws + WS_MOD);
    float* vec = (float*)(ws + WS_VEC);
    { const int gt = BX * 512 + tid, NGT = G * 512;
      for (int i = gt; i < 2 * 17 * 1024; i += NGT) { const int l = i / (17 * 1024), r = (i >> 10) % 17, k = i & 1023; vec[V_GN2 + i] = ap->in[7][l * 1024 + k] * (1.0f + mod[(size_t)(l * 17 + r) * 6144 + 4096 + k]); }
      for (int i = gt; i < 17 * 1024; i += NGT) { const int r = i >> 10, k = i & 1023; vec[V_GN1 + i] = ap->in[6][1024 + k] * (1.0f + mod[(size_t)(17 + r) * 6144 + 1024 + k]); } }
    LAS float* S = (LAS float*)lds;
    LAS float* part = (LAS float*)(lds + 17 * 1024 * 4);
    for (int item = BX; item < 156; item += G) {
        const bool up = item < 128;
        const int l = up ? item / 64 : 1, n0 = up ? (item % 64) * 64 : (item - 128) * 64, N = up ? 4096 : 1696, soff = up ? 3072 : 0;
        const float* Wb = up ? ap->in[18] + (size_t)l * 1024 * 4096 : ap->in[8] + (size_t)1024 * 1696;
        __syncthreads();
        for (int i = tid; i < 17 * 1024; i += 512) { const int r = i >> 10, k = i & 1023; S[i] = mod[(size_t)(l * 17 + r) * 6144 + soff + k]; }
        __syncthreads();
        const bool cv = n0 + lane < N;
        const float* W = Wb + n0 + (cv ? lane : 0);
        float acc[17];
#pragma unroll
        for (int r = 0; r < 17; ++r) acc[r] = 0.f;
        for (int k = wave * 128; k < wave * 128 + 128; k += 4) {
            const float w0 = W[(size_t)k * N], w1 = W[(size_t)(k + 1) * N], w2 = W[(size_t)(k + 2) * N], w3 = W[(size_t)(k + 3) * N];
#pragma unroll
            for (int r = 0; r < 17; ++r) { const f32x4 sv = *(const LAS f32x4*)(S + r * 1024 + k); acc[r] += sv[0] * w0 + sv[1] * w1 + sv[2] * w2 + sv[3] * w3; }
        }
#pragma unroll
        for (int r = 0; r < 17; ++r) part[(wave * 17 + r) * 64 + lane] = cv ? acc[r] : 0.f;
        __syncthreads();
        for (int i = tid; i < 17 * 64; i += 512) { const int r = i >> 6, j = i & 63; float sum = 0.f;
#pragma unroll
            for (int w = 0; w < 8; ++w) sum += part[(w * 17 + r) * 64 + j];
            if (up) vec[V_CB2 + (size_t)(l * 17 + r) * 4096 + n0 + j] = sum; else vec[V_CB1 + (size_t)r * 1792 + n0 + j] = sum; }
    }
    __syncthreads();
}
constexpr int RPI = 4;
__device__ __forceinline__ void phase_norm_mod(const float* xl, const float* xc, const float* g, const float* mod, int shoff, int scoff, bf16_t* H, int nrows, int lane, int wave, const int BX, const int G) {
    const int gw = BX * 8 + wave, NGW = G * 8;
    for (int row0 = gw; row0 < nrows; row0 += NGW * RPI) {
        f32x4 v[RPI][4]; float ss[RPI];
#pragma unroll
        for (int i = 0; i < RPI; ++i) { const int row = row0 + i * NGW; ss[i] = 0.f;
            if (row < nrows) { const float* src = row < ML ? xl + (size_t)row * DM : xc + (size_t)(row - ML) * DM;
#pragma unroll
                for (int j = 0; j < 4; ++j) v[i][j] = *(const f32x4*)(src + lane * 4 + 256 * j); }
            else {
#pragma unroll
                for (int j = 0; j < 4; ++j) v[i][j] = (f32x4){0.f, 0.f, 0.f, 0.f}; } }
#pragma unroll
        for (int i = 0; i < RPI; ++i) {
#pragma unroll
            for (int j = 0; j < 4; ++j) ss[i] += (v[i][j][0] * v[i][j][0] + v[i][j][1] * v[i][j][1]) + (v[i][j][2] * v[i][j][2] + v[i][j][3] * v[i][j][3]); }
#pragma unroll
        for (int o = 1; o < 64; o <<= 1) {
#pragma unroll
            for (int i = 0; i < RPI; ++i) ss[i] += shx(ss[i], o, lane); }
#pragma unroll
        for (int i = 0; i < RPI; ++i) { const int row = row0 + i * NGW;
            if (row < nrows) {
                const float rr = 1.0f / sqrtf(ss[i] * (1.f / DM) + EPS);
                const float* mv = mod + (size_t)(row < ML ? (row >> 12) : 16) * 6144;
#pragma unroll
                for (int j = 0; j < 4; ++j) { const int col = lane * 4 + 256 * j;
                    const f32x4 gg = *(const f32x4*)(g + col), sc = *(const f32x4*)(mv + scoff + col), sh = *(const f32x4*)(mv + shoff + col);
                    const f32x4 o = (v[i][j] * rr * gg) * (sc + 1.0f) + sh;
                    u32x2 w; w.x = cvt_pk_bf16(o[0], o[1]); w.y = cvt_pk_bf16(o[2], o[3]);
                    *(u32x2*)(H + (size_t)row * DM + col) = w; } } }
    }
}
__device__ __forceinline__ void phase_final_norm(float* x, const float* g, int lane, int wave, const int BX, const int G) {
    const int gw = BX * 8 + wave, NGW = G * 8;
    for (int row0 = gw; row0 < ML; row0 += NGW * RPI) {
        f32x4 v[RPI][4]; float ss[RPI];
#pragma unroll
        for (int i = 0; i < RPI; ++i) { const int row = row0 + i * NGW; ss[i] = 0.f;
#pragma unroll
            for (int j = 0; j < 4; ++j) v[i][j] = *(const f32x4*)(x + (size_t)row * DM + lane * 4 + 256 * j); }
#pragma unroll
        for (int i = 0; i < RPI; ++i) {
#pragma unroll
            for (int j = 0; j < 4; ++j) ss[i] += (v[i][j][0] * v[i][j][0] + v[i][j][1] * v[i][j][1]) + (v[i][j][2] * v[i][j][2] + v[i][j][3] * v[i][j][3]); }
#pragma unroll
        for (int o = 1; o < 64; o <<= 1) {
#pragma unroll
            for (int i = 0; i < RPI; ++i) ss[i] += shx(ss[i], o, lane); }
#pragma unroll
        for (int i = 0; i < RPI; ++i) { const int row = row0 + i * NGW;
            const float rr = 1.0f / sqrtf(ss[i] * (1.f / DM) + EPS);
#pragma unroll
            for (int j = 0; j < 4; ++j) { const int col = lane * 4 + 256 * j; const f32x4 gg = *(const f32x4*)(g + col); *(f32x4*)(x + (size_t)row * DM + col) = v[i][j] * rr * gg; } }
    }
}

__device__ __forceinline__ void phase_token_local(const bf16_t* P, float* rq, float* rkv, bf16_t* Kc, bf16_t* MIX, bf16_t* POOLIN, const float* conv_w, const float* ropetab, int tid, int lane, int wave, const int BX, const int G) {
    const int gw = BX * 8 + wave, NGW = G * 8;
    for (int row0 = gw; row0 < MT; row0 += NGW * RPI) {
        u32x2 cq[RPI]; unsigned ck[RPI]; float sq[RPI], sk[RPI];
#pragma unroll
        for (int i = 0; i < RPI; ++i) { const int row = min(row0 + i * NGW, MT - 1); const GAS bf16_t* pr = (const GAS bf16_t*)P + (size_t)row * LDP;
            cq[i] = *(const GAS u32x2*)(pr + 1280 + lane * 4); ck[i] = *(const GAS unsigned*)(pr + 1536 + lane * 2); }
#pragma unroll
        for (int i = 0; i < RPI; ++i) { const float a0 = bflo(cq[i].x), a1 = bfhi(cq[i].x), a2 = bflo(cq[i].y), a3 = bfhi(cq[i].y), k0 = bflo(ck[i]), k1 = bfhi(ck[i]);
            sq[i] = (a0 * a0 + a1 * a1) + (a2 * a2 + a3 * a3); sk[i] = k0 * k0 + k1 * k1; }
#pragma unroll
        for (int o = 1; o < 64; o <<= 1) {
#pragma unroll
            for (int i = 0; i < RPI; ++i) { sq[i] += shx(sq[i], o, lane); sk[i] += shx(sk[i], o, lane); } }
#pragma unroll
        for (int i = 0; i < RPI; ++i) { const int row = row0 + i * NGW;
            if (row < MT && lane == 0) { ((GAS float*)rq)[row] = 1.0f / sqrtf(sq[i] * (1.f / 256.f) + EPS); ((GAS float*)rkv)[row] = 1.0f / sqrtf(sk[i] * (1.f / 128.f) + EPS); } }
    }
    {
        const int gt0 = BX * 512 + tid, NGT0 = G * 512;
        for (int e = gt0; e < MT * 4; e += NGT0) {
            const int row = e >> 2, L = e & 3;
            const bool lat = row < ML; int b, t, key;
            if (lat) { b = row >> 12; t = row & 4095; key = CTX + t; } else { const int rr = row - ML; b = rr >> 8; t = rr & 255; key = t; }
            const GAS bf16_t* pr = (const GAS bf16_t*)P + (size_t)row * LDP + 1664;
            const u32x4 own = *(const GAS u32x4*)(pr + 8 * L), par = *(const GAS u32x4*)(pr + 8 * (L ^ 1));
            u32x4 outw = own;
            if (lat) {
                const int ipos = (L & 2) ? (t & 63) : (t >> 6);
                const GAS f32x4* tb = (const GAS f32x4*)(ropetab + ipos * 16);
                const f32x4 t0 = tb[0], t1 = tb[1], t2 = tb[2], t3 = tb[3];
                const float sg = (L & 1) ? 1.0f : -1.0f;
                float xo[8] = {bflo(own.x), bfhi(own.x), bflo(own.y), bfhi(own.y), bflo(own.z), bfhi(own.z), bflo(own.w), bfhi(own.w)};
                float xp[8] = {bflo(par.x), bfhi(par.x), bflo(par.y), bfhi(par.y), bflo(par.z), bfhi(par.z), bflo(par.w), bfhi(par.w)};
                float cs[8] = {t0[0], t0[2], t1[0], t1[2], t2[0], t2[2], t3[0], t3[2]}, sn[8] = {t0[1], t0[3], t1[1], t1[3], t2[1], t2[3], t3[1], t3[3]};
                float o[8];
#pragma unroll
                for (int j = 0; j < 8; ++j) o[j] = xo[j] * cs[j] + sg * xp[j] * sn[j];
                outw.x = pk2(o[0], o[1]); outw.y = pk2(o[2], o[3]); outw.z = pk2(o[4], o[5]); outw.w = pk2(o[6], o[7]);
            }
#pragma unroll
            for (int h = 0; h < 4; ++h) *(GAS u32x4*)((GAS bf16_t*)Kc + (size_t)((b * 4 + h) * NKEY + key) * QKD + 64 + 8 * L) = outw;
        }
    }
    const int rpb = (MT + G - 1) / G;
    const int rbeg = BX * rpb, rend = min(rbeg + rpb, MT);
    const int c16 = tid & 63, ch = c16 * 4;
    const f32x4 cw0 = *(const f32x4*)(conv_w + ch), cw1 = *(const f32x4*)(conv_w + 256 + ch), cw2 = *(const f32x4*)(conv_w + 512 + ch);
    const int hw = 1 << (c16 >> 4);
    for (int row = rbeg + (tid >> 6); row < rend; row += 8) {
        int t, n; if (row < ML) { t = row & 4095; n = SEQ; } else { t = (row - ML) & 255; n = CTX; }
        const bf16_t* pr = P + (size_t)row * LDP;
        const u32x2 bg = *(const u32x2*)(pr + 256 + ch), cg = *(const u32x2*)(pr + 512 + ch), xi = *(const u32x2*)(pr + 768 + ch);
        const bool hp = t > 0, hn = t < n - 1;
        const bf16_t* pp = hp ? pr - LDP : pr; const bf16_t* pn = hn ? pr + LDP : pr;
        const u32x2 c0 = *(const u32x2*)(pp + 512 + ch), x0 = *(const u32x2*)(pp + 768 + ch), c2 = *(const u32x2*)(pn + 512 + ch), x2 = *(const u32x2*)(pn + 768 + ch);
        const bf16_t* pq = pr + 1024 + ch;
        u32x2 tap[16];
#pragma unroll
        for (int k = 0; k < 16; ++k) { const int d = k - 8; const bool ok = (d >= -hw) && (d < hw) && (t + d >= 0) && (t + d < n);
            tap[k] = *(const u32x2*)(pq + (ptrdiff_t)(ok ? d : 0) * LDP); if (!ok) tap[k] = (u32x2){0u, 0u}; }
        const u32x2 u0 = *(const u32x2*)pq;
        {
            const f32x4 z = (f32x4){bflo(cg.x) * bflo(xi.x), bfhi(cg.x) * bfhi(xi.x), bflo(cg.y) * bflo(xi.y), bfhi(cg.y) * bfhi(xi.y)};
            const f32x4 zp = (f32x4){bflo(c0.x) * bflo(x0.x), bfhi(c0.x) * bfhi(x0.x), bflo(c0.y) * bflo(x0.y), bfhi(c0.y) * bfhi(x0.y)};
            const f32x4 zn = (f32x4){bflo(c2.x) * bflo(x2.x), bfhi(c2.x) * bfhi(x2.x), bflo(c2.y) * bflo(x2.y), bfhi(c2.y) * bfhi(x2.y)};
            const f32x4 y = z * cw1 + zp * (hp ? cw0 : cw0 * 0.f) + zn * (hn ? cw2 : cw2 * 0.f);
            u32x2 w; w.x = cvt_pk_bf16(bflo(bg.x) * y[0], bfhi(bg.x) * y[1]); w.y = cvt_pk_bf16(bflo(bg.y) * y[2], bfhi(bg.y) * y[3]);
            *(u32x2*)(MIX + (size_t)row * DM + 256 + ch) = w;
        }
        {
            f32x4 sacc = (f32x4){0.f, 0.f, 0.f, 0.f};
#pragma unroll
            for (int k = 0; k < 16; ++k) sacc += (f32x4){bflo(tap[k].x), bfhi(tap[k].x), bflo(tap[k].y), bfhi(tap[k].y)};
            const int lo = max(t - hw, 0), hi = min(t + hw - 1, n - 1);
            const float ic = 1.0f / (float)(hi - lo + 1);
            u32x2 w; w.x = cvt_pk_bf16(sacc[0] * ic - bflo(u0.x), sacc[1] * ic - bfhi(u0.x)); w.y = cvt_pk_bf16(sacc[2] * ic - bflo(u0.y), sacc[3] * ic - bfhi(u0.y));
            *(u32x2*)(POOLIN + (size_t)row * 256 + ch) = w;
        }
    }
}

__device__ __forceinline__ void phase_dft_combine(unsigned char* ws, int tid, int lane, int wave, const int BX, const int G) {
    const GAS float* PT = (const GAS float*)(ws + WS_PT); const GAS float* QT = (const GAS float*)(ws + WS_QT);
    GAS bf16_t* MIX = (GAS bf16_t*)(ws + WS_MIX);
    const int gt = BX * 512 + tid, NGT = G * 512;
    for (int i = gt; i < 2048 * 512; i += NGT) {
        const int r = i >> 9, col = (i & 511) * 8, b = col >> 8, n = col & 255, k1 = r + 1;
        const f32x4 p0 = *(const GAS f32x4*)(PT + (size_t)r * 4096 + col), p1 = *(const GAS f32x4*)(PT + (size_t)r * 4096 + col + 4);
        const f32x4 q0 = *(const GAS f32x4*)(QT + (size_t)r * 4096 + col), q1 = *(const GAS f32x4*)(QT + (size_t)r * 4096 + col + 4);
        const float sc = 1.f / 512.f;
        *(gv4p)(MIX + (size_t)(b * SEQ + k1) * DM + n) = pack8((p0 - q0) * sc, (p1 - q1) * sc);
        *(gv4p)(MIX + (size_t)(b * SEQ + 4096 - k1) * DM + n) = pack8((p0 + q0) * sc, (p1 + q1) * sc);
    }
    const GAS bf16_t* UT = (const GAS bf16_t*)(ws + WS_UT);
    const int gw = BX * 8 + wave, NGW = G * 8;
    for (int rowi = gw; rowi < 4096; rowi += NGW) {
        const GAS u32x4* src = (const GAS u32x4*)(UT + (size_t)rowi * 8192) + lane;
        float sacc = 0.f;
#pragma unroll
        for (int c = 0; c < 8; ++c) { const u32x4 w = src[c * 64]; sacc += (bflo(w.x) + bfhi(w.x)) + (bflo(w.y) + bfhi(w.y)) + (bflo(w.z) + bfhi(w.z)) + (bflo(w.w) + bfhi(w.w)); }
        sacc = wave_sum(sacc, lane);
        if (lane == 0) { const int b = rowi >> 8, n = rowi & 255; MIX[(size_t)(b * SEQ) * DM + n] = (bf16_t)f2bf(sacc * (1.f / 512.f)); }
    }
}

constexpr int KROW = 208, VROW = 144, KBUF = 64 * KROW, VBUF = 64 * VROW, ABUF = KBUF + VBUF;
__device__ __forceinline__ void attn_unit(LAS unsigned char* lds, const bf16_t* Qb, const bf16_t* Kb, const bf16_t* Vtb, int nk, bf16_t* Ob, bool rope, int tok0, const int tid, const float* ropetab) {
    const int lane = tid & 63, r = lane & 31, hi = lane >> 5, wid = tid >> 6;
    bf16x8 qf[6];
    const bf16_t* qrow = Qb + (size_t)(wid * 32 + r) * 384 + 8 * hi;
#pragma unroll
    for (int d0 = 0; d0 < 6; ++d0) qf[d0] = *(const bf16x8*)(qrow + d0 * 16);
    if (rope) {
        const int t = tok0 + wid * 32 + r;
#pragma unroll
        for (int d0 = 4; d0 < 6; ++d0) {
            const int ipos = d0 == 4 ? (t >> 6) : (t & 63);
            bf16x8 o;
#pragma unroll
            for (int j = 0; j < 8; ++j) {
                const float own = bf1((bf16_t)qf[d0][j]);
                const float partner = shx(own, 32, lane);
                const f32x2 csn = *(const GAS f32x2*)(ropetab + (ipos * 8 + j) * 2); const float cs = csn[0], sn = csn[1];
                o[j] = (short)f2bf(own * cs + (hi ? partner : -partner) * sn);
            }
            qf[d0] = o;
        }
    }
    const int kc0 = tid, kc1 = tid + 512;
    const int kr0 = kc0 / 12, kcc0 = kc0 % 12, kr1 = kc1 / 12, kcc1 = kc1 % 12;
    const bool k1v = kc1 < 768;
    const int vr = tid >> 3, vcc = tid & 7;
    const bf16_t* kg0 = Kb + (size_t)kr0 * QKD + kcc0 * 8;
    const bf16_t* kg1 = Kb + (size_t)kr1 * QKD + kcc1 * 8;
    const bf16_t* vg = Vtb + (size_t)vr * NKEY + vcc * 8;
    const int kl0 = kr0 * KROW + kcc0 * 16, kl1 = kr1 * KROW + kcc1 * 16, vl = KBUF + vr * VROW + vcc * 16;
    const int NT = nk >> 6;
    u32x4 sk0, sk1 = (u32x4){0u, 0u, 0u, 0u}, sv;
    sk0 = *(const u32x4*)kg0; if (k1v) sk1 = *(const u32x4*)kg1; sv = *(const u32x4*)vg;
    *(LAS u32x4*)(lds + kl0) = sk0; if (k1v) *(LAS u32x4*)(lds + kl1) = sk1; *(LAS u32x4*)(lds + vl) = sv;
    __syncthreads();
    f32x16 ot0, ot1;
#pragma unroll
    for (int i = 0; i < 16; ++i) { ot0[i] = 0.f; ot1[i] = 0.f; }
    float l_run = 0.f;
    f32x16 negm;
#pragma unroll
    for (int i = 0; i < 16; ++i) negm[i] = 0.f;
    asm volatile("" : "+v"(negm));
    for (int tI = 0; tI < NT; ++tI) {
        LAS unsigned char* cur = lds + (tI & 1) * ABUF;
        LAS unsigned char* nxt = lds + ((tI + 1) & 1) * ABUF;
        const bool more = tI + 1 < NT;
        if (more) { const size_t ko = (size_t)(tI + 1) * 64 * QKD; sk0 = *(const u32x4*)(kg0 + ko); if (k1v) sk1 = *(const u32x4*)(kg1 + ko); sv = *(const u32x4*)(vg + (tI + 1) * 64); }
        f32x16 s0, s1;
        __builtin_amdgcn_s_setprio(1);
#pragma unroll
        for (int d0 = 0; d0 < 6; ++d0) {
            const bf16x8 a0 = *(const LAS bf16x8*)(cur + r * KROW + d0 * 32 + hi * 16);
            const bf16x8 a1 = *(const LAS bf16x8*)(cur + (32 + r) * KROW + d0 * 32 + hi * 16);
            if (d0 == 0) { s0 = __builtin_amdgcn_mfma_f32_32x32x16_bf16(a0, qf[0], negm, 0, 0, 0); s1 = __builtin_amdgcn_mfma_f32_32x32x16_bf16(a1, qf[0], negm, 0, 0, 0); }
            else { s0 = __builtin_amdgcn_mfma_f32_32x32x16_bf16(a0, qf[d0], s0, 0, 0, 0); s1 = __builtin_amdgcn_mfma_f32_32x32x16_bf16(a1, qf[d0], s1, 0, 0, 0); }
        }
        __builtin_amdgcn_s_setprio(0);
        float mx = s0[0];
#pragma unroll
        for (int i = 1; i < 16; ++i) mx = fmaxf(mx, s0[i]);
#pragma unroll
        for (int i = 0; i < 16; ++i) mx = fmaxf(mx, s1[i]);
        mx = fmaxf(mx, shx(mx, 32, lane));
        if (tI == 0 || __builtin_amdgcn_ballot_w64(mx > 8.0f) != 0ull) {
            const float dl = tI == 0 ? mx : fmaxf(mx, 0.f);
            const float alpha = tI == 0 ? 0.f : __builtin_amdgcn_exp2f(-dl);
#pragma unroll
            for (int i = 0; i < 16; ++i) { s0[i] -= dl; s1[i] -= dl; ot0[i] *= alpha; ot1[i] *= alpha; negm[i] -= dl; }
            l_run *= alpha;
            asm volatile("" : "+v"(negm));
        }
        float ps = 0.f;
#pragma unroll
        for (int i = 0; i < 16; ++i) { s0[i] = __builtin_amdgcn_exp2f(s0[i]); s1[i] = __builtin_amdgcn_exp2f(s1[i]); ps += s0[i] + s1[i]; }
        l_run += ps;
        bf16x8 pb[4];
#pragma unroll
        for (int s = 0; s < 4; ++s) {
            u32x4 w;
            if (s < 2) { w.x = cvt_pk_bf16(s0[8 * s + 0], s0[8 * s + 1]); w.y = cvt_pk_bf16(s0[8 * s + 2], s0[8 * s + 3]); w.z = cvt_pk_bf16(s0[8 * s + 4], s0[8 * s + 5]); w.w = cvt_pk_bf16(s0[8 * s + 6], s0[8 * s + 7]); }
            else { const int q = s - 2; w.x = cvt_pk_bf16(s1[8 * q + 0], s1[8 * q + 1]); w.y = cvt_pk_bf16(s1[8 * q + 2], s1[8 * q + 3]); w.z = cvt_pk_bf16(s1[8 * q + 4], s1[8 * q + 5]); w.w = cvt_pk_bf16(s1[8 * q + 6], s1[8 * q + 7]); }
            pb[s] = __builtin_bit_cast(bf16x8, w);
        }
#pragma unroll
        for (int s = 0; s < 4; ++s) {
            const int ko = (16 * s + 4 * hi) * 2;
            const s16x4 l0 = *(const LAS s16x4*)(cur + KBUF + r * VROW + ko), h0 = *(const LAS s16x4*)(cur + KBUF + r * VROW + ko + 16);
            const s16x4 l1 = *(const LAS s16x4*)(cur + KBUF + (32 + r) * VROW + ko), h1 = *(const LAS s16x4*)(cur + KBUF + (32 + r) * VROW + ko + 16);
            const bf16x8 a0 = __builtin_shufflevector(l0, h0, 0, 1, 2, 3, 4, 5, 6, 7), a1 = __builtin_shufflevector(l1, h1, 0, 1, 2, 3, 4, 5, 6, 7);
            __builtin_amdgcn_s_setprio(1);
            ot0 = __builtin_amdgcn_mfma_f32_32x32x16_bf16(a0, pb[s], ot0, 0, 0, 0);
            ot1 = __builtin_amdgcn_mfma_f32_32x32x16_bf16(a1, pb[s], ot1, 0, 0, 0);
            __builtin_amdgcn_s_setprio(0);
        }
        if (more) { *(LAS u32x4*)(nxt + kl0) = sk0; if (k1v) *(LAS u32x4*)(nxt + kl1) = sk1; *(LAS u32x4*)(nxt + vl) = sv; }
        __syncthreads();
    }
    const float lt = l_run + shx(l_run, 32, lane);
    const float il = 1.0f / lt;
    bf16_t* orow = Ob + (size_t)(wid * 32 + r) * DM;
#pragma unroll
    for (int g = 0; g < 4; ++g) {
        u32x2 w0, w1;
        w0.x = cvt_pk_bf16(ot0[4 * g] * il, ot0[4 * g + 1] * il); w0.y = cvt_pk_bf16(ot0[4 * g + 2] * il, ot0[4 * g + 3] * il);
        w1.x = cvt_pk_bf16(ot1[4 * g] * il, ot1[4 * g + 1] * il); w1.y = cvt_pk_bf16(ot1[4 * g + 2] * il, ot1[4 * g + 3] * il);
        *(u32x2*)(orow + 8 * g + 4 * hi) = w0;
        *(u32x2*)(orow + 32 + 8 * g + 4 * hi) = w1;
    }
}
__device__ __forceinline__ void phase_attention(LAS unsigned char* lds, unsigned char* ws, bool with_ctx, const int tid, const int bx, const int G) {
    const int vcu = (G % 8 == 0) ? (bx % 8) * (G / 8) + bx / 8 : bx;
    const bf16_t* Q = (const bf16_t*)(ws + WS_Q); const bf16_t* Qc = (const bf16_t*)(ws + WS_QC);
    const bf16_t* Kc = (const bf16_t*)(ws + WS_KC); const bf16_t* Vt = (const bf16_t*)(ws + WS_VT);
    bf16_t* MIX = (bf16_t*)(ws + WS_MIX);
    const int nunits = 1024 + (with_ctx ? 64 : 0);
    for (int u = vcu; u < nunits; u += G) {
        if (u < 1024) {
            const int bh = u >> 4, qb = u & 15, b = bh >> 2, h = bh & 3;
            attn_unit(lds, Q + (size_t)(b * SEQ + qb * 256) * 384 + h * QKD, Kc + (size_t)bh * NKEY * QKD, Vt + (size_t)bh * 64 * NKEY, NKEY,
                      MIX + (size_t)(b * SEQ + qb * 256) * DM + 768 + h * 64, true, qb * 256, tid, (const float*)(ws + WS_ROPE));
        } else {
            const int bh = u - 1024, b = bh >> 2, h = bh & 3;
            attn_unit(lds, Qc + (size_t)(b * CTX) * 384 + h * QKD, Kc + (size_t)bh * NKEY * QKD, Vt + (size_t)bh * 64 * NKEY, CTX,
                      MIX + (size_t)(ML + b * CTX) * DM + 768 + h * 64, false, 0, tid, (const float*)(ws + WS_ROPE));
        }
    }
}

struct Job { pg8::Gemm g; Epi e; };
__device__ __forceinline__ bool get_job(KArgs ap, unsigned char* ws, float* outp, int l, int kind, int j, Job& J) {
    unsigned char* wl = ws + (size_t)l * WL;
    const int Mx = l == 0 ? MT : ML;
    bf16_t* P = (bf16_t*)(ws + WS_P); bf16_t* MIX = (bf16_t*)(ws + WS_MIX); bf16_t* H = (bf16_t*)(ws + WS_H);
    const float* rq = (const float*)(ws + WS_RQ); const float* rkv = (const float*)(ws + WS_RKV);
    const float* mod = (const float*)(ws + WS_MOD) + (size_t)l * 17 * 6144;
    float* xc = (float*)(ws + WS_XC);
    J.e.e = EpiArgs{nullptr, nullptr, nullptr, nullptr, nullptr, nullptr, 0, 0};
    if (kind == 0) { if (j) return false;
        J.g = pg8::Gemm{H, (const bf16_t*)(wl + O_WIN), MT, LDP, DM, DM, DM}; J.e.mode = l == 0 ? M_P : M_PS; J.e.e.o0 = P; J.e.e.ld = LDP;
        J.e.e.f0 = (const float*)(ws + WS_RSS + 2 * RSS_STRIDE); J.e.e.f1 = (const float*)(ws + WS_VEC) + V_CB1; J.e.e.goff = LDP; return true; }
    if (kind == 1) { if (j) return false;
        J.g = pg8::Gemm{(const bf16_t*)(wl + O_WF), P, 512, Mx, 256, 256, LDP}; J.e.mode = M_UT; J.e.e.o0 = (bf16_t*)(ws + WS_UT); J.e.e.o1 = (bf16_t*)(ws + WS_UTC); return true; }
    if (kind == 2) {
        switch (j) {
            case 0: J.g = pg8::Gemm{(const bf16_t*)(ws + WS_DFT), (const bf16_t*)(ws + WS_UT), 2048, 4096, 4096, 4096, 8192}; J.e.mode = M_F32; J.e.e.o0 = (bf16_t*)(ws + WS_PT); return true;
            case 6: J.g = pg8::Gemm{(const bf16_t*)(ws + WS_DFT) + (size_t)2048 * 4096, (const bf16_t*)(ws + WS_UT) + 4096, 2048, 4096, 4096, 4096, 8192}; J.e.mode = M_F32; J.e.e.o0 = (bf16_t*)(ws + WS_QT); return true;
            case 1: J.g = pg8::Gemm{P + 1280, (const bf16_t*)(wl + O_WUQ), Mx, 512, 256, LDP, 256}; J.e.mode = M_Q; J.e.e.o0 = (bf16_t*)(ws + WS_Q); J.e.e.o1 = (bf16_t*)(ws + WS_QC); J.e.e.f0 = rq; return true;
            case 2: J.g = pg8::Gemm{P + 1536, (const bf16_t*)(wl + O_WK), MT, 256, 128, LDP, 128}; J.e.mode = M_K; J.e.e.o0 = (bf16_t*)(ws + WS_KC); J.e.e.f0 = rkv; return true;
            case 3: J.g = pg8::Gemm{(const bf16_t*)(wl + O_WV), P + 1536, 256, MT, 128, 128, LDP}; J.e.mode = M_VT; J.e.e.o0 = (bf16_t*)(ws + WS_VT); J.e.e.f0 = rkv; return true;
            case 4: J.g = pg8::Gemm{(const bf16_t*)(ws + WS_POOLIN), (const bf16_t*)(wl + O_POOL), Mx, 256, 256, 256, 256}; J.e.mode = M_POOL; J.e.e.o0 = MIX; J.e.e.f0 = ap->in[12] + l * 256; return true;
            case 5: if (l != 0) return false;
                J.g = pg8::Gemm{(const bf16_t*)(ws + WS_DFTC), (const bf16_t*)(ws + WS_UTC), 256, 4096, 512, 512, 512}; J.e.mode = M_DFTC; J.e.e.o0 = MIX; return true;
            default: return false;
        }
    }
    if (kind == 4 || kind == 7) { if (j) return false;
        if (kind == 4) J.g = pg8::Gemm{MIX, (const bf16_t*)(wl + O_WOUT), Mx, DM, DM, DM, DM};
        else J.g = pg8::Gemm{(const bf16_t*)(ws + WS_ACT), (const bf16_t*)(wl + O_W2), Mx, DM, DFF, DFF, DFF};
        J.e.mode = M_RES; J.e.e.o1 = (bf16_t*)mod; J.e.e.goff = kind == 4 ? 2048 : 5120;
        J.e.e.f0 = (l == 0 && kind == 4) ? ap->in[0] : outp; J.e.e.f1 = (l == 0 && kind == 4) ? ap->in[2] : xc; J.e.e.x0 = outp; J.e.e.x1 = xc;
        J.e.e.ld = kind == 4 ? 1 + l : (l == 0 ? 3 : 0); return true; }
    if (kind == 6) { if (j) return false;
        J.g = pg8::Gemm{H, (const bf16_t*)(wl + O_W1), Mx, DFF, DM, DM, DM}; J.e.mode = M_RELU2; J.e.e.o0 = (bf16_t*)(ws + WS_ACT); J.e.e.ld = DFF;
        J.e.e.f0 = (const float*)(ws + WS_RSS + (size_t)l * RSS_STRIDE); J.e.e.f1 = (const float*)(ws + WS_VEC) + V_CB2 + l * 17 * 4096; J.e.e.goff = DFF; return true; }
    return false;
}

#define XB_TMO      128
#define XB_XCNT(j)  (256  + 64 * (j))
#define XB_XSUB(j)  (1280 + 64 * (j))
#define XB_XGEN(j)  (2304 + 64 * (j))
#define XB_TOP      3328
#define XB_TOPGEN   3392
#define XCD_BAR_WORDS 3456
#define XB_SPIN_CAP (1u << 18)
__device__ __forceinline__ unsigned xb_ld(unsigned* p)              { return __hip_atomic_load(p, __ATOMIC_RELAXED, __HIP_MEMORY_SCOPE_AGENT); }
__device__ __forceinline__ unsigned xb_add(unsigned* p, unsigned v) { return __hip_atomic_fetch_add(p, v, __ATOMIC_RELAXED, __HIP_MEMORY_SCOPE_AGENT); }
__device__ __forceinline__ unsigned xb_xcc_id() { return (unsigned)__builtin_amdgcn_s_getreg((3 << 11) | 20) & 0xFu; }
#define XB_SPIN(cond, bar) do { unsigned _sp = 0; while (cond) { __builtin_amdgcn_s_sleep(1); \
    if ((++_sp & 255u) == 0u) { if (xb_ld(&(bar)[XB_TMO])) break; if (_sp > XB_SPIN_CAP) { atomicAdd(&(bar)[XB_TMO], 1u); break; } } } } while (0)
struct XcdBarrier { unsigned* bar; unsigned x; volatile LAS unsigned* st; };
__device__ __forceinline__ XcdBarrier xcd_barrier_post(unsigned* bar, volatile LAS unsigned* st) {
    XcdBarrier b; b.bar = bar; b.x = xb_xcc_id(); b.st = st;
    if (threadIdx.x == 0) (void)xb_add(&bar[XB_XCNT(b.x)], 1u);
    return b;
}
__device__ __forceinline__ void xcd_barrier_complete(unsigned* bar, unsigned x, unsigned& nloc, unsigned& nx) {
    const unsigned G = gridDim.x * gridDim.y * gridDim.z;
    unsigned sum, cnt, mine, sp = 0u;
    for (;;) {
        sum = 0u; cnt = 0u; mine = 0u;
#pragma unroll
        for (unsigned j = 0; j < 16; ++j) { const unsigned c = xb_ld(&bar[XB_XCNT(j)]); sum += c; cnt += (c > 0u) ? 1u : 0u; mine = (j == x) ? c : mine; }
        if (sum == G) break;
        __builtin_amdgcn_s_sleep(1);
        if ((++sp & 255u) == 0u) { if (xb_ld(&bar[XB_TMO])) break; if (sp > XB_SPIN_CAP) { atomicAdd(&bar[XB_TMO], 1u); break; } }
    }
    nloc = mine > 0u ? mine : 1u; nx = cnt > 0u ? cnt : 1u;
}
__device__ __forceinline__ void xcd_barrier(const XcdBarrier& b) {
    asm volatile("s_waitcnt vmcnt(0)" ::: "memory");
    __syncthreads();
    if (threadIdx.x == 0) {
        unsigned* bar = b.bar;
        __builtin_amdgcn_s_waitcnt(0);
        unsigned nloc = b.st[0], nx = b.st[1];
        if (nloc == 0u) { xcd_barrier_complete(bar, b.x, nloc, nx); b.st[0] = nloc; b.st[1] = nx; }
        const unsigned old = xb_add(&bar[XB_XSUB(b.x)], 1u);
        const unsigned gen = old / nloc;
        if (old + 1u == (gen + 1u) * nloc) {
            __builtin_amdgcn_fence(__ATOMIC_RELEASE, "agent");
            asm volatile("s_waitcnt vmcnt(0)" ::: "memory");
            const unsigned og = xb_add(&bar[XB_TOP], 1u);
            const unsigned tg = og / nx;
            if (og + 1u == (tg + 1u) * nx) xb_add(&bar[XB_TOPGEN], 1u);
            else XB_SPIN(xb_ld(&bar[XB_TOPGEN]) == tg, bar);
            __builtin_amdgcn_fence(__ATOMIC_ACQUIRE, "agent");
            xb_add(&bar[XB_XGEN(b.x)], 1u);
            asm volatile("s_waitcnt vmcnt(0)" ::: "memory");
        } else {
            XB_SPIN(xb_ld(&bar[XB_XGEN(b.x)]) == gen, bar);
            __builtin_amdgcn_fence(__ATOMIC_ACQUIRE, "agent");
            asm volatile("s_waitcnt vmcnt(0)" ::: "memory");
        }
    }
    __syncthreads();
}

constexpr int LDS_BYTES = 147456;
constexpr int N_PHASES = 2 + 9 * 2;
template <int PH> __device__ __forceinline__ void run_phase(LAS unsigned char* lds) {
    int tid = threadIdx.x; asm volatile("" : "+v"(tid));
    int BX = blockIdx.x, G = gridDim.x; asm volatile("" : "+s"(BX), "+s"(G));
    const int lane = tid & 63, wave = __builtin_amdgcn_readfirstlane(tid >> 6);
    KArgs ap = (KArgs)__builtin_amdgcn_kernarg_segment_ptr(); asm volatile("" : "+s"(ap));
    unsigned char* ws = ap->ws; float* outp = ap->out;
    if constexpr (PH == 0) {
        phase_setup(ap, ws, lds, tid, lane, wave, BX, G);
    } else if constexpr (PH == 1) {
        phase_vectors(ap, ws, lds, tid, lane, wave, BX, G);
        phase_norm_mod(ap->in[0], ap->in[2], ap->in[6], (const float*)(ws + WS_MOD), 0, 1024, (bf16_t*)(ws + WS_H), MT, lane, wave, BX, G);
    } else {
        constexpr int l = (PH - 2) / 9, kind = (PH - 2) % 9;
        const float* mod = (const float*)(ws + WS_MOD) + (size_t)l * 17 * 6144;
        if constexpr (kind == 1) phase_token_local((const bf16_t*)(ws + WS_P), (float*)(ws + WS_RQ), (float*)(ws + WS_RKV), (bf16_t*)(ws + WS_KC), (bf16_t*)(ws + WS_MIX), (bf16_t*)(ws + WS_POOLIN), ap->in[10] + l * 768, (const float*)(ws + WS_ROPE), tid, lane, wave, BX, G);
        if constexpr (kind == 3) { phase_dft_combine(ws, tid, lane, wave, BX, G); phase_attention(lds, ws, l == 0, tid, BX, G); }
        else if constexpr (kind == 5) { }
        else if constexpr (kind == 8) {
            if constexpr (l == 0) { }
            else phase_final_norm(outp, ap->in[20], lane, wave, BX, G);
        } else {
            Job J; int lr = l, kr = kind; asm volatile("" : "+s"(lr), "+s"(kr));
            for (int j = 0;; ++j) {
                KArgs ap2 = ap; unsigned char* ws2 = ws; float* out2 = outp; int tid2 = tid, BX2 = BX, G2 = G;
                asm volatile("" : "+s"(ap2), "+s"(ws2), "+s"(out2), "+v"(tid2), "+s"(BX2), "+s"(G2));
                if (kr == 2 && j > 6) break;
                const int jj = kr == 2 ? (j == 0 ? 0 : j == 1 ? 6 : j - 1) : j;
                if (!get_job(ap2, ws2, out2, lr, kr, jj, J)) break;
                const int rot = kr == 2 ? (jj == 6 ? 128 : jj == 2 ? 32 : jj == 3 ? 48 : jj == 4 ? 64 : jj == 5 ? 80 : 0) : 0;
                pg8::StaticOrder S; S.init(J.g.M, J.g.N, G2, (BX2 + rot) % G2);
                pg8::gemm_phase<Epi>(lds, J.g, S, J.e, tid2);
            }
        }
    }
}
__global__ void __launch_bounds__(512, 2) fwd_megakernel(Args a) {
    extern __shared__ __attribute__((aligned(16))) unsigned char lds_raw[];
    LAS unsigned char* lds = (LAS unsigned char*)lds_raw;
    cg::grid_group grid = cg::this_grid();
    const int ph_lo = a.ph_lo, ph_hi = a.ph_hi;
    for (int u = threadIdx.x; u < (LDS_BYTES - 131072) / 4; u += 512) ((LAS unsigned*)(lds + 131072))[u] = 0u;
    __syncthreads();
    if (blockIdx.x == 0) for (int u = threadIdx.x; u < (int)(CTL_BYTES / 4); u += 512) ((unsigned*)(a.ws + WS_CTL))[u] = 0u;
    XcdBarrier bar; bar.bar = (unsigned*)(a.ws + WS_CTL); bar.x = 0; bar.st = (volatile LAS unsigned*)(lds + 131072 + 64);
#ifndef EXP_SYNC
#define EXP_SYNC 0
#endif
#ifndef EXP_REP
#define EXP_REP(k) 0
#endif
#define PH_EMPTY(k) ((k) == 7 || (k) == 16 || (k) == 10)
#define PHASE(k) if (!PH_EMPTY(k) && ph_lo <= (k) && (k) < ph_hi) { run_phase<k>(lds); if (EXP_REP(k)) { grid.sync(); run_phase<k>(lds); } if ((k) + 1 < ph_hi) { if ((k) == 0) { grid.sync(); bar = xcd_barrier_post((unsigned*)(a.ws + WS_CTL), (volatile LAS unsigned*)(lds + 131072 + 64)); } else xcd_barrier(bar); if (EXP_SYNC) xcd_barrier(bar); } }
    PHASE(0) PHASE(1) PHASE(2) PHASE(3) PHASE(4) PHASE(5) PHASE(6) PHASE(7) PHASE(8) PHASE(9) PHASE(10)
    PHASE(11) PHASE(12) PHASE(13) PHASE(14) PHASE(15) PHASE(16) PHASE(17) PHASE(18) PHASE(19)
#undef PHASE
}

#ifndef MK_MULTI_LAUNCH
#define MK_MULTI_LAUNCH 0
#endif
extern "C" void kernel_launch(void* const* d_in, const int* in_sizes, int n_in, void* d_out, int out_size, void* d_ws, size_t ws_size, hipStream_t stream) {
    static int grid = 0;
    if (grid == 0) {
        int dev = 0, cus = 0, per_cu = 0;
        hipGetDevice(&dev);
        hipDeviceGetAttribute(&cus, hipDeviceAttributeMultiprocessorCount, dev);
        hipFuncSetAttribute((const void*)fwd_megakernel, hipFuncAttributeMaxDynamicSharedMemorySize, LDS_BYTES);
        hipOccupancyMaxActiveBlocksPerMultiprocessor(&per_cu, (const void*)fwd_megakernel, 512, LDS_BYTES);
        (void)hipGetLastError();
        if (cus <= 0) cus = 256;
        grid = cus;
        if (per_cu < 1) fprintf(stderr, "kernel_launch: occupancy query says %d blocks/CU\n", per_cu);
        if (ws_size < WS_END) { fprintf(stderr, "kernel_launch: workspace too small (%zu < %zu)\n", ws_size, (size_t)WS_END); grid = -1; }
    }
    if (grid < 0) return;
    Args a{};
    for (int i = 0; i < 21; ++i) a.in[i] = (const float*)d_in[i];
    a.out = (float*)d_out; a.ws = (unsigned char*)d_ws;
#if MK_MULTI_LAUNCH
    for (int ph = 0; ph < N_PHASES; ++ph) { a.ph_lo = ph; a.ph_hi = ph + 1; hipLaunchKernelGGL(fwd_megakernel, dim3(grid), dim3(512), LDS_BYTES, stream, a); }
#else
    a.ph_lo = 0; a.ph_hi = N_PHASES;
    void* args[] = {&a};
    hipError_t e = hipLaunchCooperativeKernel((const void*)fwd_megakernel, dim3(grid), dim3(512), args, LDS_BYTES, stream);
    if (e != hipSuccess) fprintf(stderr, "cooperative launch failed: %s (grid %d)\n", hipGetErrorString(e), grid);
#endif
}
```

```cpp
#include <hip/hip_runtime.h>
#include <hip/hip_cooperative_groups.h>
#include <cstdio>
#include <cstdint>
namespace cg = cooperative_groups;

#define LAS __attribute__((address_space(3)))
typedef unsigned short bf16_t;
typedef short bf16x8 __attribute__((ext_vector_type(8)));
typedef short s16x4 __attribute__((ext_vector_type(4)));
typedef float f32x4 __attribute__((ext_vector_type(4)));
typedef float f32x2 __attribute__((ext_vector_type(2)));
typedef float f32x16 __attribute__((ext_vector_type(16)));
typedef unsigned u32x4 __attribute__((ext_vector_type(4)));
typedef unsigned u32x2 __attribute__((ext_vector_type(2)));

constexpr int NB = 16, SEQ = 4096, DM = 1024, CTX = 256, ML = NB * SEQ, MC = NB * CTX, MT = ML + MC;
constexpr int LDP = 1792, DFF = 4096, NKEY = SEQ + CTX, NHEAD = 4, QKD = 96;
constexpr float EPS = 1e-6f;
constexpr float QSCALE = 0.10206207261596577f * 1.4426950408889634f;

constexpr size_t MiB = 1u << 20;
constexpr size_t WL = 24 * MiB;
constexpr size_t O_WIN = 0, O_WOUT = 3670016, O_W1 = 5767168, O_W2 = 14155776, O_WUQ = 22544384, O_WK = 22806528, O_WV = 22872064, O_WF = 22937600, O_POOL = 23199744;
constexpr size_t WS_CTL = 48 * MiB + 832 * 1024, CTL_BYTES = 16384;
constexpr size_t WS_MOD = 48 * MiB, WS_RQ = 49 * MiB, WS_RKV = 49 * MiB + 512 * 1024, WS_DFTC = 50 * MiB, WS_DFT = 51 * MiB, WS_XC = 115 * MiB, WS_H = 131 * MiB, WS_OV = 267 * MiB;
constexpr size_t WS_P = WS_OV, WS_MIX = WS_OV + 238 * MiB, WS_UT = WS_OV + 374 * MiB, WS_UTC = WS_OV + 438 * MiB, WS_Q = WS_OV + 442 * MiB, WS_QC = WS_OV + 490 * MiB,
                 WS_KC = WS_OV + 493 * MiB, WS_VT = WS_OV + 544 * MiB, WS_POOLIN = WS_OV + 578 * MiB, WS_ACT = WS_OV, WS_RSS = WS_OV + 613 * MiB, RSS_STRIDE = 512 * 1024, WS_VEC = WS_OV + 615 * MiB, WS_PT = WS_OV + 617 * MiB, WS_QT = WS_OV + 649 * MiB, WS_END = WS_OV + 681 * MiB;
constexpr size_t WS_ROPE = WS_VEC + 1 * MiB;
constexpr int V_GN2 = 0, V_CB2 = 2 * 17 * 1024, V_GN1 = V_CB2 + 2 * 17 * 4096, V_CB1 = V_GN1 + 17 * 1024;

__device__ __forceinline__ unsigned cvt_pk_bf16(float lo, float hi) { unsigned r; asm volatile("v_cvt_pk_bf16_f32 %0, %1, %2" : "=v"(r) : "v"(lo), "v"(hi)); return r; }
__device__ __forceinline__ unsigned f2bf(float f) { unsigned u = __builtin_bit_cast(unsigned, f); return (u + 0x7fffu + ((u >> 16) & 1u)) >> 16; }
__device__ __forceinline__ unsigned pk2(float lo, float hi) { return f2bf(lo) | (f2bf(hi) << 16); }
__device__ __forceinline__ float bflo(unsigned w) { return __uint_as_float(w << 16); }
__device__ __forceinline__ float bfhi(unsigned w) { return __uint_as_float(w & 0xffff0000u); }
__device__ __forceinline__ float bf1(bf16_t b) { return __uint_as_float((unsigned)b << 16); }
__device__ __forceinline__ float shx(float v, int mask, int lane) { return __builtin_bit_cast(float, __builtin_amdgcn_ds_bpermute((lane ^ mask) << 2, __builtin_bit_cast(int, v))); }
__device__ __forceinline__ float wave_sum(float v, int lane) {
#pragma unroll
    for (int o = 1; o < 64; o <<= 1) v += shx(v, o, lane);
    return v;
}
__device__ __forceinline__ float invfreq(int j) {
    return j == 0 ? 1.0f : j == 1 ? 0.31622776601683794f : j == 2 ? 0.1f : j == 3 ? 0.031622776601683794f : j == 4 ? 0.01f : j == 5 ? 0.0031622776601683794f : j == 6 ? 0.001f : 0.00031622776601683794f;
}

namespace pg8 {
constexpr int BM = 256, BK = 64, HALF = 128, HTB = HALF * BK * 2, STAGE_BYTES = 8 * HTB, NXCD = 8, WGM = 8;
__host__ __device__ __forceinline__ int lds_byte(int r, int c) { const int st = (r >> 4) * 2 + (c >> 5), rr = r & 15, cc = c & 31, ob = rr * 64 + cc * 2; return st * 1024 + (ob ^ (((ob >> 9) & 1) << 5)); }
__host__ __device__ __forceinline__ void stage_rc(int b, int& R, int& C) { const int st = b / 1024, sb = b % 1024, swz = sb ^ (((sb >> 9) & 1) << 5); R = (st >> 1) * 16 + swz / 64; C = (st & 1) * 32 + (swz % 64) / 2; }
__host__ __device__ __forceinline__ int perm32(int rho) { const int n = rho >> 4, i = rho & 15; return 8 * (i >> 2) + 4 * n + (i & 3); }
struct Unit { int pm, pn; };
__device__ __forceinline__ const char* uptr(const char* p) { const unsigned long long v = (unsigned long long)p; const unsigned lo = __builtin_amdgcn_readfirstlane((unsigned)v), hi = __builtin_amdgcn_readfirstlane((unsigned)(v >> 32)); return (const char*)(((unsigned long long)hi << 32) | lo); }
struct Gemm { const bf16_t* A; const bf16_t* Bt; int M, N, K, lda, ldb; };
struct StaticOrder {
    int nM, nN, nwg, G, c;
    __device__ void init(int M, int N, int G_, int c_) { nM = M / BM; nN = N / BM; nwg = nM * nN; G = G_; c = c_; }
    __device__ bool next(int i, Unit& u) const {
        const long L = (long)i * G + c; if (L >= nwg) return false;
        int wgid = (int)L; { const int q = nwg / NXCD, r = nwg % NXCD, xcd = wgid % NXCD, off = wgid / NXCD; wgid = (xcd < r ? xcd * (q + 1) : r * (q + 1) + (xcd - r) * q) + off; }
        const int nig = WGM * nN, gid = wgid / nig, fm = gid * WGM, gsz = (nM - fm) < WGM ? (nM - fm) : WGM;
        u.pm = fm + ((wgid % nig) % gsz); u.pn = (wgid % nig) / gsz; return true;
    }
};

template <class Epi>
__device__ __forceinline__ void gemm_phase(LAS unsigned char* lds, const Gemm g, const StaticOrder& S, const Epi& E, const int tid) {
    const int wid = __builtin_amdgcn_readfirstlane(tid >> 6), lane = tid & 63, wr = wid >> 2, wc = wid & 3, fr = lane & 15, fq = lane >> 4;
    const int K = g.K, nt = K / BK;
    unsigned voffA[2], voffB[2];
#pragma unroll
    for (int i = 0; i < 2; ++i) { int R, C; stage_rc(tid * 16 + i * 8192, R, C); const int Rb = (R & ~31) + perm32(R & 31);
        voffA[i] = (unsigned)(R * g.lda + C) * 2u; voffB[i] = (unsigned)(Rb * g.ldb + C) * 2u; }
    const size_t kstep = (size_t)(BK * 2);
    const size_t hsA = (size_t)HALF * g.lda * 2, hsB = (size_t)HALF * g.ldb * 2;
    const size_t tsA = 2 * hsA, tsB = 2 * hsB;
    const unsigned ldsw = (unsigned)wid * 1024u;
    const int aoff = lds_byte(wr * 64 + fr, fq * 8), boff = lds_byte(wc * 32 + fr, fq * 8);
#define PG8_SA(b, h) (((b) * 2 + (h)) * HTB)
#define PG8_SB(b, h) ((4 + (b) * 2 + (h)) * HTB)
#define PG8_STAGE(bufoff, gbase, voff) do { const char* _gb = uptr((const char*)(gbase)); _Pragma("unroll") for (int _i = 0; _i < 2; ++_i) \
        __builtin_amdgcn_global_load_lds((const unsigned*)(_gb + (voff)[_i]), (LAS unsigned*)(lds + (bufoff) + ldsw + _i * 8192), 16, 0, 0); } while (0)
#define PG8_LDA(dst, b, h) do { _Pragma("unroll") for (int m = 0; m < 4; ++m) _Pragma("unroll") for (int k = 0; k < 2; ++k) dst[m][k] = *(const LAS bf16x8*)(lds + PG8_SA(b, h) + aoff + m * 2048 + k * 1024); } while (0)
#define PG8_LDB(dst, b, h) do { _Pragma("unroll") for (int n = 0; n < 2; ++n) _Pragma("unroll") for (int k = 0; k < 2; ++k) dst[n][k] = *(const LAS bf16x8*)(lds + PG8_SB(b, h) + boff + n * 2048 + k * 1024); } while (0)
#define PG8_MMA(ai, bj, At, Bt) do { __builtin_amdgcn_s_setprio(1); _Pragma("unroll") for (int m = 0; m < 4; ++m) _Pragma("unroll") for (int n = 0; n < 2; ++n) _Pragma("unroll") for (int k = 0; k < 2; ++k) \
        acc[ai][bj][m][n] = __builtin_amdgcn_mfma_f32_16x16x32_bf16(Bt[n][k], At[m][k], acc[ai][bj][m][n], 0, 0, 0); __builtin_amdgcn_s_setprio(0); } while (0)
#define PG8_WAIT_V(n) asm volatile("s_waitcnt vmcnt(" #n ")" ::: "memory")
#define PG8_WAIT_L(n) asm volatile("s_waitcnt lgkmcnt(" #n ")" ::: "memory")
#define PG8_BAR __builtin_amdgcn_s_barrier()
#define PG8_SCHED __builtin_amdgcn_sched_barrier(0)
    Unit cur, nxt; int ui = 0;
    if (!S.next(0, cur)) return;
    f32x4 acc[2][2][4][2];
#pragma unroll
    for (int a = 0; a < 2; ++a)
#pragma unroll
        for (int b = 0; b < 2; ++b)
#pragma unroll
            for (int m = 0; m < 4; ++m)
#pragma unroll
                for (int n = 0; n < 2; ++n) acc[a][b][m][n] = (f32x4){0.f, 0.f, 0.f, 0.f};
    bf16x8 At[4][2], B0[2][2], B1[2][2];
    const char* cA = (const char*)g.A + (size_t)cur.pm * tsA; const char* cB = (const char*)g.Bt + (size_t)cur.pn * tsB;
    PG8_STAGE(PG8_SB(0, 0), cB, voffB); PG8_STAGE(PG8_SB(0, 1), cB + hsB, voffB); PG8_STAGE(PG8_SA(0, 0), cA, voffA); PG8_STAGE(PG8_SA(0, 1), cA + hsA, voffA);
    if (wr == 1) PG8_BAR;
    PG8_WAIT_V(2); PG8_BAR;
    PG8_STAGE(PG8_SB(1, 0), cB + kstep, voffB); PG8_STAGE(PG8_SA(1, 0), cA + kstep, voffA); PG8_STAGE(PG8_SB(1, 1), cB + hsB + kstep, voffB);
    PG8_WAIT_V(6); PG8_BAR;
    for (;;) {
        const bool has_next = S.next(ui + 1, nxt);
        const char* nA = has_next ? (const char*)g.A + (size_t)nxt.pm * tsA : cA; const char* nB = has_next ? (const char*)g.Bt + (size_t)nxt.pn * tsB : cB;
        for (int t = 0; t < nt; t += 2) {
            const bool last = (t == nt - 2);
            const char* a1 = cA + (size_t)(t + 1) * kstep;
            const char* a2 = last ? nA : cA + (size_t)(t + 2) * kstep; const char* b2 = last ? nB : cB + (size_t)(t + 2) * kstep;
            const char* a3 = a2 + kstep; const char* b3 = b2 + kstep;
            PG8_LDB(B0, 0, 0); PG8_LDB(B1, 0, 1); PG8_SCHED; PG8_LDA(At, 0, 0); PG8_STAGE(PG8_SA(1, 1), a1 + hsA, voffA);
            PG8_WAIT_V(8); PG8_WAIT_L(0); PG8_BAR; PG8_MMA(0, 0, At, B0); PG8_MMA(0, 1, At, B1); PG8_BAR; PG8_SCHED;
            PG8_LDA(At, 0, 1); PG8_STAGE(PG8_SB(0, 0), b2, voffB); PG8_STAGE(PG8_SB(0, 1), b2 + hsB, voffB); PG8_STAGE(PG8_SA(0, 0), a2, voffA);
            PG8_WAIT_V(8); PG8_WAIT_L(0); PG8_BAR; PG8_MMA(1, 0, At, B0); PG8_MMA(1, 1, At, B1); PG8_BAR; PG8_SCHED;
            PG8_LDB(B0, 1, 0); PG8_LDB(B1, 1, 1); PG8_SCHED; PG8_LDA(At, 1, 0); PG8_STAGE(PG8_SA(0, 1), a2 + hsA, voffA);
            PG8_WAIT_V(8); PG8_WAIT_L(0); PG8_BAR; PG8_MMA(0, 0, At, B0); PG8_MMA(0, 1, At, B1); PG8_BAR; PG8_SCHED;
            PG8_LDA(At, 1, 1); PG8_STAGE(PG8_SB(1, 0), b3, voffB); PG8_STAGE(PG8_SB(1, 1), b3 + hsB, voffB); PG8_STAGE(PG8_SA(1, 0), a3, voffA);
            PG8_WAIT_V(8); PG8_WAIT_L(0); PG8_BAR; PG8_MMA(1, 0, At, B0); PG8_MMA(1, 1, At, B1); PG8_BAR; PG8_SCHED;
        }
        if (wr == 0) PG8_BAR;
        E(acc, cur, wr, wc, fr, fq);
        if (!has_next) break;
#pragma unroll
        for (int a = 0; a < 2; ++a)
#pragma unroll
            for (int b = 0; b < 2; ++b)
#pragma unroll
                for (int m = 0; m < 4; ++m)
#pragma unroll
                    for (int n = 0; n < 2; ++n) acc[a][b][m][n] = (f32x4){0.f, 0.f, 0.f, 0.f};
        cur = nxt; cA = nA; cB = nB; ++ui;
        if (wr == 1) PG8_BAR;
    }
    PG8_WAIT_V(0);
    PG8_BAR;
#undef PG8_SA
#undef PG8_SB
#undef PG8_STAGE
#undef PG8_LDA
#undef PG8_LDB
#undef PG8_MMA
#undef PG8_WAIT_V
#undef PG8_WAIT_L
#undef PG8_BAR
#undef PG8_SCHED
}
}

enum { M_P = 0, M_UT = 1, M_Q = 2, M_K = 3, M_VT = 4, M_POOL = 5, M_DFT = 6, M_DFTC = 7, M_RES = 8, M_RELU2 = 9, M_PS = 10, M_F32 = 11 };
struct EpiArgs {
    bf16_t* o0; bf16_t* o1;
    const float* f0; const float* f1;
    float* x0; float* x1;
    int ld; int goff;
};
__device__ __forceinline__ u32x4 pack8(const f32x4& a, const f32x4& b) { u32x4 w; w.x = cvt_pk_bf16(a[0], a[1]); w.y = cvt_pk_bf16(a[2], a[3]); w.z = cvt_pk_bf16(b[0], b[1]); w.w = cvt_pk_bf16(b[2], b[3]); return w; }

#define GAS __attribute__((address_space(1)))
typedef GAS u32x4* gv4p; typedef GAS f32x4* gf4p; typedef const GAS f32x4* gcf4p; typedef const GAS float* gcfp;
template <int MODE> __device__ __forceinline__ void store8(const EpiArgs& e, int row, int col, f32x4 v0, f32x4 v1, const f32x4 sA, const f32x4 sB) {
    if constexpr (MODE == M_P || MODE == M_PS) {
        *(gv4p)(e.o0 + (size_t)row * e.ld + col) = pack8(v0, v1);
    } else if constexpr (MODE == M_UT) {
        const int part = row >> 8, n = row & 255;
        bf16_t* dst;
        if (col < ML) { const int b = col >> 12, t = col & 4095; dst = e.o0 + ((size_t)(b * 256 + n) * 8192 + part * 4096 + t); }
        else { const int cc = col - ML, b = cc >> 8, t = cc & 255; dst = e.o1 + ((size_t)(b * 256 + n) * 512 + part * 256 + t); }
        *(gv4p)dst = pack8(v0, v1);
    } else if constexpr (MODE == M_Q) {
        if (col < 384) {
            const float s = sA[0];
            bf16_t* dst = row < ML ? e.o0 + (size_t)row * 384 + col : e.o1 + (size_t)(row - ML) * 384 + col;
            *(gv4p)dst = pack8(v0 * s, v1 * s);
        }
    } else if constexpr (MODE == M_K) {
        const int h = col >> 6, d = col & 63; const float s = sA[0];
        int b, key; if (row < ML) { b = row >> 12; key = CTX + (row & 4095); } else { const int rr = row - ML; b = rr >> 8; key = rr & 255; }
        *(gv4p)(e.o0 + ((size_t)((b * 4 + h) * NKEY + key) * QKD + d)) = pack8(v0 * s, v1 * s);
    } else if constexpr (MODE == M_VT) {
        int b, key; if (col < ML) { b = col >> 12; key = CTX + (col & 4095); } else { const int cc = col - ML; b = cc >> 8; key = cc & 255; }
        const u32x4 w = pack8(v0 * sA, v1 * sB); const int half = (key >> 3) & 1;
        GAS bf16_t* d = (GAS bf16_t*)e.o0 + ((size_t)(b * 256 + row) * NKEY + (key & ~15));
        *(GAS u32x2*)(d + (half ? 4 : 0)) = (u32x2){w.x, w.y}; *(GAS u32x2*)(d + (half ? 12 : 8)) = (u32x2){w.z, w.w};
    } else if constexpr (MODE == M_POOL) {
        *(gv4p)(e.o0 + (size_t)row * DM + 512 + col) = pack8(v0 * sA, v1 * sB);
    } else if constexpr (MODE == M_DFT) {
        const int b = col >> 8, n = col & 255;
        *(gv4p)(e.o0 + (size_t)(b * SEQ + row) * DM + n) = pack8(v0 * (1.f / 512.f), v1 * (1.f / 512.f));
    } else if constexpr (MODE == M_F32) {
        GAS float* d = (GAS float*)e.o0 + (size_t)row * 4096 + col; *(gf4p)d = v0; *(gf4p)(d + 4) = v1;
    } else if constexpr (MODE == M_DFTC) {
        const int b = col >> 8, n = col & 255;
        *(gv4p)(e.o0 + (size_t)(ML + b * CTX + row) * DM + n) = pack8(v0 * (1.f / 128.f), v1 * (1.f / 128.f));
    } else if constexpr (MODE == M_RELU2) {
#pragma unroll
        for (int i = 0; i < 4; ++i) { const float a = fmaxf(v0[i], 0.f), b = fmaxf(v1[i], 0.f); v0[i] = a * a; v1[i] = b * b; }
        *(gv4p)(e.o0 + (size_t)row * e.ld + col) = pack8(v0, v1);
    }
}
template <int MODE> __device__ __forceinline__ void epi_loops(const EpiArgs& e, const f32x4 (&acc)[2][2][4][2], const pg8::Unit& u, int wr, int wc, int fr, int fq) {
    const int row0 = u.pm * 256 + wr * 64 + fr, col0 = u.pn * 256 + wc * 32 + 8 * fq;
    const f32x4 zero4 = (f32x4){0.f, 0.f, 0.f, 0.f};
    if constexpr (MODE == M_RES) {
        const int bi = row0 < ML ? (row0 >> 12) : 16;
        gcfp gp = (gcfp)((const float*)e.o1 + (size_t)bi * 6144 + e.goff + col0);
        f32x4 gt[2][2];
#pragma unroll
        for (int bj = 0; bj < 2; ++bj) { gt[bj][0] = *(gcf4p)(gp + bj * 128); gt[bj][1] = *(gcf4p)(gp + bj * 128 + 4); }
        const bool lat = row0 < ML;
        gcfp sbase = lat ? (gcfp)(e.f0 + (size_t)row0 * DM + col0) : (gcfp)(e.f1 + (size_t)(row0 - ML) * DM + col0);
        GAS float* dbase = lat ? (GAS float*)(e.x0 + (size_t)row0 * DM + col0) : (GAS float*)(e.x1 + (size_t)(row0 - ML) * DM + col0);
        const int emit = e.ld;
        unsigned char* wsb = (unsigned char*)e.x1 - WS_XC;
        const float* vec = (const float*)(wsb + WS_VEC);
        gcfp gnp = (gcfp)(vec + (emit == 3 ? V_GN1 : V_GN2 + (emit == 2 ? 17 * 1024 : 0)) + bi * 1024 + col0);
        GAS float* rss = (GAS float*)(wsb + WS_RSS + (size_t)(emit > 0 ? emit - 1 : 0) * RSS_STRIDE) + row0;
        GAS bf16_t* hbase = (GAS bf16_t*)(wsb + WS_H) + (size_t)row0 * DM + col0;
        f32x4 gn[2][2];
#pragma unroll
        for (int bj = 0; bj < 2; ++bj) { gn[bj][0] = emit ? *(gcf4p)(gnp + bj * 128) : zero4; gn[bj][1] = emit ? *(gcf4p)(gnp + bj * 128 + 4) : zero4; }
        const int lane_e = fq * 16 + fr;
        f32x4 cur[2][2], nxt[2][2];
#pragma unroll
        for (int bj = 0; bj < 2; ++bj) { cur[bj][0] = *(gcf4p)(sbase + bj * 128); cur[bj][1] = *(gcf4p)(sbase + bj * 128 + 4); }
#pragma unroll
        for (int g = 0; g < 8; ++g) {
            const int ai = g >> 2, m = g & 3;
            if (g + 1 < 8) { const int a2 = (g + 1) >> 2, m2 = (g + 1) & 3; const size_t off = (size_t)(a2 * 128 + m2 * 16) * DM;
#pragma unroll
                for (int bj = 0; bj < 2; ++bj) { nxt[bj][0] = *(gcf4p)(sbase + off + bj * 128); nxt[bj][1] = *(gcf4p)(sbase + off + bj * 128 + 4); } }
            const size_t offc = (size_t)(ai * 128 + m * 16) * DM;
            float sq = 0.f;
#pragma unroll
            for (int bj = 0; bj < 2; ++bj) {
                const f32x4 x0 = cur[bj][0] + gt[bj][0] * acc[ai][bj][m][0], x1 = cur[bj][1] + gt[bj][1] * acc[ai][bj][m][1];
                *(gf4p)(dbase + offc + bj * 128) = x0; *(gf4p)(dbase + offc + bj * 128 + 4) = x1;
                if (emit) { *(gv4p)(hbase + offc + bj * 128) = pack8(x0 * gn[bj][0], x1 * gn[bj][1]);
                    sq += (x0[0] * x0[0] + x0[1] * x0[1]) + (x0[2] * x0[2] + x0[3] * x0[3]) + (x1[0] * x1[0] + x1[1] * x1[1]) + (x1[2] * x1[2] + x1[3] * x1[3]); }
            }
            if (emit) { sq += shx(sq, 16, lane_e); sq += shx(sq, 32, lane_e); if (fq == 0) atomicAdd((float*)(rss + ai * 128 + m * 16), sq); }
            asm volatile("" ::: "memory");
#pragma unroll
            for (int bj = 0; bj < 2; ++bj) { cur[bj][0] = nxt[bj][0]; cur[bj][1] = nxt[bj][1]; }
        }
    } else {
        float rs[8]; f32x4 cs[2][2];
        if constexpr (MODE == M_Q || MODE == M_K) {
#pragma unroll
            for (int g = 0; g < 8; ++g) rs[g] = ((gcfp)e.f0)[row0 + (g >> 2) * 128 + (g & 3) * 16] * (MODE == M_Q ? QSCALE : 1.0f);
        }
        if constexpr (MODE == M_VT || MODE == M_POOL) {
#pragma unroll
            for (int bj = 0; bj < 2; ++bj) { cs[bj][0] = *(gcf4p)(e.f0 + col0 + bj * 128); cs[bj][1] = *(gcf4p)(e.f0 + col0 + bj * 128 + 4); }
        }
        if constexpr (MODE == M_RELU2 || MODE == M_PS) {
            const int bi = row0 < ML ? (row0 >> 12) : 16;
#pragma unroll
            for (int g = 0; g < 8; ++g) rs[g] = 1.0f / sqrtf(((gcfp)e.f0)[row0 + (g >> 2) * 128 + (g & 3) * 16] * (1.f / DM) + EPS);
#pragma unroll
            for (int bj = 0; bj < 2; ++bj) { cs[bj][0] = *(gcf4p)(e.f1 + (size_t)bi * e.goff + col0 + bj * 128); cs[bj][1] = *(gcf4p)(e.f1 + (size_t)bi * e.goff + col0 + bj * 128 + 4); }
        }
#pragma unroll
        for (int ai = 0; ai < 2; ++ai)
#pragma unroll
            for (int m = 0; m < 4; ++m)
#pragma unroll
                for (int bj = 0; bj < 2; ++bj) {
                    f32x4 sA = zero4, sB = zero4;
                    if constexpr (MODE == M_Q || MODE == M_K) sA[0] = rs[ai * 4 + m];
                    if constexpr (MODE == M_VT || MODE == M_POOL) { sA = cs[bj][0]; sB = cs[bj][1]; }
                    if constexpr (MODE == M_RELU2 || MODE == M_PS) { const float rr = rs[ai * 4 + m];
                        store8<MODE>(e, row0 + ai * 128 + m * 16, col0 + bj * 128, acc[ai][bj][m][0] * rr + cs[bj][0], acc[ai][bj][m][1] * rr + cs[bj][1], sA, sB); }
                    else
                    store8<MODE>(e, row0 + ai * 128 + m * 16, col0 + bj * 128, acc[ai][bj][m][0], acc[ai][bj][m][1], sA, sB);
                }
    }
}
struct Epi {
    int mode; EpiArgs e;
    __device__ __forceinline__ void operator()(const f32x4 (&acc)[2][2][4][2], const pg8::Unit& u, int wr, int wc, int fr, int fq) const {
        switch (mode) {
            case M_P: epi_loops<M_P>(e, acc, u, wr, wc, fr, fq); break;
            case M_UT: epi_loops<M_UT>(e, acc, u, wr, wc, fr, fq); break;
            case M_Q: epi_loops<M_Q>(e, acc, u, wr, wc, fr, fq); break;
            case M_K: epi_loops<M_K>(e, acc, u, wr, wc, fr, fq); break;
            case M_VT: epi_loops<M_VT>(e, acc, u, wr, wc, fr, fq); break;
            case M_POOL: epi_loops<M_POOL>(e, acc, u, wr, wc, fr, fq); break;
            case M_DFTC: epi_loops<M_DFTC>(e, acc, u, wr, wc, fr, fq); break;
            case M_RES: epi_loops<M_RES>(e, acc, u, wr, wc, fr, fq); break;
            case M_PS: epi_loops<M_PS>(e, acc, u, wr, wc, fr, fq); break;
            case M_F32: epi_loops<M_F32>(e, acc, u, wr, wc, fr, fq); break;
            default: epi_loops<M_RELU2>(e, acc, u, wr, wc, fr, fq); break;
        }
    }
};

struct Args { const float* in[21]; float* out; unsigned char* ws; int ph_lo, ph_hi; };
typedef const __attribute__((address_space(4))) Args* KArgs;

__device__ __forceinline__ void transpose_item(const float* W, int K, int N, bf16_t* WT, LAS float* scr, int item, int lane) {
    const int nblk = N / 32, kb = item / nblk, nb = item % nblk, k0 = 64 * kb, n0 = 32 * nb;
#pragma unroll 8
    for (int i = 0; i < 32; ++i) { const int kk = 2 * i + (lane >> 5); scr[kk * 33 + (lane & 31)] = W[(size_t)(k0 + kk) * N + n0 + (lane & 31)]; }
    asm volatile("s_waitcnt lgkmcnt(0)" ::: "memory");
    const int c = lane & 7;
#pragma unroll
    for (int j = 0; j < 4; ++j) { const int n = (lane >> 3) + 8 * j; const LAS float* s = scr + (8 * c) * 33 + n;
        u32x4 o; o.x = pk2(s[0 * 33], s[1 * 33]); o.y = pk2(s[2 * 33], s[3 * 33]); o.z = pk2(s[4 * 33], s[5 * 33]); o.w = pk2(s[6 * 33], s[7 * 33]);
        *(u32x4*)(WT + (size_t)(n0 + n) * K + k0 + 8 * c) = o; }
    asm volatile("s_waitcnt lgkmcnt(0)" ::: "memory");
}

__device__ __forceinline__ void phase_setup(KArgs ap, unsigned char* ws, LAS unsigned char* lds, int tid, int lane, int wave, const int BX, const int G) {
    {
        LAS float* S = (LAS float*)lds;
        LAS float* part = (LAS float*)(lds + 17 * 1024 * 4);
        float* mod = (float*)(ws + WS_MOD);
        if (BX < 192) {
            for (int i = tid; i < 17 * 1024; i += 512) { const int r = i >> 10, k = i & 1023; const float v = r < 16 ? ap->in[1][r * 1024 + k] : ap->in[3][k]; S[i] = v / (1.f + expf(-v)); }
        }
        __syncthreads();
        for (int item = BX; item < 192; item += G) {
            const int l = item / 96, n0 = (item % 96) * 64;
            const float* W = ap->in[4] + (size_t)l * 1024 * 6144 + n0 + lane;
            float acc[17];
#pragma unroll
            for (int r = 0; r < 17; ++r) acc[r] = 0.f;
            for (int k = wave * 128; k < wave * 128 + 128; k += 4) {
                const float w0 = W[(size_t)k * 6144], w1 = W[(size_t)(k + 1) * 6144], w2 = W[(size_t)(k + 2) * 6144], w3 = W[(size_t)(k + 3) * 6144];
#pragma unroll
                for (int r = 0; r < 17; ++r) { const f32x4 s = *(const LAS f32x4*)(S + r * 1024 + k); acc[r] += s[0] * w0 + s[1] * w1 + s[2] * w2 + s[3] * w3; }
            }
#pragma unroll
            for (int r = 0; r < 17; ++r) part[(wave * 17 + r) * 64 + lane] = acc[r];
            __syncthreads();
            for (int i = tid; i < 17 * 64; i += 512) { const int r = i >> 6, j = i & 63; float s = ap->in[5][l * 6144 + n0 + j];
#pragma unroll
                for (int w = 0; w < 8; ++w) s += part[(w * 17 + r) * 64 + j];
                mod[(size_t)(l * 17 + r) * 6144 + n0 + j] = s; }
            __syncthreads();
        }
    }
    {
        LAS float* scr = (LAS float*)(lds + wave * 16384);
        const int gw = BX * 8 + wave, NGW = G * 8;
        constexpr int I_IN = 16 * 53, I_OUT = 16 * 32, I_1 = 16 * 128, I_2 = 64 * 32, I_L = I_IN + I_OUT + I_1 + I_2;
        for (int it = gw; it < 2 * I_L; it += NGW) {
            const int l = it / I_L; int r = it % I_L; unsigned char* wl = ws + l * WL;
            if (r < I_IN) { transpose_item(ap->in[8] + (size_t)l * 1024 * 1696, 1024, 1696, (bf16_t*)(wl + O_WIN), scr, r, lane); continue; } r -= I_IN;
            if (r < I_OUT) { transpose_item(ap->in[17] + (size_t)l * 1024 * 1024, 1024, 1024, (bf16_t*)(wl + O_WOUT), scr, r, lane); continue; } r -= I_OUT;
            if (r < I_1) { transpose_item(ap->in[18] + (size_t)l * 1024 * 4096, 1024, 4096, (bf16_t*)(wl + O_W1), scr, r, lane); continue; } r -= I_1;
            transpose_item(ap->in[19] + (size_t)l * 4096 * 1024, 4096, 1024, (bf16_t*)(wl + O_W2), scr, r, lane);
        }
    }
    {
        const int gt = BX * 512 + tid, NGT = G * 512;
        for (int l = 0; l < 2; ++l) {
            unsigned char* wl = ws + l * WL;
            { unsigned* z = (unsigned*)((bf16_t*)(wl + O_WIN) + (size_t)1696 * 1024); for (int i = gt; i < 96 * 1024 / 2; i += NGT) z[i] = 0u; }
            { bf16_t* o = (bf16_t*)(wl + O_WUQ); const float* w = ap->in[14] + (size_t)l * 256 * 384; const float* gq = ap->in[13] + l * 256;
              for (int i = gt; i < 512 * 256; i += NGT) { const int n = i >> 8, k = i & 255; o[i] = (bf16_t)(n < 384 ? f2bf(gq[k] * w[k * 384 + n]) : 0u); } }
            { bf16_t* ok = (bf16_t*)(wl + O_WK); bf16_t* ov = (bf16_t*)(wl + O_WV); const float* w = ap->in[16] + (size_t)l * 128 * 512; const float* gk = ap->in[15] + l * 128;
              for (int i = gt; i < 256 * 128; i += NGT) { const int n = i >> 7, k = i & 127, h = n >> 6, d = n & 63; const float gg = gk[k];
                  ok[i] = (bf16_t)f2bf(gg * w[k * 512 + h * 128 + d]); ov[i] = (bf16_t)f2bf(gg * w[k * 512 + h * 128 + 64 + d]); } }
            { bf16_t* o = (bf16_t*)(wl + O_WF); const float* fw = ap->in[9] + (size_t)l * 256 * 256;
              for (int i = gt; i < 512 * 256; i += NGT) { const int r = i >> 8, kin = i & 255, part = r >> 8, n = r & 255, h = kin >> 6, c = kin & 63; float s = 0.f;
                  for (int k2 = 0; k2 < 64; ++k2) { const float ang = (float)((c * k2) & 63) * (1.f / 32.f); const float tr = part ? sinpif(ang) : cospif(ang); s += tr * fw[(h * 64 + k2) * 256 + n]; }
                  o[i] = (bf16_t)f2bf(s); } }
            { bf16_t* o = (bf16_t*)(wl + O_POOL); const float* pw = ap->in[11] + (size_t)l * 4 * 64 * 64;
              for (int i = gt; i < 256 * 256; i += NGT) { const int r = i >> 8, k = i & 255, g = r >> 6, n = r & 63; o[i] = (bf16_t)((k >> 6) == g ? f2bf(pw[(g * 64 + (k & 63)) * 64 + n]) : 0u); } }
        }
        { float* tab = (float*)(ws + WS_ROPE); for (int i = gt; i < 512; i += NGT) { float sn, cs; sincosf((float)(i >> 3) * invfreq(i & 7), &sn, &cs); tab[2 * i] = cs; tab[2 * i + 1] = sn; } }
        { u32x4* z = (u32x4*)(ws + WS_RSS); for (int i = gt; i < (int)(3 * RSS_STRIDE / 16); i += NGT) z[i] = (u32x4){0u, 0u, 0u, 0u}; }
        { u32x4* o = (u32x4*)(ws + WS_DFT);
          for (int i = gt; i < 2 * 2048 * 512; i += NGT) { const int part = i >> 20, ii = i & ((1 << 20) - 1), row = ii >> 9, t0 = (ii & 511) * 8; float v[8];
#pragma unroll
              for (int e = 0; e < 8; ++e) { const float ang = (float)(((row + 1) * (t0 + e)) & 4095) * (1.f / 2048.f); v[e] = part ? sinpif(ang) : cospif(ang); }
              u32x4 w; w.x = pk2(v[0], v[1]); w.y = pk2(v[2], v[3]); w.z = pk2(v[4], v[5]); w.w = pk2(v[6], v[7]); o[i] = w; } }
        { u32x4* o = (u32x4*)(ws + WS_DFTC);
          for (int i = gt; i < 256 * 64; i += NGT) { const int row = i >> 6, j0 = (i & 63) * 8; float v[8];
#pragma unroll
              for (int e = 0; e < 8; ++e) { const int j = j0 + e, t = j & 255; const float ang = (float)((row * t) & 255) * (1.f / 128.f); v[e] = (j >> 8) ? -sinpif(ang) : cospif(ang); }
              u32x4 w; w.x = pk2(v[0], v[1]); w.y = pk2(v[2], v[3]); w.z = pk2(v[4], v[5]); w.w = pk2(v[6], v[7]); o[i] = w; } }
    }
}

__device__ __forceinline__ void phase_vectors(KArgs ap, unsigned char* ws, LAS unsigned char* lds, int tid, int lane, int wave, const int BX, const int G) {
    const float* mod = (const float*)(ws + WS_MOD);
    float* vec = (float*)(ws + WS_VEC);
    { const int gt = BX * 512 + tid, NGT = G * 512;
      for (int i = gt; i < 2 * 17 * 1024; i += NGT) { const int l = i / (17 * 1024), r = (i >> 10) % 17, k = i & 1023; vec[V_GN2 + i] = ap->in[7][l * 1024 + k] * (1.0f + mod[(size_t)(l * 17 + r) * 6144 + 4096 + k]); }
      for (int i = gt; i < 17 * 1024; i += NGT) { const int r = i >> 10, k = i & 1023; vec[V_GN1 + i] = ap->in[6][1024 + k] * (1.0f + mod[(size_t)(17 + r) * 6144 + 1024 + k]); } }
    LAS float* S = (LAS float*)lds;
    LAS float* part = (LAS float*)(lds + 17 * 1024 * 4);
    for (int item = BX; item < 156; item += G) {
        const bool up = item < 128;
        const int l = up ? item / 64 : 1, n0 = up ? (item % 64) * 64 : (item - 128) * 64, N = up ? 4096 : 1696, soff = up ? 3072 : 0;
        const float* Wb = up ? ap->in[18] + (size_t)l * 1024 * 4096 : ap->in[8] + (size_t)1024 * 1696;
        __syncthreads();
        for (int i = tid; i < 17 * 1024; i += 512) { const int r = i >> 10, k = i & 1023; S[i] = mod[(size_t)(l * 17 + r) * 6144 + soff + k]; }
        __syncthreads();
        const bool cv = n0 + lane < N;
        const float* W = Wb + n0 + (cv ? lane : 0);
        float acc[17];
#pragma unroll
        for (int r = 0; r < 17; ++r) acc[r] = 0.f;
        for (int k = wave * 128; k < wave * 128 + 128; k += 4) {
            const float w0 = W[(size_t)k * N], w1 = W[(size_t)(k + 1) * N], w2 = W[(size_t)(k + 2) * N], w3 = W[(size_t)(k + 3) * N];
#pragma unroll
            for (int r = 0; r < 17; ++r) { const f32x4 sv = *(const LAS f32x4*)(S + r * 1024 + k); acc[r] += sv[0] * w0 + sv[1] * w1 + sv[2] * w2 + sv[3] * w3; }
        }
#pragma unroll
        for (int r = 0; r < 17; ++r) part[(wave * 17 + r) * 64 + lane] = cv ? acc[r] : 0.f;
        __syncthreads();
        for (int i = tid; i < 17 * 64; i += 512) { const int r = i >> 6, j = i & 63; float sum = 0.f;
#pragma unroll
            for (int w = 0; w < 8; ++w) sum += part[(w * 17 + r) * 64 + j];
            if (up) vec[V_CB2 + (size_t)(l * 17 + r) * 4096 + n0 + j] = sum; else vec[V_CB1 + (size_t)r * 1792 + n0 + j] = sum; }
    }
    __syncthreads();
}
constexpr int RPI = 4;
__device__ __forceinline__ void phase_norm_mod(const float* xl, const float* xc, const float* g, const float* mod, int shoff, int scoff, bf16_t* H, int nrows, int lane, int wave, const int BX, const int G) {
    const int gw = BX * 8 + wave, NGW = G * 8;
    for (int row0 = gw; row0 < nrows; row0 += NGW * RPI) {
        f32x4 v[RPI][4]; float ss[RPI];
#pragma unroll
        for (int i = 0; i < RPI; ++i) { const int row = row0 + i * NGW; ss[i] = 0.f;
            if (row < nrows) { const float* src = row < ML ? xl + (size_t)row * DM : xc + (size_t)(row - ML) * DM;
#pragma unroll
                for (int j = 0; j < 4; ++j) v[i][j] = *(const f32x4*)(src + lane * 4 + 256 * j); }
            else {
#pragma unroll
                for (int j = 0; j < 4; ++j) v[i][j] = (f32x4){0.f, 0.f, 0.f, 0.f}; } }
#pragma unroll
        for (int i = 0; i < RPI; ++i) {
#pragma unroll
            for (int j = 0; j < 4; ++j) ss[i] += (v[i][j][0] * v[i][j][0] + v[i][j][1] * v[i][j][1]) + (v[i][j][2] * v[i][j][2] + v[i][j][3] * v[i][j][3]); }
#pragma unroll
        for (int o = 1; o < 64; o <<= 1) {
#pragma unroll
            for (int i = 0; i < RPI; ++i) ss[i] += shx(ss[i], o, lane); }
#pragma unroll
        for (int i = 0; i < RPI; ++i) { const int row = row0 + i * NGW;
            if (row < nrows) {
                const float rr = 1.0f / sqrtf(ss[i] * (1.f / DM) + EPS);
                const float* mv = mod + (size_t)(row < ML ? (row >> 12) : 16) * 6144;
#pragma unroll
                for (int j = 0; j < 4; ++j) { const int col = lane * 4 + 256 * j;
                    const f32x4 gg = *(const f32x4*)(g + col), sc = *(const f32x4*)(mv + scoff + col), sh = *(const f32x4*)(mv + shoff + col);
                    const f32x4 o = (v[i][j] * rr * gg) * (sc + 1.0f) + sh;
                    u32x2 w; w.x = cvt_pk_bf16(o[0], o[1]); w.y = cvt_pk_bf16(o[2], o[3]);
                    *(u32x2*)(H + (size_t)row * DM + col) = w; } } }
    }
}
__device__ __forceinline__ void phase_final_norm(float* x, const float* g, int lane, int wave, const int BX, const int G) {
    const int gw = BX * 8 + wave, NGW = G * 8;
    for (int row0 = gw; row0 < ML; row0 += NGW * RPI) {
        f32x4 v[RPI][4]; float ss[RPI];
#pragma unroll
        for (int i = 0; i < RPI; ++i) { const int row = row0 + i * NGW; ss[i] = 0.f;
#pragma unroll
            for (int j = 0; j < 4; ++j) v[i][j] = *(const f32x4*)(x + (size_t)row * DM + lane * 4 + 256 * j); }
#pragma unroll
        for (int i = 0; i < RPI; ++i) {
#pragma unroll
            for (int j = 0; j < 4; ++j) ss[i] += (v[i][j][0] * v[i][j][0] + v[i][j][1] * v[i][j][1]) + (v[i][j][2] * v[i][j][2] + v[i][j][3] * v[i][j][3]); }
#pragma unroll
        for (int o = 1; o < 64; o <<= 1) {
#pragma unroll
            for (int i = 0; i < RPI; ++i) ss[i] += shx(ss[i], o, lane); }
#pragma unroll
        for (int i = 0; i < RPI; ++i) { const int row = row0 + i * NGW;
            const float rr = 1.0f / sqrtf(ss[i] * (1.f / DM) + EPS);
#pragma unroll
            for (int j = 0; j < 4; ++j) { const int col = lane * 4 + 256 * j; const f32x4 gg = *(const f32x4*)(g + col); *(f32x4*)(x + (size_t)row * DM + col) = v[i][j] * rr * gg; } }
    }
}

__device__ __forceinline__ void phase_token_local(const bf16_t* P, float* rq, float* rkv, bf16_t* Kc, bf16_t* MIX, bf16_t* POOLIN, const float* conv_w, const float* ropetab, int tid, int lane, int wave, const int BX, const int G) {
    const int gw = BX * 8 + wave, NGW = G * 8;
    for (int row0 = gw; row0 < MT; row0 += NGW * RPI) {
        u32x2 cq[RPI]; unsigned ck[RPI]; float sq[RPI], sk[RPI];
#pragma unroll
        for (int i = 0; i < RPI; ++i) { const int row = min(row0 + i * NGW, MT - 1); const GAS bf16_t* pr = (const GAS bf16_t*)P + (size_t)row * LDP;
            cq[i] = *(const GAS u32x2*)(pr + 1280 + lane * 4); ck[i] = *(const GAS unsigned*)(pr + 1536 + lane * 2); }
#pragma unroll
        for (int i = 0; i < RPI; ++i) { const float a0 = bflo(cq[i].x), a1 = bfhi(cq[i].x), a2 = bflo(cq[i].y), a3 = bfhi(cq[i].y), k0 = bflo(ck[i]), k1 = bfhi(ck[i]);
            sq[i] = (a0 * a0 + a1 * a1) + (a2 * a2 + a3 * a3); sk[i] = k0 * k0 + k1 * k1; }
#pragma unroll
        for (int o = 1; o < 64; o <<= 1) {
#pragma unroll
            for (int i = 0; i < RPI; ++i) { sq[i] += shx(sq[i], o, lane); sk[i] += shx(sk[i], o, lane); } }
#pragma unroll
        for (int i = 0; i < RPI; ++i) { const int row = row0 + i * NGW;
            if (row < MT && lane == 0) { ((GAS float*)rq)[row] = 1.0f / sqrtf(sq[i] * (1.f / 256.f) + EPS); ((GAS float*)rkv)[row] = 1.0f / sqrtf(sk[i] * (1.f / 128.f) + EPS); } }
    }
    {
        const int gt0 = BX * 512 + tid, NGT0 = G * 512;
        for (int e = gt0; e < MT * 4; e += NGT0) {
            const int row = e >> 2, L = e & 3;
            const bool lat = row < ML; int b, t, key;
            if (lat) { b = row >> 12; t = row & 4095; key = CTX + t; } else { const int rr = row - ML; b = rr >> 8; t = rr & 255; key = t; }
            const GAS bf16_t* pr = (const GAS bf16_t*)P + (size_t)row * LDP + 1664;
            const u32x4 own = *(const GAS u32x4*)(pr + 8 * L), par = *(const GAS u32x4*)(pr + 8 * (L ^ 1));
            u32x4 outw = own;
            if (lat) {
                const int ipos = (L & 2) ? (t & 63) : (t >> 6);
                const GAS f32x4* tb = (const GAS f32x4*)(ropetab + ipos * 16);
                const f32x4 t0 = tb[0], t1 = tb[1], t2 = tb[2], t3 = tb[3];
                const float sg = (L & 1) ? 1.0f : -1.0f;
                float xo[8] = {bflo(own.x), bfhi(own.x), bflo(own.y), bfhi(own.y), bflo(own.z), bfhi(own.z), bflo(own.w), bfhi(own.w)};
                float xp[8] = {bflo(par.x), bfhi(par.x), bflo(par.y), bfhi(par.y), bflo(par.z), bfhi(par.z), bflo(par.w), bfhi(par.w)};
                float cs[8] = {t0[0], t0[2], t1[0], t1[2], t2[0], t2[2], t3[0], t3[2]}, sn[8] = {t0[1], t0[3], t1[1], t1[3], t2[1], t2[3], t3[1], t3[3]};
                float o[8];
#pragma unroll
                for (int j = 0; j < 8; ++j) o[j] = xo[j] * cs[j] + sg * xp[j] * sn[j];
                outw.x = pk2(o[0], o[1]); outw.y = pk2(o[2], o[3]); outw.z = pk2(o[4], o[5]); outw.w = pk2(o[6], o[7]);
            }
#pragma unroll
            for (int h = 0; h < 4; ++h) *(GAS u32x4*)((GAS bf16_t*)Kc + (size_t)((b * 4 + h) * NKEY + key) * QKD + 64 + 8 * L) = outw;
        }
    }
    const int rpb = (MT + G - 1) / G;
    const int rbeg = BX * rpb, rend = min(rbeg + rpb, MT);
    const int c16 = tid & 63, ch = c16 * 4;
    const f32x4 cw0 = *(const f32x4*)(conv_w + ch), cw1 = *(const f32x4*)(conv_w + 256 + ch), cw2 = *(const f32x4*)(conv_w + 512 + ch);
    const int hw = 1 << (c16 >> 4);
    for (int row = rbeg + (tid >> 6); row < rend; row += 8) {
        int t, n; if (row < ML) { t = row & 4095; n = SEQ; } else { t = (row - ML) & 255; n = CTX; }
        const bf16_t* pr = P + (size_t)row * LDP;
        const u32x2 bg = *(const u32x2*)(pr + 256 + ch), cg = *(const u32x2*)(pr + 512 + ch), xi = *(const u32x2*)(pr + 768 + ch);
        const bool hp = t > 0, hn = t < n - 1;
        const bf16_t* pp = hp ? pr - LDP : pr; const bf16_t* pn = hn ? pr + LDP : pr;
        const u32x2 c0 = *(const u32x2*)(pp + 512 + ch), x0 = *(const u32x2*)(pp + 768 + ch), c2 = *(const u32x2*)(pn + 512 + ch), x2 = *(const u32x2*)(pn + 768 + ch);
        const bf16_t* pq = pr + 1024 + ch;
        u32x2 tap[16];
#pragma unroll
        for (int k = 0; k < 16; ++k) { const int d = k - 8; const bool ok = (d >= -hw) && (d < hw) && (t + d >= 0) && (t + d < n);
            tap[k] = *(const u32x2*)(pq + (ptrdiff_t)(ok ? d : 0) * LDP); if (!ok) tap[k] = (u32x2){0u, 0u}; }
        const u32x2 u0 = *(const u32x2*)pq;
        {
            const f32x4 z = (f32x4){bflo(cg.x) * bflo(xi.x), bfhi(cg.x) * bfhi(xi.x), bflo(cg.y) * bflo(xi.y), bfhi(cg.y) * bfhi(xi.y)};
            const f32x4 zp = (f32x4){bflo(c0.x) * bflo(x0.x), bfhi(c0.x) * bfhi(x0.x), bflo(c0.y) * bflo(x0.y), bfhi(c0.y) * bfhi(x0.y)};
            const f32x4 zn = (f32x4){bflo(c2.x) * bflo(x2.x), bfhi(c2.x) * bfhi(x2.x), bflo(c2.y) * bflo(x2.y), bfhi(c2.y) * bfhi(x2.y)};
            const f32x4 y = z * cw1 + zp * (hp ? cw0 : cw0 * 0.f) + zn * (hn ? cw2 : cw2 * 0.f);
            u32x2 w; w.x = cvt_pk_bf16(bflo(bg.x) * y[0], bfhi(bg.x) * y[1]); w.y = cvt_pk_bf16(bflo(bg.y) * y[2], bfhi(bg.y) * y[3]);
            *(u32x2*)(MIX + (size_t)row * DM + 256 + ch) = w;
        }
        {
            f32x4 sacc = (f32x4){0.f, 0.f, 0.f, 0.f};
#pragma unroll
            for (int k = 0; k < 16; ++k) sacc += (f32x4){bflo(tap[k].x), bfhi(tap[k].x), bflo(tap[k].y), bfhi(tap[k].y)};
            const int lo = max(t - hw, 0), hi = min(t + hw - 1, n - 1);
            const float ic = 1.0f / (float)(hi - lo + 1);
            u32x2 w; w.x = cvt_pk_bf16(sacc[0] * ic - bflo(u0.x), sacc[1] * ic - bfhi(u0.x)); w.y = cvt_pk_bf16(sacc[2] * ic - bflo(u0.y), sacc[3] * ic - bfhi(u0.y));
            *(u32x2*)(POOLIN + (size_t)row * 256 + ch) = w;
        }
    }
}

__device__ __forceinline__ void phase_dft_combine(unsigned char* ws, int tid, int lane, int wave, const int BX, const int G) {
    const GAS float* PT = (const GAS float*)(ws + WS_PT); const GAS float* QT = (const GAS float*)(ws + WS_QT);
    GAS bf16_t* MIX = (GAS bf16_t*)(ws + WS_MIX);
    const int gt = BX * 512 + tid, NGT = G * 512;
    for (int i = gt; i < 2048 * 512; i += NGT) {
        const int r = i >> 9, col = (i & 511) * 8, b = col >> 8, n = col & 255, k1 = r + 1;
        const f32x4 p0 = *(const GAS f32x4*)(PT + (size_t)r * 4096 + col), p1 = *(const GAS f32x4*)(PT + (size_t)r * 4096 + col + 4);
        const f32x4 q0 = *(const GAS f32x4*)(QT + (size_t)r * 4096 + col), q1 = *(const GAS f32x4*)(QT + (size_t)r * 4096 + col + 4);
        const float sc = 1.f / 512.f;
        *(gv4p)(MIX + (size_t)(b * SEQ + k1) * DM + n) = pack8((p0 - q0) * sc, (p1 - q1) * sc);
        *(gv4p)(MIX + (size_t)(b * SEQ + 4096 - k1) * DM + n) = pack8((p0 + q0) * sc, (p1 + q1) * sc);
    }
    const GAS bf16_t* UT = (const GAS bf16_t*)(ws + WS_UT);
    const int gw = BX * 8 + wave, NGW = G * 8;
    for (int rowi = gw; rowi < 4096; rowi += NGW) {
        const GAS u32x4* src = (const GAS u32x4*)(UT + (size_t)rowi * 8192) + lane;
        float sacc = 0.f;
#pragma unroll
        for (int c = 0; c < 8; ++c) { const u32x4 w = src[c * 64]; sacc += (bflo(w.x) + bfhi(w.x)) + (bflo(w.y) + bfhi(w.y)) + (bflo(w.z) + bfhi(w.z)) + (bflo(w.w) + bfhi(w.w)); }
        sacc = wave_sum(sacc, lane);
        if (lane == 0) { const int b = rowi >> 8, n = rowi & 255; MIX[(size_t)(b * SEQ) * DM + n] = (bf16_t)f2bf(sacc * (1.f / 512.f)); }
    }
}

constexpr int KROW = 208, VROW = 144, KBUF = 64 * KROW, VBUF = 64 * VROW, ABUF = KBUF + VBUF;
__device__ __forceinline__ void attn_unit(LAS unsigned char* lds, const bf16_t* Qb, const bf16_t* Kb, const bf16_t* Vtb, int nk, bf16_t* Ob, bool rope, int tok0, const int tid, const float* ropetab) {
    const int lane = tid & 63, r = lane & 31, hi = lane >> 5, wid = tid >> 6;
    bf16x8 qf[6];
    const bf16_t* qrow = Qb + (size_t)(wid * 32 + r) * 384 + 8 * hi;
#pragma unroll
    for (int d0 = 0; d0 < 6; ++d0) qf[d0] = *(const bf16x8*)(qrow + d0 * 16);
    if (rope) {
        const int t = tok0 + wid * 32 + r;
#pragma unroll
        for (int d0 = 4; d0 < 6; ++d0) {
            const int ipos = d0 == 4 ? (t >> 6) : (t & 63);
            bf16x8 o;
#pragma unroll
            for (int j = 0; j < 8; ++j) {
                const float own = bf1((bf16_t)qf[d0][j]);
                const float partner = shx(own, 32, lane);
                const f32x2 csn = *(const GAS f32x2*)(ropetab + (ipos * 8 + j) * 2); const float cs = csn[0], sn = csn[1];
                o[j] = (short)f2bf(own * cs + (hi ? partner : -partner) * sn);
            }
            qf[d0] = o;
        }
    }
    const int kc0 = tid, kc1 = tid + 512;
    const int kr0 = kc0 / 12, kcc0 = kc0 % 12, kr1 = kc1 / 12, kcc1 = kc1 % 12;
    const bool k1v = kc1 < 768;
    const int vr = tid >> 3, vcc = tid & 7;
    const bf16_t* kg0 = Kb + (size_t)kr0 * QKD + kcc0 * 8;
    const bf16_t* kg1 = Kb + (size_t)kr1 * QKD + kcc1 * 8;
    const bf16_t* vg = Vtb + (size_t)vr * NKEY + vcc * 8;
    const int kl0 = kr0 * KROW + kcc0 * 16, kl1 = kr1 * KROW + kcc1 * 16, vl = KBUF + vr * VROW + vcc * 16;
    const int NT = nk >> 6;
    u32x4 sk0, sk1 = (u32x4){0u, 0u, 0u, 0u}, sv;
    sk0 = *(const u32x4*)kg0; if (k1v) sk1 = *(const u32x4*)kg1; sv = *(const u32x4*)vg;
    *(LAS u32x4*)(lds + kl0) = sk0; if (k1v) *(LAS u32x4*)(lds + kl1) = sk1; *(LAS u32x4*)(lds + vl) = sv;
    __syncthreads();
    f32x16 ot0, ot1;
#pragma unroll
    for (int i = 0; i < 16; ++i) { ot0[i] = 0.f; ot1[i] = 0.f; }
    float l_run = 0.f;
    f32x16 negm;
#pragma unroll
    for (int i = 0; i < 16; ++i) negm[i] = 0.f;
    asm volatile("" : "+v"(negm));
    for (int tI = 0; tI < NT; ++tI) {
        LAS unsigned char* cur = lds + (tI & 1) * ABUF;
        LAS unsigned char* nxt = lds + ((tI + 1) & 1) * ABUF;
        const bool more = tI + 1 < NT;
        if (more) { const size_t ko = (size_t)(tI + 1) * 64 * QKD; sk0 = *(const u32x4*)(kg0 + ko); if (k1v) sk1 = *(const u32x4*)(kg1 + ko); sv = *(const u32x4*)(vg + (tI + 1) * 64); }
        f32x16 s0, s1;
        __builtin_amdgcn_s_setprio(1);
#pragma unroll
        for (int d0 = 0; d0 < 6; ++d0) {
            const bf16x8 a0 = *(const LAS bf16x8*)(cur + r * KROW + d0 * 32 + hi * 16);
            const bf16x8 a1 = *(const LAS bf16x8*)(cur + (32 + r) * KROW + d0 * 32 + hi * 16);
            if (d0 == 0) { s0 = __builtin_amdgcn_mfma_f32_32x32x16_bf16(a0, qf[0], negm, 0, 0, 0); s1 = __builtin_amdgcn_mfma_f32_32x32x16_bf16(a1, qf[0], negm, 0, 0, 0); }
            else { s0 = __builtin_amdgcn_mfma_f32_32x32x16_bf16(a0, qf[d0], s0, 0, 0, 0); s1 = __builtin_amdgcn_mfma_f32_32x32x16_bf16(a1, qf[d0], s1, 0, 0, 0); }
        }
        __builtin_amdgcn_s_setprio(0);
        float mx = s0[0];
#pragma unroll
        for (int i = 1; i < 16; ++i) mx = fmaxf(mx, s0[i]);
#pragma unroll
        for (int i = 0; i < 16; ++i) mx = fmaxf(mx, s1[i]);
        mx = fmaxf(mx, shx(mx, 32, lane));
        if (tI == 0 || __builtin_amdgcn_ballot_w64(mx > 8.0f) != 0ull) {
            const float dl = tI == 0 ? mx : fmaxf(mx, 0.f);
            const float alpha = tI == 0 ? 0.f : __builtin_amdgcn_exp2f(-dl);
#pragma unroll
            for (int i = 0; i < 16; ++i) { s0[i] -= dl; s1[i] -= dl; ot0[i] *= alpha; ot1[i] *= alpha; negm[i] -= dl; }
            l_run *= alpha;
            asm volatile("" : "+v"(negm));
        }
        float ps = 0.f;
#pragma unroll
        for (int i = 0; i < 16; ++i) { s0[i] = __builtin_amdgcn_exp2f(s0[i]); s1[i] = __builtin_amdgcn_exp2f(s1[i]); ps += s0[i] + s1[i]; }
        l_run += ps;
        bf16x8 pb[4];
#pragma unroll
        for (int s = 0; s < 4; ++s) {
            u32x4 w;
            if (s < 2) { w.x = cvt_pk_bf16(s0[8 * s + 0], s0[8 * s + 1]); w.y = cvt_pk_bf16(s0[8 * s + 2], s0[8 * s + 3]); w.z = cvt_pk_bf16(s0[8 * s + 4], s0[8 * s + 5]); w.w = cvt_pk_bf16(s0[8 * s + 6], s0[8 * s + 7]); }
            else { const int q = s - 2; w.x = cvt_pk_bf16(s1[8 * q + 0], s1[8 * q + 1]); w.y = cvt_pk_bf16(s1[8 * q + 2], s1[8 * q + 3]); w.z = cvt_pk_bf16(s1[8 * q + 4], s1[8 * q + 5]); w.w = cvt_pk_bf16(s1[8 * q + 6], s1[8 * q + 7]); }
            pb[s] = __builtin_bit_cast(bf16x8, w);
        }
#pragma unroll
        for (int s = 0; s < 4; ++s) {
            const int ko = (16 * s + 8 * hi) * 2;
            const bf16x8 a0 = *(const LAS bf16x8*)(cur + KBUF + r * VROW + ko), a1 = *(const LAS bf16x8*)(cur + KBUF + (32 + r) * VROW + ko);
            __builtin_amdgcn_s_setprio(1);
            ot0 = __builtin_amdgcn_mfma_f32_32x32x16_bf16(a0, pb[s], ot0, 0, 0, 0);
            ot1 = __builtin_amdgcn_mfma_f32_32x32x16_bf16(a1, pb[s], ot1, 0, 0, 0);
            __builtin_amdgcn_s_setprio(0);
        }
        if (more) { *(LAS u32x4*)(nxt + kl0) = sk0; if (k1v) *(LAS u32x4*)(nxt + kl1) = sk1; *(LAS u32x4*)(nxt + vl) = sv; }
        __syncthreads();
    }
    const float lt = l_run + shx(l_run, 32, lane);
    const float il = 1.0f / lt;
    bf16_t* orow = Ob + (size_t)(wid * 32 + r) * DM;
#pragma unroll
    for (int g = 0; g < 4; ++g) {
        u32x2 w0, w1;
        w0.x = cvt_pk_bf16(ot0[4 * g] * il, ot0[4 * g + 1] * il); w0.y = cvt_pk_bf16(ot0[4 * g + 2] * il, ot0[4 * g + 3] * il);
        w1.x = cvt_pk_bf16(ot1[4 * g] * il, ot1[4 * g + 1] * il); w1.y = cvt_pk_bf16(ot1[4 * g + 2] * il, ot1[4 * g + 3] * il);
        *(u32x2*)(orow + 8 * g + 4 * hi) = w0;
        *(u32x2*)(orow + 32 + 8 * g + 4 * hi) = w1;
    }
}
__device__ __forceinline__ void phase_attention(LAS unsigned char* lds, unsigned char* ws, bool with_ctx, const int tid, const int bx, const int G) {
    const int vcu = (G % 8 == 0) ? (bx % 8) * (G / 8) + bx / 8 : bx;
    const bf16_t* Q = (const bf16_t*)(ws + WS_Q); const bf16_t* Qc = (const bf16_t*)(ws + WS_QC);
    const bf16_t* Kc = (const bf16_t*)(ws + WS_KC); const bf16_t* Vt = (const bf16_t*)(ws + WS_VT);
    bf16_t* MIX = (bf16_t*)(ws + WS_MIX);
    const int nunits = 1024 + (with_ctx ? 64 : 0);
    for (int u = vcu; u < nunits; u += G) {
        if (u < 1024) {
            const int bh = u >> 4, qb = u & 15, b = bh >> 2, h = bh & 3;
            attn_unit(lds, Q + (size_t)(b * SEQ + qb * 256) * 384 + h * QKD, Kc + (size_t)bh * NKEY * QKD, Vt + (size_t)bh * 64 * NKEY, NKEY,
                      MIX + (size_t)(b * SEQ + qb * 256) * DM + 768 + h * 64, true, qb * 256, tid, (const float*)(ws + WS_ROPE));
        } else {
            const int bh = u - 1024, b = bh >> 2, h = bh & 3;
            attn_unit(lds, Qc + (size_t)(b * CTX) * 384 + h * QKD, Kc + (size_t)bh * NKEY * QKD, Vt + (size_t)bh * 64 * NKEY, CTX,
                      MIX + (size_t)(ML + b * CTX) * DM + 768 + h * 64, false, 0, tid, (const float*)(ws + WS_ROPE));
        }
    }
}

struct Job { pg8::Gemm g; Epi e; };
__device__ __forceinline__ bool get_job(KArgs ap, unsigned char* ws, float* outp, int l, int kind, int j, Job& J) {
    unsigned char* wl = ws + (size_t)l * WL;
    const int Mx = l == 0 ? MT : ML;
    bf16_t* P = (bf16_t*)(ws + WS_P); bf16_t* MIX = (bf16_t*)(ws + WS_MIX); bf16_t* H = (bf16_t*)(ws + WS_H);
    const float* rq = (const float*)(ws + WS_RQ); const float* rkv = (const float*)(ws + WS_RKV);
    const float* mod = (const float*)(ws + WS_MOD) + (size_t)l * 17 * 6144;
    float* xc = (float*)(ws + WS_XC);
    J.e.e = EpiArgs{nullptr, nullptr, nullptr, nullptr, nullptr, nullptr, 0, 0};
    if (kind == 0) { if (j) return false;
        J.g = pg8::Gemm{H, (const bf16_t*)(wl + O_WIN), MT, LDP, DM, DM, DM}; J.e.mode = l == 0 ? M_P : M_PS; J.e.e.o0 = P; J.e.e.ld = LDP;
        J.e.e.f0 = (const float*)(ws + WS_RSS + 2 * RSS_STRIDE); J.e.e.f1 = (const float*)(ws + WS_VEC) + V_CB1; J.e.e.goff = LDP; return true; }
    if (kind == 1) { if (j) return false;
        J.g = pg8::Gemm{(const bf16_t*)(wl + O_WF), P, 512, Mx, 256, 256, LDP}; J.e.mode = M_UT; J.e.e.o0 = (bf16_t*)(ws + WS_UT); J.e.e.o1 = (bf16_t*)(ws + WS_UTC); return true; }
    if (kind == 2) {
        switch (j) {
            case 0: J.g = pg8::Gemm{(const bf16_t*)(ws + WS_DFT), (const bf16_t*)(ws + WS_UT), 2048, 4096, 4096, 4096, 8192}; J.e.mode = M_F32; J.e.e.o0 = (bf16_t*)(ws + WS_PT); return true;
            case 6: J.g = pg8::Gemm{(const bf16_t*)(ws + WS_DFT) + (size_t)2048 * 4096, (const bf16_t*)(ws + WS_UT) + 4096, 2048, 4096, 4096, 4096, 8192}; J.e.mode = M_F32; J.e.e.o0 = (bf16_t*)(ws + WS_QT); return true;
            case 1: J.g = pg8::Gemm{P + 1280, (const bf16_t*)(wl + O_WUQ), Mx, 512, 256, LDP, 256}; J.e.mode = M_Q; J.e.e.o0 = (bf16_t*)(ws + WS_Q); J.e.e.o1 = (bf16_t*)(ws + WS_QC); J.e.e.f0 = rq; return true;
            case 2: J.g = pg8::Gemm{P + 1536, (const bf16_t*)(wl + O_WK), MT, 256, 128, LDP, 128}; J.e.mode = M_K; J.e.e.o0 = (bf16_t*)(ws + WS_KC); J.e.e.f0 = rkv; return true;
            case 3: J.g = pg8::Gemm{(const bf16_t*)(wl + O_WV), P + 1536, 256, MT, 128, 128, LDP}; J.e.mode = M_VT; J.e.e.o0 = (bf16_t*)(ws + WS_VT); J.e.e.f0 = rkv; return true;
            case 4: J.g = pg8::Gemm{(const bf16_t*)(ws + WS_POOLIN), (const bf16_t*)(wl + O_POOL), Mx, 256, 256, 256, 256}; J.e.mode = M_POOL; J.e.e.o0 = MIX; J.e.e.f0 = ap->in[12] + l * 256; return true;
            case 5: if (l != 0) return false;
                J.g = pg8::Gemm{(const bf16_t*)(ws + WS_DFTC), (const bf16_t*)(ws + WS_UTC), 256, 4096, 512, 512, 512}; J.e.mode = M_DFTC; J.e.e.o0 = MIX; return true;
            default: return false;
        }
    }
    if (kind == 4 || kind == 7) { if (j) return false;
        if (kind == 4) J.g = pg8::Gemm{MIX, (const bf16_t*)(wl + O_WOUT), Mx, DM, DM, DM, DM};
        else J.g = pg8::Gemm{(const bf16_t*)(ws + WS_ACT), (const bf16_t*)(wl + O_W2), Mx, DM, DFF, DFF, DFF};
        J.e.mode = M_RES; J.e.e.o1 = (bf16_t*)mod; J.e.e.goff = kind == 4 ? 2048 : 5120;
        J.e.e.f0 = (l == 0 && kind == 4) ? ap->in[0] : outp; J.e.e.f1 = (l == 0 && kind == 4) ? ap->in[2] : xc; J.e.e.x0 = outp; J.e.e.x1 = xc;
        J.e.e.ld = kind == 4 ? 1 + l : (l == 0 ? 3 : 0); return true; }
    if (kind == 6) { if (j) return false;
        J.g = pg8::Gemm{H, (const bf16_t*)(wl + O_W1), Mx, DFF, DM, DM, DM}; J.e.mode = M_RELU2; J.e.e.o0 = (bf16_t*)(ws + WS_ACT); J.e.e.ld = DFF;
        J.e.e.f0 = (const float*)(ws + WS_RSS + (size_t)l * RSS_STRIDE); J.e.e.f1 = (const float*)(ws + WS_VEC) + V_CB2 + l * 17 * 4096; J.e.e.goff = DFF; return true; }
    return false;
}

#define XB_TMO      128
#define XB_XCNT(j)  (256  + 64 * (j))
#define XB_XSUB(j)  (1280 + 64 * (j))
#define XB_XGEN(j)  (2304 + 64 * (j))
#define XB_TOP      3328
#define XB_TOPGEN   3392
#define XCD_BAR_WORDS 3456
#define XB_SPIN_CAP (1u << 18)
__device__ __forceinline__ unsigned xb_ld(unsigned* p)              { return __hip_atomic_load(p, __ATOMIC_RELAXED, __HIP_MEMORY_SCOPE_AGENT); }
__device__ __forceinline__ unsigned xb_add(unsigned* p, unsigned v) { return __hip_atomic_fetch_add(p, v, __ATOMIC_RELAXED, __HIP_MEMORY_SCOPE_AGENT); }
__device__ __forceinline__ unsigned xb_xcc_id() { return (unsigned)__builtin_amdgcn_s_getreg((3 << 11) | 20) & 0xFu; }
#define XB_SPIN(cond, bar) do { unsigned _sp = 0; while (cond) { __builtin_amdgcn_s_sleep(1); \
    if ((++_sp & 255u) == 0u) { if (xb_ld(&(bar)[XB_TMO])) break; if (_sp > XB_SPIN_CAP) { atomicAdd(&(bar)[XB_TMO], 1u); break; } } } } while (0)
struct XcdBarrier { unsigned* bar; unsigned x; volatile LAS unsigned* st; };
__device__ __forceinline__ XcdBarrier xcd_barrier_post(unsigned* bar, volatile LAS unsigned* st) {
    XcdBarrier b; b.bar = bar; b.x = xb_xcc_id(); b.st = st;
    if (threadIdx.x == 0) (void)xb_add(&bar[XB_XCNT(b.x)], 1u);
    return b;
}
__device__ __forceinline__ void xcd_barrier_complete(unsigned* bar, unsigned x, unsigned& nloc, unsigned& nx) {
    const unsigned G = gridDim.x * gridDim.y * gridDim.z;
    unsigned sum, cnt, mine, sp = 0u;
    for (;;) {
        sum = 0u; cnt = 0u; mine = 0u;
#pragma unroll
        for (unsigned j = 0; j < 16; ++j) { const unsigned c = xb_ld(&bar[XB_XCNT(j)]); sum += c; cnt += (c > 0u) ? 1u : 0u; mine = (j == x) ? c : mine; }
        if (sum == G) break;
        __builtin_amdgcn_s_sleep(1);
        if ((++sp & 255u) == 0u) { if (xb_ld(&bar[XB_TMO])) break; if (sp > XB_SPIN_CAP) { atomicAdd(&bar[XB_TMO], 1u); break; } }
    }
    nloc = mine > 0u ? mine : 1u; nx = cnt > 0u ? cnt : 1u;
}
__device__ __forceinline__ void xcd_barrier(const XcdBarrier& b) {
    asm volatile("s_waitcnt vmcnt(0)" ::: "memory");
    __syncthreads();
    if (threadIdx.x == 0) {
        unsigned* bar = b.bar;
        __builtin_amdgcn_s_waitcnt(0);
        unsigned nloc = b.st[0], nx = b.st[1];
        if (nloc == 0u) { xcd_barrier_complete(bar, b.x, nloc, nx); b.st[0] = nloc; b.st[1] = nx; }
        const unsigned old = xb_add(&bar[XB_XSUB(b.x)], 1u);
        const unsigned gen = old / nloc;
        if (old + 1u == (gen + 1u) * nloc) {
            __builtin_amdgcn_fence(__ATOMIC_RELEASE, "agent");
            asm volatile("s_waitcnt vmcnt(0)" ::: "memory");
            const unsigned og = xb_add(&bar[XB_TOP], 1u);
            const unsigned tg = og / nx;
            if (og + 1u == (tg + 1u) * nx) xb_add(&bar[XB_TOPGEN], 1u);
            else XB_SPIN(xb_ld(&bar[XB_TOPGEN]) == tg, bar);
            __builtin_amdgcn_fence(__ATOMIC_ACQUIRE, "agent");
            xb_add(&bar[XB_XGEN(b.x)], 1u);
            asm volatile("s_waitcnt vmcnt(0)" ::: "memory");
        } else {
            XB_SPIN(xb_ld(&bar[XB_XGEN(b.x)]) == gen, bar);
            __builtin_amdgcn_fence(__ATOMIC_ACQUIRE, "agent");
            asm volatile("s_waitcnt vmcnt(0)" ::: "memory");
        }
    }
    __syncthreads();
}

constexpr int LDS_BYTES = 147456;
constexpr int N_PHASES = 2 + 9 * 2;
template <int PH> __device__ __forceinline__ void run_phase(LAS unsigned char* lds) {
    int tid = threadIdx.x; asm volatile("" : "+v"(tid));
    int BX = blockIdx.x, G = gridDim.x; asm volatile("" : "+s"(BX), "+s"(G));
    const int lane = tid & 63, wave = __builtin_amdgcn_readfirstlane(tid >> 6);
    KArgs ap = (KArgs)__builtin_amdgcn_kernarg_segment_ptr(); asm volatile("" : "+s"(ap));
    unsigned char* ws = ap->ws; float* outp = ap->out;
    if constexpr (PH == 0) {
        phase_setup(ap, ws, lds, tid, lane, wave, BX, G);
    } else if constexpr (PH == 1) {
        phase_vectors(ap, ws, lds, tid, lane, wave, BX, G);
        phase_norm_mod(ap->in[0], ap->in[2], ap->in[6], (const float*)(ws + WS_MOD), 0, 1024, (bf16_t*)(ws + WS_H), MT, lane, wave, BX, G);
    } else {
        constexpr int l = (PH - 2) / 9, kind = (PH - 2) % 9;
        const float* mod = (const float*)(ws + WS_MOD) + (size_t)l * 17 * 6144;
        if constexpr (kind == 1) phase_token_local((const bf16_t*)(ws + WS_P), (float*)(ws + WS_RQ), (float*)(ws + WS_RKV), (bf16_t*)(ws + WS_KC), (bf16_t*)(ws + WS_MIX), (bf16_t*)(ws + WS_POOLIN), ap->in[10] + l * 768, (const float*)(ws + WS_ROPE), tid, lane, wave, BX, G);
        if constexpr (kind == 3) { phase_dft_combine(ws, tid, lane, wave, BX, G); phase_attention(lds, ws, l == 0, tid, BX, G); }
        else if constexpr (kind == 5) { }
        else if constexpr (kind == 8) {
            if constexpr (l == 0) { }
            else phase_final_norm(outp, ap->in[20], lane, wave, BX, G);
        } else {
            Job J; int lr = l, kr = kind; asm volatile("" : "+s"(lr), "+s"(kr));
            for (int j = 0;; ++j) {
                KArgs ap2 = ap; unsigned char* ws2 = ws; float* out2 = outp; int tid2 = tid, BX2 = BX, G2 = G;
                asm volatile("" : "+s"(ap2), "+s"(ws2), "+s"(out2), "+v"(tid2), "+s"(BX2), "+s"(G2));
                if (kr == 2 && j > 6) break;
                const int jj = kr == 2 ? (j == 0 ? 0 : j == 1 ? 6 : j - 1) : j;
                if (!get_job(ap2, ws2, out2, lr, kr, jj, J)) break;
                const int rot = kr == 2 ? (jj == 6 ? 128 : jj == 2 ? 32 : jj == 3 ? 48 : jj == 4 ? 64 : jj == 5 ? 80 : 0) : 0;
                pg8::StaticOrder S; S.init(J.g.M, J.g.N, G2, (BX2 + rot) % G2);
                pg8::gemm_phase<Epi>(lds, J.g, S, J.e, tid2);
            }
        }
    }
}
__global__ void __launch_bounds__(512, 2) fwd_megakernel(Args a) {
    extern __shared__ __attribute__((aligned(16))) unsigned char lds_raw[];
    LAS unsigned char* lds = (LAS unsigned char*)lds_raw;
    cg::grid_group grid = cg::this_grid();
    const int ph_lo = a.ph_lo, ph_hi = a.ph_hi;
    for (int u = threadIdx.x; u < (LDS_BYTES - 131072) / 4; u += 512) ((LAS unsigned*)(lds + 131072))[u] = 0u;
    __syncthreads();
    if (blockIdx.x == 0) for (int u = threadIdx.x; u < (int)(CTL_BYTES / 4); u += 512) ((unsigned*)(a.ws + WS_CTL))[u] = 0u;
    XcdBarrier bar; bar.bar = (unsigned*)(a.ws + WS_CTL); bar.x = 0; bar.st = (volatile LAS unsigned*)(lds + 131072 + 64);
#ifndef EXP_SYNC
#define EXP_SYNC 0
#endif
#ifndef EXP_REP
#define EXP_REP(k) 0
#endif
#define PH_EMPTY(k) ((k) == 7 || (k) == 16 || (k) == 10)
#define PHASE(k) if (!PH_EMPTY(k) && ph_lo <= (k) && (k) < ph_hi) { run_phase<k>(lds); if (EXP_REP(k)) { grid.sync(); run_phase<k>(lds); } if ((k) + 1 < ph_hi) { if ((k) == 0) { grid.sync(); bar = xcd_barrier_post((unsigned*)(a.ws + WS_CTL), (volatile LAS unsigned*)(lds + 131072 + 64)); } else xcd_barrier(bar); if (EXP_SYNC) xcd_barrier(bar); } }
    PHASE(0) PHASE(1) PHASE(2) PHASE(3) PHASE(4) PHASE(5) PHASE(6) PHASE(7) PHASE(8) PHASE(9) PHASE(10)
    PHASE(11) PHASE(12) PHASE(13) PHASE(14) PHASE(15) PHASE(16) PHASE(17) PHASE(18) PHASE(19)
#undef PHASE
}

#ifndef MK_MULTI_LAUNCH
#define MK_MULTI_LAUNCH 0
#endif
extern "C" void kernel_launch(void* const* d_in, const int* in_sizes, int n_in, void* d_out, int out_size, void* d_ws, size_t ws_size, hipStream_t stream) {
    static int grid = 0;
    if (grid == 0) {
        int dev = 0, cus = 0, per_cu = 0;
        hipGetDevice(&dev);
        hipDeviceGetAttribute(&cus, hipDeviceAttributeMultiprocessorCount, dev);
        hipFuncSetAttribute((const void*)fwd_megakernel, hipFuncAttributeMaxDynamicSharedMemorySize, LDS_BYTES);
        hipOccupancyMaxActiveBlocksPerMultiprocessor(&per_cu, (const void*)fwd_megakernel, 512, LDS_BYTES);
        (void)hipGetLastError();
        if (cus <= 0) cus = 256;
        grid = cus;
        if (per_cu < 1) fprintf(stderr, "kernel_launch: occupancy query says %d blocks/CU\n", per_cu);
        if (ws_size < WS_END) { fprintf(stderr, "kernel_launch: workspace too small (%zu < %zu)\n", ws_size, (size_t)WS_END); grid = -1; }
    }
    if (grid < 0) return;
    Args a{};
    for (int i = 0; i < 21; ++i) a.in[i] = (const float*)d_in[i];
    a.out = (float*)d_out; a.ws = (unsigned char*)d_ws;
#if MK_MULTI_LAUNCH
    for (int ph = 0; ph < N_PHASES; ++ph) { a.ph_lo = ph; a.ph_hi = ph + 1; hipLaunchKernelGGL(fwd_megakernel, dim3(grid), dim3(512), LDS_BYTES, stream, a); }
#else
    a.ph_lo = 0; a.ph_hi = N_PHASES;
    void* args[] = {&a};
    hipError_t e = hipLaunchCooperativeKernel((const void*)fwd_megakernel, dim3(grid), dim3(512), args, LDS_BYTES, stream);
    if (e != hipSuccess) fprintf(stderr, "cooperative launch failed: %s (grid %d)\n", hipGetErrorString(e), grid);
#endif
}
```

```cpp
#include <hip/hip_runtime.h>
#include <hip/hip_cooperative_groups.h>
#include <cstdio>
#include <cstdint>
namespace cg = cooperative_groups;

#define LAS __attribute__((address_space(3)))
typedef unsigned short bf16_t;
typedef short bf16x8 __attribute__((ext_vector_type(8)));
typedef short s16x4 __attribute__((ext_vector_type(4)));
typedef float f32x4 __attribute__((ext_vector_type(4)));
typedef float f32x2 __attribute__((ext_vector_type(2)));
typedef float f32x16 __attribute__((ext_vector_type(16)));
typedef unsigned u32x4 __attribute__((ext_vector_type(4)));
typedef unsigned u32x2 __attribute__((ext_vector_type(2)));

constexpr int NB = 16, SEQ = 4096, DM = 1024, CTX = 256, ML = NB * SEQ, MC = NB * CTX, MT = ML + MC;
constexpr int LDP = 1792, DFF = 4096, NKEY = SEQ + CTX, NHEAD = 4, QKD = 96;
constexpr float EPS = 1e-6f;
constexpr float QSCALE = 0.10206207261596577f * 1.4426950408889634f;

constexpr size_t MiB = 1u << 20;
constexpr size_t WL = 24 * MiB;
constexpr size_t O_WIN = 0, O_WOUT = 3670016, O_W1 = 5767168, O_W2 = 14155776, O_WUQ = 22544384, O_WK = 22806528, O_WV = 22872064, O_WF = 22937600, O_POOL = 23199744;
constexpr size_t WS_CTL = 48 * MiB + 832 * 1024, CTL_BYTES = 16384;
constexpr size_t WS_MOD = 48 * MiB, WS_RQ = 49 * MiB, WS_RKV = 49 * MiB + 512 * 1024, WS_DFTC = 50 * MiB, WS_DFT = 51 * MiB, WS_XC = 115 * MiB, WS_H = 131 * MiB, WS_OV = 267 * MiB;
constexpr size_t WS_P = WS_OV, WS_MIX = WS_OV + 238 * MiB, WS_UT = WS_OV + 374 * MiB, WS_UTC = WS_OV + 438 * MiB, WS_Q = WS_OV + 442 * MiB, WS_QC = WS_OV + 490 * MiB,
                 WS_KC = WS_OV + 493 * MiB, WS_VT = WS_OV + 544 * MiB, WS_POOLIN = WS_OV + 578 * MiB, WS_ACT = WS_OV, WS_RSS = WS_OV + 613 * MiB, RSS_STRIDE = 512 * 1024, WS_VEC = WS_OV + 615 * MiB, WS_PT = WS_OV + 617 * MiB, WS_QT = WS_OV + 649 * MiB, WS_END = WS_OV + 681 * MiB;
constexpr size_t WS_ROPE = WS_VEC + 1 * MiB;
constexpr int V_GN2 = 0, V_CB2 = 2 * 17 * 1024, V_GN1 = V_CB2 + 2 * 17 * 4096, V_CB1 = V_GN1 + 17 * 1024;

__device__ __forceinline__ unsigned cvt_pk_bf16(float lo, float hi) { unsigned r; asm volatile("v_cvt_pk_bf16_f32 %0, %1, %2" : "=v"(r) : "v"(lo), "v"(hi)); return r; }
__device__ __forceinline__ unsigned f2bf(float f) { unsigned u = __builtin_bit_cast(unsigned, f); return (u + 0x7fffu + ((u >> 16) & 1u)) >> 16; }
__device__ __forceinline__ unsigned pk2(float lo, float hi) { return f2bf(lo) | (f2bf(hi) << 16); }
__device__ __forceinline__ float bflo(unsigned w) { return __uint_as_float(w << 16); }
__device__ __forceinline__ float bfhi(unsigned w) { return __uint_as_float(w & 0xffff0000u); }
__device__ __forceinline__ float bf1(bf16_t b) { return __uint_as_float((unsigned)b << 16); }
__device__ __forceinline__ float shx(float v, int mask, int lane) { return __builtin_bit_cast(float, __builtin_amdgcn_ds_bpermute((lane ^ mask) << 2, __builtin_bit_cast(int, v))); }
__device__ __forceinline__ float wave_sum(float v, int lane) {
#pragma unroll
    for (int o = 1; o < 64; o <<= 1) v += shx(v, o, lane);
    return v;
}
__device__ __forceinline__ float invfreq(int j) {
    return j == 0 ? 1.0f : j == 1 ? 0.31622776601683794f : j == 2 ? 0.1f : j == 3 ? 0.031622776601683794f : j == 4 ? 0.01f : j == 5 ? 0.0031622776601683794f : j == 6 ? 0.001f : 0.00031622776601683794f;
}

namespace pg8 {
constexpr int BM = 256, BK = 64, HALF = 128, HTB = HALF * BK * 2, STAGE_BYTES = 8 * HTB, NXCD = 8, WGM = 8;
__host__ __device__ __forceinline__ int lds_byte(int r, int c) { const int st = (r >> 4) * 2 + (c >> 5), rr = r & 15, cc = c & 31, ob = rr * 64 + cc * 2; return st * 1024 + (ob ^ (((ob >> 9) & 1) << 5)); }
__host__ __device__ __forceinline__ void stage_rc(int b, int& R, int& C) { const int st = b / 1024, sb = b % 1024, swz = sb ^ (((sb >> 9) & 1) << 5); R = (st >> 1) * 16 + swz / 64; C = (st & 1) * 32 + (swz % 64) / 2; }
__host__ __device__ __forceinline__ int perm32(int rho) { const int n = rho >> 4, i = rho & 15; return 8 * (i >> 2) + 4 * n + (i & 3); }
struct Unit { int pm, pn; };
__device__ __forceinline__ const char* uptr(const char* p) { const unsigned long long v = (unsigned long long)p; const unsigned lo = __builtin_amdgcn_readfirstlane((unsigned)v), hi = __builtin_amdgcn_readfirstlane((unsigned)(v >> 32)); return (const char*)(((unsigned long long)hi << 32) | lo); }
struct Gemm { const bf16_t* A; const bf16_t* Bt; int M, N, K, lda, ldb; };
struct StaticOrder {
    int nM, nN, nwg, G, c;
    __device__ void init(int M, int N, int G_, int c_) { nM = M / BM; nN = N / BM; nwg = nM * nN; G = G_; c = c_; }
    __device__ bool next(int i, Unit& u) const {
        const long L = (long)i * G + c; if (L >= nwg) return false;
        int wgid = (int)L; { const int q = nwg / NXCD, r = nwg % NXCD, xcd = wgid % NXCD, off = wgid / NXCD; wgid = (xcd < r ? xcd * (q + 1) : r * (q + 1) + (xcd - r) * q) + off; }
        const int nig = WGM * nN, gid = wgid / nig, fm = gid * WGM, gsz = (nM - fm) < WGM ? (nM - fm) : WGM;
        u.pm = fm + ((wgid % nig) % gsz); u.pn = (wgid % nig) / gsz; return true;
    }
};

template <class Epi>
__device__ __forceinline__ void gemm_phase(LAS unsigned char* lds, const Gemm g, const StaticOrder& S, const Epi& E, const int tid) {
    const int wid = __builtin_amdgcn_readfirstlane(tid >> 6), lane = tid & 63, wr = wid >> 2, wc = wid & 3, fr = lane & 15, fq = lane >> 4;
    const int K = g.K, nt = K / BK;
    unsigned voffA[2], voffB[2];
#pragma unroll
    for (int i = 0; i < 2; ++i) { int R, C; stage_rc(tid * 16 + i * 8192, R, C); const int Rb = (R & ~31) + perm32(R & 31);
        voffA[i] = (unsigned)(R * g.lda + C) * 2u; voffB[i] = (unsigned)(Rb * g.ldb + C) * 2u; }
    const size_t kstep = (size_t)(BK * 2);
    const size_t hsA = (size_t)HALF * g.lda * 2, hsB = (size_t)HALF * g.ldb * 2;
    const size_t tsA = 2 * hsA, tsB = 2 * hsB;
    const unsigned ldsw = (unsigned)wid * 1024u;
    const int aoff = lds_byte(wr * 64 + fr, fq * 8), boff = lds_byte(wc * 32 + fr, fq * 8);
#define PG8_SA(b, h) (((b) * 2 + (h)) * HTB)
#define PG8_SB(b, h) ((4 + (b) * 2 + (h)) * HTB)
#define PG8_STAGE(bufoff, gbase, voff) do { const char* _gb = uptr((const char*)(gbase)); _Pragma("unroll") for (int _i = 0; _i < 2; ++_i) \
        __builtin_amdgcn_global_load_lds((const unsigned*)(_gb + (voff)[_i]), (LAS unsigned*)(lds + (bufoff) + ldsw + _i * 8192), 16, 0, 0); } while (0)
#define PG8_LDA(dst, b, h) do { _Pragma("unroll") for (int m = 0; m < 4; ++m) _Pragma("unroll") for (int k = 0; k < 2; ++k) dst[m][k] = *(const LAS bf16x8*)(lds + PG8_SA(b, h) + aoff + m * 2048 + k * 1024); } while (0)
#define PG8_LDB(dst, b, h) do { _Pragma("unroll") for (int n = 0; n < 2; ++n) _Pragma("unroll") for (int k = 0; k < 2; ++k) dst[n][k] = *(const LAS bf16x8*)(lds + PG8_SB(b, h) + boff + n * 2048 + k * 1024); } while (0)
#define PG8_MMA(ai, bj, At, Bt) do { __builtin_amdgcn_s_setprio(1); _Pragma("unroll") for (int m = 0; m < 4; ++m) _Pragma("unroll") for (int n = 0; n < 2; ++n) _Pragma("unroll") for (int k = 0; k < 2; ++k) \
        acc[ai][bj][m][n] = __builtin_amdgcn_mfma_f32_16x16x32_bf16(Bt[n][k], At[m][k], acc[ai][bj][m][n], 0, 0, 0); __builtin_amdgcn_s_setprio(0); } while (0)
#define PG8_WAIT_V(n) asm volatile("s_waitcnt vmcnt(" #n ")" ::: "memory")
#define PG8_WAIT_L(n) asm volatile("s_waitcnt lgkmcnt(" #n ")" ::: "memory")
#define PG8_BAR __builtin_amdgcn_s_barrier()
#define PG8_SCHED __builtin_amdgcn_sched_barrier(0)
    Unit cur, nxt; int ui = 0;
    if (!S.next(0, cur)) return;
    f32x4 acc[2][2][4][2];
#pragma unroll
    for (int a = 0; a < 2; ++a)
#pragma unroll
        for (int b = 0; b < 2; ++b)
#pragma unroll
            for (int m = 0; m < 4; ++m)
#pragma unroll
                for (int n = 0; n < 2; ++n) acc[a][b][m][n] = (f32x4){0.f, 0.f, 0.f, 0.f};
    bf16x8 At[4][2], B0[2][2], B1[2][2];
    const char* cA = (const char*)g.A + (size_t)cur.pm * tsA; const char* cB = (const char*)g.Bt + (size_t)cur.pn * tsB;
    PG8_STAGE(PG8_SB(0, 0), cB, voffB); PG8_STAGE(PG8_SB(0, 1), cB + hsB, voffB); PG8_STAGE(PG8_SA(0, 0), cA, voffA); PG8_STAGE(PG8_SA(0, 1), cA + hsA, voffA);
    if (wr == 1) PG8_BAR;
    PG8_WAIT_V(2); PG8_BAR;
    PG8_STAGE(PG8_SB(1, 0), cB + kstep, voffB); PG8_STAGE(PG8_SA(1, 0), cA + kstep, voffA); PG8_STAGE(PG8_SB(1, 1), cB + hsB + kstep, voffB);
    PG8_WAIT_V(6); PG8_BAR;
    for (;;) {
        const bool has_next = S.next(ui + 1, nxt);
        const char* nA = has_next ? (const char*)g.A + (size_t)nxt.pm * tsA : cA; const char* nB = has_next ? (const char*)g.Bt + (size_t)nxt.pn * tsB : cB;
        for (int t = 0; t < nt; t += 2) {
            const bool last = (t == nt - 2);
            const char* a1 = cA + (size_t)(t + 1) * kstep;
            const char* a2 = last ? nA : cA + (size_t)(t + 2) * kstep; const char* b2 = last ? nB : cB + (size_t)(t + 2) * kstep;
            const char* a3 = a2 + kstep; const char* b3 = b2 + kstep;
            PG8_LDB(B0, 0, 0); PG8_LDB(B1, 0, 1); PG8_SCHED; PG8_LDA(At, 0, 0); PG8_STAGE(PG8_SA(1, 1), a1 + hsA, voffA);
            PG8_WAIT_V(8); PG8_WAIT_L(0); PG8_BAR; PG8_MMA(0, 0, At, B0); PG8_MMA(0, 1, At, B1); PG8_BAR; PG8_SCHED;
            PG8_LDA(At, 0, 1); PG8_STAGE(PG8_SB(0, 0), b2, voffB); PG8_STAGE(PG8_SB(0, 1), b2 + hsB, voffB); PG8_STAGE(PG8_SA(0, 0), a2, voffA);
            PG8_WAIT_V(8); PG8_WAIT_L(0); PG8_BAR; PG8_MMA(1, 0, At, B0); PG8_MMA(1, 1, At, B1); PG8_BAR; PG8_SCHED;
            PG8_LDB(B0, 1, 0); PG8_LDB(B1, 1, 1); PG8_SCHED; PG8_LDA(At, 1, 0); PG8_STAGE(PG8_SA(0, 1), a2 + hsA, voffA);
            PG8_WAIT_V(8); PG8_WAIT_L(0); PG8_BAR; PG8_MMA(0, 0, At, B0); PG8_MMA(0, 1, At, B1); PG8_BAR; PG8_SCHED;
            PG8_LDA(At, 1, 1); PG8_STAGE(PG8_SB(1, 0), b3, voffB); PG8_STAGE(PG8_SB(1, 1), b3 + hsB, voffB); PG8_STAGE(PG8_SA(1, 0), a3, voffA);
            PG8_WAIT_V(8); PG8_WAIT_L(0); PG8_BAR; PG8_MMA(1, 0, At, B0); PG8_MMA(1, 1, At, B1); PG8_BAR; PG8_SCHED;
        }
        if (wr == 0) PG8_BAR;
        E(acc, cur, wr, wc, fr, fq);
        if (!has_next) break;
#pragma unroll
        for (int a = 0; a < 2; ++a)
#pragma unroll
            for (int b = 0; b < 2; ++b)
#pragma unroll
                for (int m = 0; m < 4; ++m)
#pragma unroll
                    for (int n = 0; n < 2; ++n) acc[a][b][m][n] = (f32x4){0.f, 0.f, 0.f, 0.f};
        cur = nxt; cA = nA; cB = nB; ++ui;
        if (wr == 1) PG8_BAR;
    }
    PG8_WAIT_V(0);
    PG8_BAR;
#undef PG8_SA
#undef PG8_SB
#undef PG8_STAGE
#undef PG8_LDA
#undef PG8_LDB
#undef PG8_MMA
#undef PG8_WAIT_V
#undef PG8_WAIT_L
#undef PG8_BAR
#undef PG8_SCHED
}
}

enum { M_P = 0, M_UT = 1, M_Q = 2, M_K = 3, M_VT = 4, M_POOL = 5, M_DFT = 6, M_DFTC = 7, M_RES = 8, M_RELU2 = 9, M_PS = 10, M_F32 = 11 };
struct EpiArgs {
    bf16_t* o0; bf16_t* o1;
    const float* f0; const float* f1;
    float* x0; float* x1;
    int ld; int goff;
};
__device__ __forceinline__ u32x4 pack8(const f32x4& a, const f32x4& b) { u32x4 w; w.x = cvt_pk_bf16(a[0], a[1]); w.y = cvt_pk_bf16(a[2], a[3]); w.z = cvt_pk_bf16(b[0], b[1]); w.w = cvt_pk_bf16(b[2], b[3]); return w; }

#define GAS __attribute__((address_space(1)))
typedef GAS u32x4* gv4p; typedef GAS f32x4* gf4p; typedef const GAS f32x4* gcf4p; typedef const GAS float* gcfp;
template <int MODE> __device__ __forceinline__ void store8(const EpiArgs& e, int row, int col, f32x4 v0, f32x4 v1, const f32x4 sA, const f32x4 sB) {
    if constexpr (MODE == M_P || MODE == M_PS) {
        *(gv4p)(e.o0 + (size_t)row * e.ld + col) = pack8(v0, v1);
    } else if constexpr (MODE == M_UT) {
        const int part = row >> 8, n = row & 255;
        bf16_t* dst;
        if (col < ML) { const int b = col >> 12, t = col & 4095; dst = e.o0 + ((size_t)(b * 256 + n) * 8192 + part * 4096 + t); }
        else { const int cc = col - ML, b = cc >> 8, t = cc & 255; dst = e.o1 + ((size_t)(b * 256 + n) * 512 + part * 256 + t); }
        *(gv4p)dst = pack8(v0, v1);
    } else if constexpr (MODE == M_Q) {
        if (col < 384) {
            const float s = sA[0];
            bf16_t* dst = row < ML ? e.o0 + (size_t)row * 384 + col : e.o1 + (size_t)(row - ML) * 384 + col;
            *(gv4p)dst = pack8(v0 * s, v1 * s);
        }
    } else if constexpr (MODE == M_K) {
        const int h = col >> 6, d = col & 63; const float s = sA[0];
        int b, key; if (row < ML) { b = row >> 12; key = CTX + (row & 4095); } else { const int rr = row - ML; b = rr >> 8; key = rr & 255; }
        *(gv4p)(e.o0 + ((size_t)((b * 4 + h) * NKEY + key) * QKD + d)) = pack8(v0 * s, v1 * s);
    } else if constexpr (MODE == M_VT) {
        int b, key; if (col < ML) { b = col >> 12; key = CTX + (col & 4095); } else { const int cc = col - ML; b = cc >> 8; key = cc & 255; }
        const u32x4 w = pack8(v0 * sA, v1 * sB); const int half = (key >> 3) & 1;
        GAS bf16_t* d = (GAS bf16_t*)e.o0 + ((size_t)(b * 256 + row) * NKEY + (key & ~15));
        *(GAS u32x2*)(d + (half ? 4 : 0)) = (u32x2){w.x, w.y}; *(GAS u32x2*)(d + (half ? 12 : 8)) = (u32x2){w.z, w.w};
    } else if constexpr (MODE == M_POOL) {
        *(gv4p)(e.o0 + (size_t)row * DM + 512 + col) = pack8(v0 * sA, v1 * sB);
    } else if constexpr (MODE == M_DFT) {
        const int b = col >> 8, n = col & 255;
        *(gv4p)(e.o0 + (size_t)(b * SEQ + row) * DM + n) = pack8(v0 * (1.f / 512.f), v1 * (1.f / 512.f));
    } else if constexpr (MODE == M_F32) {
        GAS float* d = (GAS float*)e.o0 + (size_t)row * 4096 + col; *(gf4p)d = v0; *(gf4p)(d + 4) = v1;
    } else if constexpr (MODE == M_DFTC) {
        const int b = col >> 8, n = col & 255;
        *(gv4p)(e.o0 + (size_t)(ML + b * CTX + row) * DM + n) = pack8(v0 * (1.f / 128.f), v1 * (1.f / 128.f));
    } else if constexpr (MODE == M_RELU2) {
#pragma unroll
        for (int i = 0; i < 4; ++i) { const float a = fmaxf(v0[i], 0.f), b = fmaxf(v1[i], 0.f); v0[i] = a * a; v1[i] = b * b; }
        *(gv4p)(e.o0 + (size_t)row * e.ld + col) = pack8(v0, v1);
    }
}
template <int MODE> __device__ __forceinline__ void epi_loops(const EpiArgs& e, const f32x4 (&acc)[2][2][4][2], const pg8::Unit& u, int wr, int wc, int fr, int fq) {
    const int row0 = u.pm * 256 + wr * 64 + fr, col0 = u.pn * 256 + wc * 32 + 8 * fq;
    const f32x4 zero4 = (f32x4){0.f, 0.f, 0.f, 0.f};
    if constexpr (MODE == M_RES) {
        const int bi = row0 < ML ? (row0 >> 12) : 16;
        gcfp gp = (gcfp)((const float*)e.o1 + (size_t)bi * 6144 + e.goff + col0);
        f32x4 gt[2][2];
#pragma unroll
        for (int bj = 0; bj < 2; ++bj) { gt[bj][0] = *(gcf4p)(gp + bj * 128); gt[bj][1] = *(gcf4p)(gp + bj * 128 + 4); }
        const bool lat = row0 < ML;
        gcfp sbase = lat ? (gcfp)(e.f0 + (size_t)row0 * DM + col0) : (gcfp)(e.f1 + (size_t)(row0 - ML) * DM + col0);
        GAS float* dbase = lat ? (GAS float*)(e.x0 + (size_t)row0 * DM + col0) : (GAS float*)(e.x1 + (size_t)(row0 - ML) * DM + col0);
        const int emit = e.ld;
        unsigned char* wsb = (unsigned char*)e.x1 - WS_XC;
        const float* vec = (const float*)(wsb + WS_VEC);
        gcfp gnp = (gcfp)(vec + (emit == 3 ? V_GN1 : V_GN2 + (emit == 2 ? 17 * 1024 : 0)) + bi * 1024 + col0);
        GAS float* rss = (GAS float*)(wsb + WS_RSS + (size_t)(emit > 0 ? emit - 1 : 0) * RSS_STRIDE) + row0;
        GAS bf16_t* hbase = (GAS bf16_t*)(wsb + WS_H) + (size_t)row0 * DM + col0;
        f32x4 gn[2][2];
#pragma unroll
        for (int bj = 0; bj < 2; ++bj) { gn[bj][0] = emit ? *(gcf4p)(gnp + bj * 128) : zero4; gn[bj][1] = emit ? *(gcf4p)(gnp + bj * 128 + 4) : zero4; }
        const int lane_e = fq * 16 + fr;
        f32x4 cur[2][2], nxt[2][2];
#pragma unroll
        for (int bj = 0; bj < 2; ++bj) { cur[bj][0] = *(gcf4p)(sbase + bj * 128); cur[bj][1] = *(gcf4p)(sbase + bj * 128 + 4); }
#pragma unroll
        for (int g = 0; g < 8; ++g) {
            const int ai = g >> 2, m = g & 3;
            if (g + 1 < 8) { const int a2 = (g + 1) >> 2, m2 = (g + 1) & 3; const size_t off = (size_t)(a2 * 128 + m2 * 16) * DM;
#pragma unroll
                for (int bj = 0; bj < 2; ++bj) { nxt[bj][0] = *(gcf4p)(sbase + off + bj * 128); nxt[bj][1] = *(gcf4p)(sbase + off + bj * 128 + 4); } }
            const size_t offc = (size_t)(ai * 128 + m * 16) * DM;
            float sq = 0.f;
#pragma unroll
            for (int bj = 0; bj < 2; ++bj) {
                const f32x4 x0 = cur[bj][0] + gt[bj][0] * acc[ai][bj][m][0], x1 = cur[bj][1] + gt[bj][1] * acc[ai][bj][m][1];
                *(gf4p)(dbase + offc + bj * 128) = x0; *(gf4p)(dbase + offc + bj * 128 + 4) = x1;
                if (emit) { *(gv4p)(hbase + offc + bj * 128) = pack8(x0 * gn[bj][0], x1 * gn[bj][1]);
                    sq += (x0[0] * x0[0] + x0[1] * x0[1]) + (x0[2] * x0[2] + x0[3] * x0[3]) + (x1[0] * x1[0] + x1[1] * x1[1]) + (x1[2] * x1[2] + x1[3] * x1[3]); }
            }
            if (emit) { sq += shx(sq, 16, lane_e); sq += shx(sq, 32, lane_e); if (fq == 0) atomicAdd((float*)(rss + ai * 128 + m * 16), sq); }
            asm volatile("" ::: "memory");
#pragma unroll
            for (int bj = 0; bj < 2; ++bj) { cur[bj][0] = nxt[bj][0]; cur[bj][1] = nxt[bj][1]; }
        }
    } else {
        float rs[8]; f32x4 cs[2][2];
        if constexpr (MODE == M_Q || MODE == M_K) {
#pragma unroll
            for (int g = 0; g < 8; ++g) rs[g] = ((gcfp)e.f0)[row0 + (g >> 2) * 128 + (g & 3) * 16] * (MODE == M_Q ? QSCALE : 1.0f);
        }
        if constexpr (MODE == M_VT || MODE == M_POOL) {
#pragma unroll
            for (int bj = 0; bj < 2; ++bj) { cs[bj][0] = *(gcf4p)(e.f0 + col0 + bj * 128); cs[bj][1] = *(gcf4p)(e.f0 + col0 + bj * 128 + 4); }
        }
        if constexpr (MODE == M_RELU2 || MODE == M_PS) {
            const int bi = row0 < ML ? (row0 >> 12) : 16;
#pragma unroll
            for (int g = 0; g < 8; ++g) rs[g] = 1.0f / sqrtf(((gcfp)e.f0)[row0 + (g >> 2) * 128 + (g & 3) * 16] * (1.f / DM) + EPS);
#pragma unroll
            for (int bj = 0; bj < 2; ++bj) { cs[bj][0] = *(gcf4p)(e.f1 + (size_t)bi * e.goff + col0 + bj * 128); cs[bj][1] = *(gcf4p)(e.f1 + (size_t)bi * e.goff + col0 + bj * 128 + 4); }
        }
#pragma unroll
        for (int ai = 0; ai < 2; ++ai)
#pragma unroll
            for (int m = 0; m < 4; ++m)
#pragma unroll
                for (int bj = 0; bj < 2; ++bj) {
                    f32x4 sA = zero4, sB = zero4;
                    if constexpr (MODE == M_Q || MODE == M_K) sA[0] = rs[ai * 4 + m];
                    if constexpr (MODE == M_VT || MODE == M_POOL) { sA = cs[bj][0]; sB = cs[bj][1]; }
                    if constexpr (MODE == M_RELU2 || MODE == M_PS) { const float rr = rs[ai * 4 + m];
                        store8<MODE>(e, row0 + ai * 128 + m * 16, col0 + bj * 128, acc[ai][bj][m][0] * rr + cs[bj][0], acc[ai][bj][m][1] * rr + cs[bj][1], sA, sB); }
                    else
                    store8<MODE>(e, row0 + ai * 128 + m * 16, col0 + bj * 128, acc[ai][bj][m][0], acc[ai][bj][m][1], sA, sB);
                }
    }
}
struct Epi {
    int mode; EpiArgs e;
    __device__ __forceinline__ void operator()(const f32x4 (&acc)[2][2][4][2], const pg8::Unit& u, int wr, int wc, int fr, int fq) const {
        switch (mode) {
            case M_P: epi_loops<M_P>(e, acc, u, wr, wc, fr, fq); break;
            case M_UT: epi_loops<M_UT>(e, acc, u, wr, wc, fr, fq); break;
            case M_Q: epi_loops<M_Q>(e, acc, u, wr, wc, fr, fq); break;
            case M_K: epi_loops<M_K>(e, acc, u, wr, wc, fr, fq); break;
            case M_VT: epi_loops<M_VT>(e, acc, u, wr, wc, fr, fq); break;
            case M_POOL: epi_loops<M_POOL>(e, acc, u, wr, wc, fr, fq); break;
            case M_DFTC: epi_loops<M_DFTC>(e, acc, u, wr, wc, fr, fq); break;
            case M_RES: epi_loops<M_RES>(e, acc, u, wr, wc, fr, fq); break;
            case M_PS: epi_loops<M_PS>(e, acc, u, wr, wc, fr, fq); break;
            case M_F32: epi_loops<M_F32>(e, acc, u, wr, wc, fr, fq); break;
            default: epi_loops<M_RELU2>(e, acc, u, wr, wc, fr, fq); break;
        }
    }
};

struct Args { const float* in[21]; float* out; unsigned char* ws; int ph_lo, ph_hi; };
typedef const __attribute__((address_space(4))) Args* KArgs;

__device__ __forceinline__ void transpose_item(const float* W, int K, int N, bf16_t* WT, LAS float* scr, int item, int lane) {
    const int nblk = N / 32, kb = item / nblk, nb = item % nblk, k0 = 64 * kb, n0 = 32 * nb;
#pragma unroll 8
    for (int i = 0; i < 32; ++i) { const int kk = 2 * i + (lane >> 5); scr[kk * 33 + (lane & 31)] = W[(size_t)(k0 + kk) * N + n0 + (lane & 31)]; }
    asm volatile("s_waitcnt lgkmcnt(0)" ::: "memory");
    const int c = lane & 7;
#pragma unroll
    for (int j = 0; j < 4; ++j) { const int n = (lane >> 3) + 8 * j; const LAS float* s = scr + (8 * c) * 33 + n;
        u32x4 o; o.x = pk2(s[0 * 33], s[1 * 33]); o.y = pk2(s[2 * 33], s[3 * 33]); o.z = pk2(s[4 * 33], s[5 * 33]); o.w = pk2(s[6 * 33], s[7 * 33]);
        *(u32x4*)(WT + (size_t)(n0 + n) * K + k0 + 8 * c) = o; }
    asm volatile("s_waitcnt lgkmcnt(0)" ::: "memory");
}

__device__ __forceinline__ void phase_setup(KArgs ap, unsigned char* ws, LAS unsigned char* lds, int tid, int lane, int wave, const int BX, const int G) {
    {
        LAS float* S = (LAS float*)lds;
        LAS float* part = (LAS float*)(lds + 17 * 1024 * 4);
        float* mod = (float*)(ws + WS_MOD);
        if (BX < 192) {
            for (int i = tid; i < 17 * 1024; i += 512) { const int r = i >> 10, k = i & 1023; const float v = r < 16 ? ap->in[1][r * 1024 + k] : ap->in[3][k]; S[i] = v / (1.f + expf(-v)); }
        }
        __syncthreads();
        for (int item = BX; item < 192; item += G) {
            const int l = item / 96, n0 = (item % 96) * 64;
            const float* W = ap->in[4] + (size_t)l * 1024 * 6144 + n0 + lane;
            float acc[17];
#pragma unroll
            for (int r = 0; r < 17; ++r) acc[r] = 0.f;
            for (int k = wave * 128; k < wave * 128 + 128; k += 4) {
                const float w0 = W[(size_t)k * 6144], w1 = W[(size_t)(k + 1) * 6144], w2 = W[(size_t)(k + 2) * 6144], w3 = W[(size_t)(k + 3) * 6144];
#pragma unroll
                for (int r = 0; r < 17; ++r) { const f32x4 s = *(const LAS f32x4*)(S + r * 1024 + k); acc[r] += s[0] * w0 + s[1] * w1 + s[2] * w2 + s[3] * w3; }
            }
#pragma unroll
            for (int r = 0; r < 17; ++r) part[(wave * 17 + r) * 64 + lane] = acc[r];
            __syncthreads();
            for (int i = tid; i < 17 * 64; i += 512) { const int r = i >> 6, j = i & 63; float s = ap->in[5][l * 6144 + n0 + j];
#pragma unroll
                for (int w = 0; w < 8; ++w) s += part[(w * 17 + r) * 64 + j];
                mod[(size_t)(l * 17 + r) * 6144 + n0 + j] = s; }
            __syncthreads();
        }
    }
    {
        LAS float* scr = (LAS float*)(lds + wave * 16384);
        const int gw = BX * 8 + wave, NGW = G * 8;
        constexpr int I_IN = 16 * 53, I_OUT = 16 * 32, I_1 = 16 * 128, I_2 = 64 * 32, I_L = I_IN + I_OUT + I_1 + I_2;
        for (int it = gw; it < 2 * I_L; it += NGW) {
            const int l = it / I_L; int r = it % I_L; unsigned char* wl = ws + l * WL;
            if (r < I_IN) { transpose_item(ap->in[8] + (size_t)l * 1024 * 1696, 1024, 1696, (bf16_t*)(wl + O_WIN), scr, r, lane); continue; } r -= I_IN;
            if (r < I_OUT) { transpose_item(ap->in[17] + (size_t)l * 1024 * 1024, 1024, 1024, (bf16_t*)(wl + O_WOUT), scr, r, lane); continue; } r -= I_OUT;
            if (r < I_1) { transpose_item(ap->in[18] + (size_t)l * 1024 * 4096, 1024, 4096, (bf16_t*)(wl + O_W1), scr, r, lane); continue; } r -= I_1;
            transpose_item(ap->in[19] + (size_t)l * 4096 * 1024, 4096, 1024, (bf16_t*)(wl + O_W2), scr, r, lane);
        }
    }
    {
        const int gt = BX * 512 + tid, NGT = G * 512;
        for (int l = 0; l < 2; ++l) {
            unsigned char* wl = ws + l * WL;
            { unsigned* z = (unsigned*)((bf16_t*)(wl + O_WIN) + (size_t)1696 * 1024); for (int i = gt; i < 96 * 1024 / 2; i += NGT) z[i] = 0u; }
            { bf16_t* o = (bf16_t*)(wl + O_WUQ); const float* w = ap->in[14] + (size_t)l * 256 * 384; const float* gq = ap->in[13] + l * 256;
              for (int i = gt; i < 512 * 256; i += NGT) { const int n = i >> 8, k = i & 255; o[i] = (bf16_t)(n < 384 ? f2bf(gq[k] * w[k * 384 + n]) : 0u); } }
            { bf16_t* ok = (bf16_t*)(wl + O_WK); bf16_t* ov = (bf16_t*)(wl + O_WV); const float* w = ap->in[16] + (size_t)l * 128 * 512; const float* gk = ap->in[15] + l * 128;
              for (int i = gt; i < 256 * 128; i += NGT) { const int n = i >> 7, k = i & 127, h = n >> 6, d = n & 63; const float gg = gk[k];
                  ok[i] = (bf16_t)f2bf(gg * w[k * 512 + h * 128 + d]); ov[i] = (bf16_t)f2bf(gg * w[k * 512 + h * 128 + 64 + d]); } }
            { bf16_t* o = (bf16_t*)(wl + O_WF); const float* fw = ap->in[9] + (size_t)l * 256 * 256;
              for (int i = gt; i < 512 * 256; i += NGT) { const int r = i >> 8, kin = i & 255, part = r >> 8, n = r & 255, h = kin >> 6, c = kin & 63; float s = 0.f;
                  for (int k2 = 0; k2 < 64; ++k2) { const float ang = (float)((c * k2) & 63) * (1.f / 32.f); const float tr = part ? sinpif(ang) : cospif(ang); s += tr * fw[(h * 64 + k2) * 256 + n]; }
                  o[i] = (bf16_t)f2bf(s); } }
            { bf16_t* o = (bf16_t*)(wl + O_POOL); const float* pw = ap->in[11] + (size_t)l * 4 * 64 * 64;
              for (int i = gt; i < 256 * 256; i += NGT) { const int r = i >> 8, k = i & 255, g = r >> 6, n = r & 63; o[i] = (bf16_t)((k >> 6) == g ? f2bf(pw[(g * 64 + (k & 63)) * 64 + n]) : 0u); } }
        }
        { float* tab = (float*)(ws + WS_ROPE); for (int i = gt; i < 512; i += NGT) { float sn, cs; sincosf((float)(i >> 3) * invfreq(i & 7), &sn, &cs); tab[2 * i] = cs; tab[2 * i + 1] = sn; } }
        { u32x4* z = (u32x4*)(ws + WS_RSS); for (int i = gt; i < (int)(3 * RSS_STRIDE / 16); i += NGT) z[i] = (u32x4){0u, 0u, 0u, 0u}; }
        { u32x4* o = (u32x4*)(ws + WS_DFT);
          for (int i = gt; i < 2 * 2048 * 512; i += NGT) { const int part = i >> 20, ii = i & ((1 << 20) - 1), row = ii >> 9, t0 = (ii & 511) * 8; float v[8];
#pragma unroll
              for (int e = 0; e < 8; ++e) { const float ang = (float)(((row + 1) * (t0 + e)) & 4095) * (1.f / 2048.f); v[e] = part ? sinpif(ang) : cospif(ang); }
              u32x4 w; w.x = pk2(v[0], v[1]); w.y = pk2(v[2], v[3]); w.z = pk2(v[4], v[5]); w.w = pk2(v[6], v[7]); o[i] = w; } }
        { u32x4* o = (u32x4*)(ws + WS_DFTC);
          for (int i = gt; i < 256 * 64; i += NGT) { const int row = i >> 6, j0 = (i & 63) * 8; float v[8];
#pragma unroll
              for (int e = 0; e < 8; ++e) { const int j = j0 + e, t = j & 255; const float ang = (float)((row * t) & 255) * (1.f / 128.f); v[e] = (j >> 8) ? -sinpif(ang) : cospif(ang); }
              u32x4 w; w.x = pk2(v[0], v[1]); w.y = pk2(v[2], v[3]); w.z = pk2(v[4], v[5]); w.w = pk2(v[6], v[7]); o[i] = w; } }
    }
}

__device__ __forceinline__ void phase_vectors(KArgs ap, unsigned char* ws, LAS unsigned char* lds, int tid, int lane, int wave, const int BX, const int G) {
    const float* mod = (const float*)(ws + WS_MOD);
    float* vec = (float*)(ws + WS_VEC);
    { const int gt = BX * 512 + tid, NGT = G * 512;
      for (int i = gt; i < 2 * 17 * 1024; i += NGT) { const int l = i / (17 * 1024), r = (i >> 10) % 17, k = i & 1023; vec[V_GN2 + i] = ap->in[7][l * 1024 + k] * (1.0f + mod[(size_t)(l * 17 + r) * 6144 + 4096 + k]); }
      for (int i = gt; i < 17 * 1024; i += NGT) { const int r = i >> 10, k = i & 1023; vec[V_GN1 + i] = ap->in[6][1024 + k] * (1.0f + mod[(size_t)(17 + r) * 6144 + 1024 + k]); } }
    LAS float* S = (LAS float*)lds;
    LAS float* part = (LAS float*)(lds + 17 * 1024 * 4);
    for (int item = BX; item < 156; item += G) {
        const bool up = item < 128;
        const int l = up ? item / 64 : 1, n0 = up ? (item % 64) * 64 : (item - 128) * 64, N = up ? 4096 : 1696, soff = up ? 3072 : 0;
        const float* Wb = up ? ap->in[18] + (size_t)l * 1024 * 4096 : ap->in[8] + (size_t)1024 * 1696;
        __syncthreads();
        for (int i = tid; i < 17 * 1024; i += 512) { const int r = i >> 10, k = i & 1023; S[i] = mod[(size_t)(l * 17 + r) * 6144 + soff + k]; }
        __syncthreads();
        const bool cv = n0 + lane < N;
        const float* W = Wb + n0 + (cv ? lane : 0);
        float acc[17];
#pragma unroll
        for (int r = 0; r < 17; ++r) acc[r] = 0.f;
        for (int k = wave * 128; k < wave * 128 + 128; k += 4) {
            const float w0 = W[(size_t)k * N], w1 = W[(size_t)(k + 1) * N], w2 = W[(size_t)(k + 2) * N], w3 = W[(size_t)(k + 3) * N];
#pragma unroll
            for (int r = 0; r < 17; ++r) { const f32x4 sv = *(const LAS f32x4*)(S + r * 1024 + k); acc[r] += sv[0] * w0 + sv[1] * w1 + sv[2] * w2 + sv[3] * w3; }
        }
#pragma unroll
        for (int r = 0; r < 17; ++r) part[(wave * 17 + r) * 64 + lane] = cv ? acc[r] : 0.f;
        __syncthreads();
        for (int i = tid; i < 17 * 64; i += 512) { const int r = i >> 6, j = i & 63; float sum = 0.f;
#pragma unroll
            for (int w = 0; w < 8; ++w) sum += part[(w * 17 + r) * 64 + j];
            if (up) vec[V_CB2 + (size_t)(l * 17 + r) * 4096 + n0 + j] = sum; else vec[V_CB1 + (size_t)r * 1792 + n0 + j] = sum; }
    }
    __syncthreads();
}
constexpr int RPI = 4;
__device__ __forceinline__ void phase_norm_mod(const float* xl, const float* xc, const float* g, const float* mod, int shoff, int scoff, bf16_t* H, int nrows, int lane, int wave, const int BX, const int G) {
    const int gw = BX * 8 + wave, NGW = G * 8;
    for (int row0 = gw; row0 < nrows; row0 += NGW * RPI) {
        f32x4 v[RPI][4]; float ss[RPI];
#pragma unroll
        for (int i = 0; i < RPI; ++i) { const int row = row0 + i * NGW; ss[i] = 0.f;
            if (row < nrows) { const float* src = row < ML ? xl + (size_t)row * DM : xc + (size_t)(row - ML) * DM;
#pragma unroll
                for (int j = 0; j < 4; ++j) v[i][j] = *(const f32x4*)(src + lane * 4 + 256 * j); }
            else {
#pragma unroll
                for (int j = 0; j < 4; ++j) v[i][j] = (f32x4){0.f, 0.f, 0.f, 0.f}; } }
#pragma unroll
        for (int i = 0; i < RPI; ++i) {
#pragma unroll
            for (int j = 0; j < 4; ++j) ss[i] += (v[i][j][0] * v[i][j][0] + v[i][j][1] * v[i][j][1]) + (v[i][j][2] * v[i][j][2] + v[i][j][3] * v[i][j][3]); }
#pragma unroll
        for (int o = 1; o < 64; o <<= 1) {
#pragma unroll
            for (int i = 0; i < RPI; ++i) ss[i] += shx(ss[i], o, lane); }
#pragma unroll
        for (int i = 0; i < RPI; ++i) { const int row = row0 + i * NGW;
            if (row < nrows) {
                const float rr = 1.0f / sqrtf(ss[i] * (1.f / DM) + EPS);
                const float* mv = mod + (size_t)(row < ML ? (row >> 12) : 16) * 6144;
#pragma unroll
                for (int j = 0; j < 4; ++j) { const int col = lane * 4 + 256 * j;
                    const f32x4 gg = *(const f32x4*)(g + col), sc = *(const f32x4*)(mv + scoff + col), sh = *(const f32x4*)(mv + shoff + col);
                    const f32x4 o = (v[i][j] * rr * gg) * (sc + 1.0f) + sh;
                    u32x2 w; w.x = cvt_pk_bf16(o[0], o[1]); w.y = cvt_pk_bf16(o[2], o[3]);
                    *(u32x2*)(H + (size_t)row * DM + col) = w; } } }
    }
}
__device__ __forceinline__ void phase_final_norm(float* x, const float* g, int lane, int wave, const int BX, const int G) {
    const int gw = BX * 8 + wave, NGW = G * 8;
    for (int row0 = gw; row0 < ML; row0 += NGW * RPI) {
        f32x4 v[RPI][4]; float ss[RPI];
#pragma unroll
        for (int i = 0; i < RPI; ++i) { const int row = row0 + i * NGW; ss[i] = 0.f;
#pragma unroll
            for (int j = 0; j < 4; ++j) v[i][j] = *(const f32x4*)(x + (size_t)row * DM + lane * 4 + 256 * j); }
#pragma unroll
        for (int i = 0; i < RPI; ++i) {
#pragma unroll
            for (int j = 0; j < 4; ++j) ss[i] += (v[i][j][0] * v[i][j][0] + v[i][j][1] * v[i][j][1]) + (v[i][j][2] * v[i][j][2] + v[i][j][3] * v[i][j][3]); }
#pragma unroll
        for (int o = 1; o < 64; o <<= 1) {
#pragma unroll
            for (int i = 0; i < RPI; ++i) ss[i] += shx(ss[i], o, lane); }
#pragma unroll
        for (int i = 0; i < RPI; ++i) { const int row = row0 + i * NGW;
            const float rr = 1.0f / sqrtf(ss[i] * (1.f / DM) + EPS);
#pragma unroll
            for (int j = 0; j < 4; ++j) { const int col = lane * 4 + 256 * j; const f32x4 gg = *(const f32x4*)(g + col); *(f32x4*)(x + (size_t)row * DM + col) = v[i][j] * rr * gg; } }
    }
}

__device__ __forceinline__ void phase_token_local(const bf16_t* P, float* rq, float* rkv, bf16_t* Kc, bf16_t* MIX, bf16_t* POOLIN, const float* conv_w, const float* ropetab, int tid, int lane, int wave, const int BX, const int G) {
    const int gw = BX * 8 + wave, NGW = G * 8;
    for (int row0 = gw; row0 < MT; row0 += NGW * RPI) {
        u32x2 cq[RPI]; unsigned ck[RPI]; float sq[RPI], sk[RPI];
#pragma unroll
        for (int i = 0; i < RPI; ++i) { const int row = min(row0 + i * NGW, MT - 1); const GAS bf16_t* pr = (const GAS bf16_t*)P + (size_t)row * LDP;
            cq[i] = *(const GAS u32x2*)(pr + 1280 + lane * 4); ck[i] = *(const GAS unsigned*)(pr + 1536 + lane * 2); }
#pragma unroll
        for (int i = 0; i < RPI; ++i) { const float a0 = bflo(cq[i].x), a1 = bfhi(cq[i].x), a2 = bflo(cq[i].y), a3 = bfhi(cq[i].y), k0 = bflo(ck[i]), k1 = bfhi(ck[i]);
            sq[i] = (a0 * a0 + a1 * a1) + (a2 * a2 + a3 * a3); sk[i] = k0 * k0 + k1 * k1; }
#pragma unroll
        for (int o = 1; o < 64; o <<= 1) {
#pragma unroll
            for (int i = 0; i < RPI; ++i) { sq[i] += shx(sq[i], o, lane); sk[i] += shx(sk[i], o, lane); } }
#pragma unroll
        for (int i = 0; i < RPI; ++i) { const int row = row0 + i * NGW;
            if (row < MT && lane == 0) { ((GAS float*)rq)[row] = 1.0f / sqrtf(sq[i] * (1.f / 256.f) + EPS); ((GAS float*)rkv)[row] = 1.0f / sqrtf(sk[i] * (1.f / 128.f) + EPS); } }
    }
    {
        const int gt0 = BX * 512 + tid, NGT0 = G * 512;
        for (int e = gt0; e < MT * 4; e += NGT0) {
            const int row = e >> 2, L = e & 3;
            const bool lat = row < ML; int b, t, key;
            if (lat) { b = row >> 12; t = row & 4095; key = CTX + t; } else { const int rr = row - ML; b = rr >> 8; t = rr & 255; key = t; }
            const GAS bf16_t* pr = (const GAS bf16_t*)P + (size_t)row * LDP + 1664;
            const u32x4 own = *(const GAS u32x4*)(pr + 8 * L), par = *(const GAS u32x4*)(pr + 8 * (L ^ 1));
            u32x4 outw = own;
            if (lat) {
                const int ipos = (L & 2) ? (t & 63) : (t >> 6);
                const GAS f32x4* tb = (const GAS f32x4*)(ropetab + ipos * 16);
                const f32x4 t0 = tb[0], t1 = tb[1], t2 = tb[2], t3 = tb[3];
                const float sg = (L & 1) ? 1.0f : -1.0f;
                float xo[8] = {bflo(own.x), bfhi(own.x), bflo(own.y), bfhi(own.y), bflo(own.z), bfhi(own.z), bflo(own.w), bfhi(own.w)};
                float xp[8] = {bflo(par.x), bfhi(par.x), bflo(par.y), bfhi(par.y), bflo(par.z), bfhi(par.z), bflo(par.w), bfhi(par.w)};
                float cs[8] = {t0[0], t0[2], t1[0], t1[2], t2[0], t2[2], t3[0], t3[2]}, sn[8] = {t0[1], t0[3], t1[1], t1[3], t2[1], t2[3], t3[1], t3[3]};
                float o[8];
#pragma unroll
                for (int j = 0; j < 8; ++j) o[j] = xo[j] * cs[j] + sg * xp[j] * sn[j];
                outw.x = pk2(o[0], o[1]); outw.y = pk2(o[2], o[3]); outw.z = pk2(o[4], o[5]); outw.w = pk2(o[6], o[7]);
            }
#pragma unroll
            for (int h = 0; h < 4; ++h) *(GAS u32x4*)((GAS bf16_t*)Kc + (size_t)((b * 4 + h) * NKEY + key) * QKD + 64 + 8 * L) = outw;
        }
    }
    const int rpb = (MT + G - 1) / G;
    const int rbeg = BX * rpb, rend = min(rbeg + rpb, MT);
    const int c16 = tid & 63, ch = c16 * 4;
    const f32x4 cw0 = *(const f32x4*)(conv_w + ch), cw1 = *(const f32x4*)(conv_w + 256 + ch), cw2 = *(const f32x4*)(conv_w + 512 + ch);
    const int hw = 1 << (c16 >> 4);
    for (int row = rbeg + (tid >> 6); row < rend; row += 8) {
        int t, n; if (row < ML) { t = row & 4095; n = SEQ; } else { t = (row - ML) & 255; n = CTX; }
        const bf16_t* pr = P + (size_t)row * LDP;
        const u32x2 bg = *(const u32x2*)(pr + 256 + ch), cg = *(const u32x2*)(pr + 512 + ch), xi = *(const u32x2*)(pr + 768 + ch);
        const bool hp = t > 0, hn = t < n - 1;
        const bf16_t* pp = hp ? pr - LDP : pr; const bf16_t* pn = hn ? pr + LDP : pr;
        const u32x2 c0 = *(const u32x2*)(pp + 512 + ch), x0 = *(const u32x2*)(pp + 768 + ch), c2 = *(const u32x2*)(pn + 512 + ch), x2 = *(const u32x2*)(pn + 768 + ch);
        const bf16_t* pq = pr + 1024 + ch;
        u32x2 tap[16];
#pragma unroll
        for (int k = 0; k < 16; ++k) { const int d = k - 8; const bool ok = (d >= -hw) && (d < hw) && (t + d >= 0) && (t + d < n);
            tap[k] = *(const u32x2*)(pq + (ptrdiff_t)(ok ? d : 0) * LDP); if (!ok) tap[k] = (u32x2){0u, 0u}; }
        const u32x2 u0 = *(const u32x2*)pq;
        {
            const f32x4 z = (f32x4){bflo(cg.x) * bflo(xi.x), bfhi(cg.x) * bfhi(xi.x), bflo(cg.y) * bflo(xi.y), bfhi(cg.y) * bfhi(xi.y)};
            const f32x4 zp = (f32x4){bflo(c0.x) * bflo(x0.x), bfhi(c0.x) * bfhi(x0.x), bflo(c0.y) * bflo(x0.y), bfhi(c0.y) * bfhi(x0.y)};
            const f32x4 zn = (f32x4){bflo(c2.x) * bflo(x2.x), bfhi(c2.x) * bfhi(x2.x), bflo(c2.y) * bflo(x2.y), bfhi(c2.y) * bfhi(x2.y)};
            const f32x4 y = z * cw1 + zp * (hp ? cw0 : cw0 * 0.f) + zn * (hn ? cw2 : cw2 * 0.f);
            u32x2 w; w.x = cvt_pk_bf16(bflo(bg.x) * y[0], bfhi(bg.x) * y[1]); w.y = cvt_pk_bf16(bflo(bg.y) * y[2], bfhi(bg.y) * y[3]);
            *(u32x2*)(MIX + (size_t)row * DM + 256 + ch) = w;
        }
        {
            f32x4 sacc = (f32x4){0.f, 0.f, 0.f, 0.f};
#pragma unroll
            for (int k = 0; k < 16; ++k) sacc += (f32x4){bflo(tap[k].x), bfhi(tap[k].x), bflo(tap[k].y), bfhi(tap[k].y)};
            const int lo = max(t - hw, 0), hi = min(t + hw - 1, n - 1);
            const float ic = 1.0f / (float)(hi - lo + 1);
            u32x2 w; w.x = cvt_pk_bf16(sacc[0] * ic - bflo(u0.x), sacc[1] * ic - bfhi(u0.x)); w.y = cvt_pk_bf16(sacc[2] * ic - bflo(u0.y), sacc[3] * ic - bfhi(u0.y));
            *(u32x2*)(POOLIN + (size_t)row * 256 + ch) = w;
        }
    }
}

__device__ __forceinline__ void phase_dft_combine(unsigned char* ws, int tid, int lane, int wave, const int BX, const int G) {
    const GAS float* PT = (const GAS float*)(ws + WS_PT); const GAS float* QT = (const GAS float*)(ws + WS_QT);
    GAS bf16_t* MIX = (GAS bf16_t*)(ws + WS_MIX);
    const int gt = BX * 512 + tid, NGT = G * 512;
    for (int i = gt; i < 2048 * 512; i += NGT) {
        const int r = i >> 9, col = (i & 511) * 8, b = col >> 8, n = col & 255, k1 = r + 1;
        const f32x4 p0 = *(const GAS f32x4*)(PT + (size_t)r * 4096 + col), p1 = *(const GAS f32x4*)(PT + (size_t)r * 4096 + col + 4);
        const f32x4 q0 = *(const GAS f32x4*)(QT + (size_t)r * 4096 + col), q1 = *(const GAS f32x4*)(QT + (size_t)r * 4096 + col + 4);
        const float sc = 1.f / 512.f;
        *(gv4p)(MIX + (size_t)(b * SEQ + k1) * DM + n) = pack8((p0 - q0) * sc, (p1 - q1) * sc);
        *(gv4p)(MIX + (size_t)(b * SEQ + 4096 - k1) * DM + n) = pack8((p0 + q0) * sc, (p1 + q1) * sc);
    }
    const GAS bf16_t* UT = (const GAS bf16_t*)(ws + WS_UT);
    const int gw = BX * 8 + wave, NGW = G * 8;
    for (int rowi = gw; rowi < 4096; rowi += NGW) {
        const GAS u32x4* src = (const GAS u32x4*)(UT + (size_t)rowi * 8192) + lane;
        float sacc = 0.f;
#pragma unroll
        for (int c = 0; c < 8; ++c) { const u32x4 w = src[c * 64]; sacc += (bflo(w.x) + bfhi(w.x)) + (bflo(w.y) + bfhi(w.y)) + (bflo(w.z) + bfhi(w.z)) + (bflo(w.w) + bfhi(w.w)); }
        sacc = wave_sum(sacc, lane);
        if (lane == 0) { const int b = rowi >> 8, n = rowi & 255; MIX[(size_t)(b * SEQ) * DM + n] = (bf16_t)f2bf(sacc * (1.f / 512.f)); }
    }
}

constexpr int KROW = 208, VROW = 144, KBUF = 64 * KROW, VBUF = 64 * VROW, ABUF = KBUF + VBUF;
__device__ __forceinline__ void attn_unit(LAS unsigned char* lds, const bf16_t* Qb, const bf16_t* Kb, const bf16_t* Vtb, int nk, bf16_t* Ob, bool rope, int tok0, const int tid, const float* ropetab) {
    const int lane = tid & 63, r = lane & 31, hi = lane >> 5, wid = tid >> 6;
    bf16x8 qf[6];
    const bf16_t* qrow = Qb + (size_t)(wid * 32 + r) * 384 + 8 * hi;
#pragma unroll
    for (int d0 = 0; d0 < 6; ++d0) qf[d0] = *(const bf16x8*)(qrow + d0 * 16);
    if (rope) {
        const int t = tok0 + wid * 32 + r;
#pragma unroll
        for (int d0 = 4; d0 < 6; ++d0) {
            const int ipos = d0 == 4 ? (t >> 6) : (t & 63);
            bf16x8 o;
#pragma unroll
            for (int j = 0; j < 8; ++j) {
                const float own = bf1((bf16_t)qf[d0][j]);
                const float partner = shx(own, 32, lane);
                const f32x2 csn = *(const GAS f32x2*)(ropetab + (ipos * 8 + j) * 2); const float cs = csn[0], sn = csn[1];
                o[j] = (short)f2bf(own * cs + (hi ? partner : -partner) * sn);
            }
            qf[d0] = o;
        }
    }
    const int kc0 = tid, kc1 = tid + 512;
    const int kr0 = kc0 / 12, kcc0 = kc0 % 12, kr1 = kc1 / 12, kcc1 = kc1 % 12;
    const bool k1v = kc1 < 768;
    const int vr = tid >> 3, vcc = tid & 7;
    const bf16_t* kg0 = Kb + (size_t)kr0 * QKD + kcc0 * 8;
    const bf16_t* kg1 = Kb + (size_t)kr1 * QKD + kcc1 * 8;
    const bf16_t* vg = Vtb + (size_t)vr * NKEY + vcc * 8;
    const int kl0 = kr0 * KROW + kcc0 * 16, kl1 = kr1 * KROW + kcc1 * 16, vl = KBUF + vr * VROW + vcc * 16;
    const int NT = nk >> 6;
    u32x4 sk0, sk1 = (u32x4){0u, 0u, 0u, 0u}, sv;
    sk0 = *(const u32x4*)kg0; if (k1v) sk1 = *(const u32x4*)kg1; sv = *(const u32x4*)vg;
    *(LAS u32x4*)(lds + kl0) = sk0; if (k1v) *(LAS u32x4*)(lds + kl1) = sk1; *(LAS u32x4*)(lds + vl) = sv;
    __syncthreads();
    f32x16 ot0, ot1;
#pragma unroll
    for (int i = 0; i < 16; ++i) { ot0[i] = 0.f; ot1[i] = 0.f; }
    float l_run = 0.f;
    f32x16 negm;
#pragma unroll
    for (int i = 0; i < 16; ++i) negm[i] = 0.f;
    asm volatile("" : "+v"(negm));
    for (int tI = 0; tI < NT; ++tI) {
        LAS unsigned char* cur = lds + (tI & 1) * ABUF;
        LAS unsigned char* nxt = lds + ((tI + 1) & 1) * ABUF;
        const bool more = tI + 1 < NT;
        if (more) { const size_t ko = (size_t)(tI + 1) * 64 * QKD; sk0 = *(const u32x4*)(kg0 + ko); if (k1v) sk1 = *(const u32x4*)(kg1 + ko); sv = *(const u32x4*)(vg + (tI + 1) * 64); }
        f32x16 s0, s1;
        __builtin_amdgcn_s_setprio(1);
#pragma unroll
        for (int d0 = 0; d0 < 6; ++d0) {
            const bf16x8 a0 = *(const LAS bf16x8*)(cur + r * KROW + d0 * 32 + hi * 16);
            const bf16x8 a1 = *(const LAS bf16x8*)(cur + (32 + r) * KROW + d0 * 32 + hi * 16);
            if (d0 == 0) { s0 = __builtin_amdgcn_mfma_f32_32x32x16_bf16(a0, qf[0], negm, 0, 0, 0); s1 = __builtin_amdgcn_mfma_f32_32x32x16_bf16(a1, qf[0], negm, 0, 0, 0); }
            else { s0 = __builtin_amdgcn_mfma_f32_32x32x16_bf16(a0, qf[d0], s0, 0, 0, 0); s1 = __builtin_amdgcn_mfma_f32_32x32x16_bf16(a1, qf[d0], s1, 0, 0, 0); }
        }
        __builtin_amdgcn_s_setprio(0);
        float mx = s0[0];
#pragma unroll
        for (int i = 1; i < 16; ++i) mx = fmaxf(mx, s0[i]);
#pragma unroll
        for (int i = 0; i < 16; ++i) mx = fmaxf(mx, s1[i]);
        if (tI == 0 || __builtin_amdgcn_ballot_w64(mx > 8.0f) != 0ull) {
            mx = fmaxf(mx, shx(mx, 32, lane));
            const float dl = tI == 0 ? mx : fmaxf(mx, 0.f);
            const float alpha = tI == 0 ? 0.f : __builtin_amdgcn_exp2f(-dl);
#pragma unroll
            for (int i = 0; i < 16; ++i) { s0[i] -= dl; s1[i] -= dl; ot0[i] *= alpha; ot1[i] *= alpha; negm[i] -= dl; }
            l_run *= alpha;
            asm volatile("" : "+v"(negm));
        }
        float ps = 0.f;
#pragma unroll
        for (int i = 0; i < 16; ++i) { s0[i] = __builtin_amdgcn_exp2f(s0[i]); s1[i] = __builtin_amdgcn_exp2f(s1[i]); ps += s0[i] + s1[i]; }
        l_run += ps;
        bf16x8 pb[4];
#pragma unroll
        for (int s = 0; s < 4; ++s) {
            u32x4 w;
            if (s < 2) { w.x = cvt_pk_bf16(s0[8 * s + 0], s0[8 * s + 1]); w.y = cvt_pk_bf16(s0[8 * s + 2], s0[8 * s + 3]); w.z = cvt_pk_bf16(s0[8 * s + 4], s0[8 * s + 5]); w.w = cvt_pk_bf16(s0[8 * s + 6], s0[8 * s + 7]); }
            else { const int q = s - 2; w.x = cvt_pk_bf16(s1[8 * q + 0], s1[8 * q + 1]); w.y = cvt_pk_bf16(s1[8 * q + 2], s1[8 * q + 3]); w.z = cvt_pk_bf16(s1[8 * q + 4], s1[8 * q + 5]); w.w = cvt_pk_bf16(s1[8 * q + 6], s1[8 * q + 7]); }
            pb[s] = __builtin_bit_cast(bf16x8, w);
        }
#pragma unroll
        for (int s = 0; s < 4; ++s) {
            const int ko = (16 * s + 8 * hi) * 2;
            const bf16x8 a0 = *(const LAS bf16x8*)(cur + KBUF + r * VROW + ko), a1 = *(const LAS bf16x8*)(cur + KBUF + (32 + r) * VROW + ko);
            __builtin_amdgcn_s_setprio(1);
            ot0 = __builtin_amdgcn_mfma_f32_32x32x16_bf16(a0, pb[s], ot0, 0, 0, 0);
            ot1 = __builtin_amdgcn_mfma_f32_32x32x16_bf16(a1, pb[s], ot1, 0, 0, 0);
            __builtin_amdgcn_s_setprio(0);
        }
        if (more) { *(LAS u32x4*)(nxt + kl0) = sk0; if (k1v) *(LAS u32x4*)(nxt + kl1) = sk1; *(LAS u32x4*)(nxt + vl) = sv; }
        __syncthreads();
    }
    const float lt = l_run + shx(l_run, 32, lane);
    const float il = 1.0f / lt;
    bf16_t* orow = Ob + (size_t)(wid * 32 + r) * DM;
#pragma unroll
    for (int g = 0; g < 4; ++g) {
        u32x2 w0, w1;
        w0.x = cvt_pk_bf16(ot0[4 * g] * il, ot0[4 * g + 1] * il); w0.y = cvt_pk_bf16(ot0[4 * g + 2] * il, ot0[4 * g + 3] * il);
        w1.x = cvt_pk_bf16(ot1[4 * g] * il, ot1[4 * g + 1] * il); w1.y = cvt_pk_bf16(ot1[4 * g + 2] * il, ot1[4 * g + 3] * il);
        *(u32x2*)(orow + 8 * g + 4 * hi) = w0;
        *(u32x2*)(orow + 32 + 8 * g + 4 * hi) = w1;
    }
}
__device__ __forceinline__ void phase_attention(LAS unsigned char* lds, unsigned char* ws, bool with_ctx, const int tid, const int bx, const int G) {
    const int vcu = (G % 8 == 0) ? (bx % 8) * (G / 8) + bx / 8 : bx;
    const bf16_t* Q = (const bf16_t*)(ws + WS_Q); const bf16_t* Qc = (const bf16_t*)(ws + WS_QC);
    const bf16_t* Kc = (const bf16_t*)(ws + WS_KC); const bf16_t* Vt = (const bf16_t*)(ws + WS_VT);
    bf16_t* MIX = (bf16_t*)(ws + WS_MIX);
    const int nunits = 1024 + (with_ctx ? 64 : 0);
    for (int u = vcu; u < nunits; u += G) {
        if (u < 1024) {
            const int bh = u >> 4, qb = u & 15, b = bh >> 2, h = bh & 3;
            attn_unit(lds, Q + (size_t)(b * SEQ + qb * 256) * 384 + h * QKD, Kc + (size_t)bh * NKEY * QKD, Vt + (size_t)bh * 64 * NKEY, NKEY,
                      MIX + (size_t)(b * SEQ + qb * 256) * DM + 768 + h * 64, true, qb * 256, tid, (const float*)(ws + WS_ROPE));
        } else {
            const int bh = u - 1024, b = bh >> 2, h = bh & 3;
            attn_unit(lds, Qc + (size_t)(b * CTX) * 384 + h * QKD, Kc + (size_t)bh * NKEY * QKD, Vt + (size_t)bh * 64 * NKEY, CTX,
                      MIX + (size_t)(ML + b * CTX) * DM + 768 + h * 64, false, 0, tid, (const float*)(ws + WS_ROPE));
        }
    }
}

struct Job { pg8::Gemm g; Epi e; };
__device__ __forceinline__ bool get_job(KArgs ap, unsigned char* ws, float* outp, int l, int kind, int j, Job& J) {
    unsigned char* wl = ws + (size_t)l * WL;
    const int Mx = l == 0 ? MT : ML;
    bf16_t* P = (bf16_t*)(ws + WS_P); bf16_t* MIX = (bf16_t*)(ws + WS_MIX); bf16_t* H = (bf16_t*)(ws + WS_H);
    const float* rq = (const float*)(ws + WS_RQ); const float* rkv = (const float*)(ws + WS_RKV);
    const float* mod = (const float*)(ws + WS_MOD) + (size_t)l * 17 * 6144;
    float* xc = (float*)(ws + WS_XC);
    J.e.e = EpiArgs{nullptr, nullptr, nullptr, nullptr, nullptr, nullptr, 0, 0};
    if (kind == 0) { if (j) return false;
        J.g = pg8::Gemm{H, (const bf16_t*)(wl + O_WIN), MT, LDP, DM, DM, DM}; J.e.mode = l == 0 ? M_P : M_PS; J.e.e.o0 = P; J.e.e.ld = LDP;
        J.e.e.f0 = (const float*)(ws + WS_RSS + 2 * RSS_STRIDE); J.e.e.f1 = (const float*)(ws + WS_VEC) + V_CB1; J.e.e.goff = LDP; return true; }
    if (kind == 1) { if (j) return false;
        J.g = pg8::Gemm{(const bf16_t*)(wl + O_WF), P, 512, Mx, 256, 256, LDP}; J.e.mode = M_UT; J.e.e.o0 = (bf16_t*)(ws + WS_UT); J.e.e.o1 = (bf16_t*)(ws + WS_UTC); return true; }
    if (kind == 2) {
        switch (j) {
            case 0: J.g = pg8::Gemm{(const bf16_t*)(ws + WS_DFT), (const bf16_t*)(ws + WS_UT), 2048, 4096, 4096, 4096, 8192}; J.e.mode = M_F32; J.e.e.o0 = (bf16_t*)(ws + WS_PT); return true;
            case 6: J.g = pg8::Gemm{(const bf16_t*)(ws + WS_DFT) + (size_t)2048 * 4096, (const bf16_t*)(ws + WS_UT) + 4096, 2048, 4096, 4096, 4096, 8192}; J.e.mode = M_F32; J.e.e.o0 = (bf16_t*)(ws + WS_QT); return true;
            case 1: J.g = pg8::Gemm{P + 1280, (const bf16_t*)(wl + O_WUQ), Mx, 512, 256, LDP, 256}; J.e.mode = M_Q; J.e.e.o0 = (bf16_t*)(ws + WS_Q); J.e.e.o1 = (bf16_t*)(ws + WS_QC); J.e.e.f0 = rq; return true;
            case 2: J.g = pg8::Gemm{P + 1536, (const bf16_t*)(wl + O_WK), MT, 256, 128, LDP, 128}; J.e.mode = M_K; J.e.e.o0 = (bf16_t*)(ws + WS_KC); J.e.e.f0 = rkv; return true;
            case 3: J.g = pg8::Gemm{(const bf16_t*)(wl + O_WV), P + 1536, 256, MT, 128, 128, LDP}; J.e.mode = M_VT; J.e.e.o0 = (bf16_t*)(ws + WS_VT); J.e.e.f0 = rkv; return true;
            case 4: J.g = pg8::Gemm{(const bf16_t*)(ws + WS_POOLIN), (const bf16_t*)(wl + O_POOL), Mx, 256, 256, 256, 256}; J.e.mode = M_POOL; J.e.e.o0 = MIX; J.e.e.f0 = ap->in[12] + l * 256; return true;
            case 5: if (l != 0) return false;
                J.g = pg8::Gemm{(const bf16_t*)(ws + WS_DFTC), (const bf16_t*)(ws + WS_UTC), 256, 4096, 512, 512, 512}; J.e.mode = M_DFTC; J.e.e.o0 = MIX; return true;
            default: return false;
        }
    }
    if (kind == 4 || kind == 7) { if (j) return false;
        if (kind == 4) J.g = pg8::Gemm{MIX, (const bf16_t*)(wl + O_WOUT), Mx, DM, DM, DM, DM};
        else J.g = pg8::Gemm{(const bf16_t*)(ws + WS_ACT), (const bf16_t*)(wl + O_W2), Mx, DM, DFF, DFF, DFF};
        J.e.mode = M_RES; J.e.e.o1 = (bf16_t*)mod; J.e.e.goff = kind == 4 ? 2048 : 5120;
        J.e.e.f0 = (l == 0 && kind == 4) ? ap->in[0] : outp; J.e.e.f1 = (l == 0 && kind == 4) ? ap->in[2] : xc; J.e.e.x0 = outp; J.e.e.x1 = xc;
        J.e.e.ld = kind == 4 ? 1 + l : (l == 0 ? 3 : 0); return true; }
    if (kind == 6) { if (j) return false;
        J.g = pg8::Gemm{H, (const bf16_t*)(wl + O_W1), Mx, DFF, DM, DM, DM}; J.e.mode = M_RELU2; J.e.e.o0 = (bf16_t*)(ws + WS_ACT); J.e.e.ld = DFF;
        J.e.e.f0 = (const float*)(ws + WS_RSS + (size_t)l * RSS_STRIDE); J.e.e.f1 = (const float*)(ws + WS_VEC) + V_CB2 + l * 17 * 4096; J.e.e.goff = DFF; return true; }
    return false;
}

#define XB_TMO      128
#define XB_XCNT(j)  (256  + 64 * (j))
#define XB_XSUB(j)  (1280 + 64 * (j))
#define XB_XGEN(j)  (2304 + 64 * (j))
#define XB_TOP      3328
#define XB_TOPGEN   3392
#define XCD_BAR_WORDS 3456
#define XB_SPIN_CAP (1u << 18)
__device__ __forceinline__ unsigned xb_ld(unsigned* p)              { return __hip_atomic_load(p, __ATOMIC_RELAXED, __HIP_MEMORY_SCOPE_AGENT); }
__device__ __forceinline__ unsigned xb_add(unsigned* p, unsigned v) { return __hip_atomic_fetch_add(p, v, __ATOMIC_RELAXED, __HIP_MEMORY_SCOPE_AGENT); }
__device__ __forceinline__ unsigned xb_xcc_id() { return (unsigned)__builtin_amdgcn_s_getreg((3 << 11) | 20) & 0xFu; }
#define XB_SPIN(cond, bar) do { unsigned _sp = 0; while (cond) { __builtin_amdgcn_s_sleep(1); \
    if ((++_sp & 255u) == 0u) { if (xb_ld(&(bar)[XB_TMO])) break; if (_sp > XB_SPIN_CAP) { atomicAdd(&(bar)[XB_TMO], 1u); break; } } } } while (0)
struct XcdBarrier { unsigned* bar; unsigned x; volatile LAS unsigned* st; };
__device__ __forceinline__ XcdBarrier xcd_barrier_post(unsigned* bar, volatile LAS unsigned* st) {
    XcdBarrier b; b.bar = bar; b.x = xb_xcc_id(); b.st = st;
    if (threadIdx.x == 0) (void)xb_add(&bar[XB_XCNT(b.x)], 1u);
    return b;
}
__device__ __forceinline__ void xcd_barrier_complete(unsigned* bar, unsigned x, unsigned& nloc, unsigned& nx) {
    const unsigned G = gridDim.x * gridDim.y * gridDim.z;
    unsigned sum, cnt, mine, sp = 0u;
    for (;;) {
        sum = 0u; cnt = 0u; mine = 0u;
#pragma unroll
        for (unsigned j = 0; j < 16; ++j) { const unsigned c = xb_ld(&bar[XB_XCNT(j)]); sum += c; cnt += (c > 0u) ? 1u : 0u; mine = (j == x) ? c : mine; }
        if (sum == G) break;
        __builtin_amdgcn_s_sleep(1);
        if ((++sp & 255u) == 0u) { if (xb_ld(&bar[XB_TMO])) break; if (sp > XB_SPIN_CAP) { atomicAdd(&bar[XB_TMO], 1u); break; } }
    }
    nloc = mine > 0u ? mine : 1u; nx = cnt > 0u ? cnt : 1u;
}
__device__ __forceinline__ void xcd_barrier(const XcdBarrier& b) {
    asm volatile("s_waitcnt vmcnt(0)" ::: "memory");
    __syncthreads();
    if (threadIdx.x == 0) {
        unsigned* bar = b.bar;
        __builtin_amdgcn_s_waitcnt(0);
        unsigned nloc = b.st[0], nx = b.st[1];
        if (nloc == 0u) { xcd_barrier_complete(bar, b.x, nloc, nx); b.st[0] = nloc; b.st[1] = nx; }
        const unsigned old = xb_add(&bar[XB_XSUB(b.x)], 1u);
        const unsigned gen = old / nloc;
        if (old + 1u == (gen + 1u) * nloc) {
            __builtin_amdgcn_fence(__ATOMIC_RELEASE, "agent");
            asm volatile("s_waitcnt vmcnt(0)" ::: "memory");
            const unsigned og = xb_add(&bar[XB_TOP], 1u);
            const unsigned tg = og / nx;
            if (og + 1u == (tg + 1u) * nx) xb_add(&bar[XB_TOPGEN], 1u);
            else XB_SPIN(xb_ld(&bar[XB_TOPGEN]) == tg, bar);
            __builtin_amdgcn_fence(__ATOMIC_ACQUIRE, "agent");
            xb_add(&bar[XB_XGEN(b.x)], 1u);
            asm volatile("s_waitcnt vmcnt(0)" ::: "memory");
        } else {
            XB_SPIN(xb_ld(&bar[XB_XGEN(b.x)]) == gen, bar);
            __builtin_amdgcn_fence(__ATOMIC_ACQUIRE, "agent");
            asm volatile("s_waitcnt vmcnt(0)" ::: "memory");
        }
    }
    __syncthreads();
}

constexpr int LDS_BYTES = 147456;
constexpr int N_PHASES = 2 + 9 * 2;
template <int PH> __device__ __forceinline__ void run_phase(LAS unsigned char* lds) {
    int tid = threadIdx.x; asm volatile("" : "+v"(tid));
    int BX = blockIdx.x, G = gridDim.x; asm volatile("" : "+s"(BX), "+s"(G));
    const int lane = tid & 63, wave = __builtin_amdgcn_readfirstlane(tid >> 6);
    KArgs ap = (KArgs)__builtin_amdgcn_kernarg_segment_ptr(); asm volatile("" : "+s"(ap));
    unsigned char* ws = ap->ws; float* outp = ap->out;
    if constexpr (PH == 0) {
        phase_setup(ap, ws, lds, tid, lane, wave, BX, G);
    } else if constexpr (PH == 1) {
        phase_vectors(ap, ws, lds, tid, lane, wave, BX, G);
        phase_norm_mod(ap->in[0], ap->in[2], ap->in[6], (const float*)(ws + WS_MOD), 0, 1024, (bf16_t*)(ws + WS_H), MT, lane, wave, BX, G);
    } else {
        constexpr int l = (PH - 2) / 9, kind = (PH - 2) % 9;
        const float* mod = (const float*)(ws + WS_MOD) + (size_t)l * 17 * 6144;
        if constexpr (kind == 1) phase_token_local((const bf16_t*)(ws + WS_P), (float*)(ws + WS_RQ), (float*)(ws + WS_RKV), (bf16_t*)(ws + WS_KC), (bf16_t*)(ws + WS_MIX), (bf16_t*)(ws + WS_POOLIN), ap->in[10] + l * 768, (const float*)(ws + WS_ROPE), tid, lane, wave, BX, G);
        if constexpr (kind == 3) { phase_dft_combine(ws, tid, lane, wave, BX, G); phase_attention(lds, ws, l == 0, tid, BX, G); }
        else if constexpr (kind == 5) { }
        else if constexpr (kind == 8) {
            if constexpr (l == 0) { }
            else phase_final_norm(outp, ap->in[20], lane, wave, BX, G);
        } else {
            Job J; int lr = l, kr = kind; asm volatile("" : "+s"(lr), "+s"(kr));
            for (int j = 0;; ++j) {
                KArgs ap2 = ap; unsigned char* ws2 = ws; float* out2 = outp; int tid2 = tid, BX2 = BX, G2 = G;
                asm volatile("" : "+s"(ap2), "+s"(ws2), "+s"(out2), "+v"(tid2), "+s"(BX2), "+s"(G2));
                if (kr == 2 && j > 6) break;
                const int jj = kr == 2 ? (j == 0 ? 0 : j == 1 ? 6 : j - 1) : j;
                if (!get_job(ap2, ws2, out2, lr, kr, jj, J)) break;
                const int rot = kr == 2 ? (jj == 6 ? 128 : jj == 2 ? 32 : jj == 3 ? 48 : jj == 4 ? 64 : jj == 5 ? 80 : 0) : 0;
                pg8::StaticOrder S; S.init(J.g.M, J.g.N, G2, (BX2 + rot) % G2);
                pg8::gemm_phase<Epi>(lds, J.g, S, J.e, tid2);
            }
        }
    }
}
__global__ void __launch_bounds__(512, 2) fwd_megakernel(Args a) {
    extern __shared__ __attribute__((aligned(16))) unsigned char lds_raw[];
    LAS unsigned char* lds = (LAS unsigned char*)lds_raw;
    cg::grid_group grid = cg::this_grid();
    const int ph_lo = a.ph_lo, ph_hi = a.ph_hi;
    for (int u = threadIdx.x; u < (LDS_BYTES - 131072) / 4; u += 512) ((LAS unsigned*)(lds + 131072))[u] = 0u;
    __syncthreads();
    if (blockIdx.x == 0) for (int u = threadIdx.x; u < (int)(CTL_BYTES / 4); u += 512) ((unsigned*)(a.ws + WS_CTL))[u] = 0u;
    XcdBarrier bar; bar.bar = (unsigned*)(a.ws + WS_CTL); bar.x = 0; bar.st = (volatile LAS unsigned*)(lds + 131072 + 64);
#ifndef EXP_SYNC
#define EXP_SYNC 0
#endif
#ifndef EXP_REP
#define EXP_REP(k) 0
#endif
#define PH_EMPTY(k) ((k) == 7 || (k) == 16 || (k) == 10)
#define PHASE(k) if (!PH_EMPTY(k) && ph_lo <= (k) && (k) < ph_hi) { run_phase<k>(lds); if (EXP_REP(k)) { grid.sync(); run_phase<k>(lds); } if ((k) + 1 < ph_hi) { if ((k) == 0) { grid.sync(); bar = xcd_barrier_post((unsigned*)(a.ws + WS_CTL), (volatile LAS unsigned*)(lds + 131072 + 64)); } else xcd_barrier(bar); if (EXP_SYNC) xcd_barrier(bar); } }
    PHASE(0) PHASE(1) PHASE(2) PHASE(3) PHASE(4) PHASE(5) PHASE(6) PHASE(7) PHASE(8) PHASE(9) PHASE(10)
    PHASE(11) PHASE(12) PHASE(13) PHASE(14) PHASE(15) PHASE(16) PHASE(17) PHASE(18) PHASE(19)
#undef PHASE
}

#ifndef MK_MULTI_LAUNCH
#define MK_MULTI_LAUNCH 0
#endif
extern "C" void kernel_launch(void* const* d_in, const int* in_sizes, int n_in, void* d_out, int out_size, void* d_ws, size_t ws_size, hipStream_t stream) {
    static int grid = 0;
    if (grid == 0) {
        int dev = 0, cus = 0, per_cu = 0;
        hipGetDevice(&dev);
        hipDeviceGetAttribute(&cus, hipDeviceAttributeMultiprocessorCount, dev);
        hipFuncSetAttribute((const void*)fwd_megakernel, hipFuncAttributeMaxDynamicSharedMemorySize, LDS_BYTES);
        hipOccupancyMaxActiveBlocksPerMultiprocessor(&per_cu, (const void*)fwd_megakernel, 512, LDS_BYTES);
        (void)hipGetLastError();
        if (cus <= 0) cus = 256;
        grid = cus;
        if (per_cu < 1) fprintf(stderr, "kernel_launch: occupancy query says %d blocks/CU\n", per_cu);
        if (ws_size < WS_END) { fprintf(stderr, "kernel_launch: workspace too small (%zu < %zu)\n", ws_size, (size_t)WS_END); grid = -1; }
    }
    if (grid < 0) return;
    Args a{};
    for (int i = 0; i < 21; ++i) a.in[i] = (const float*)d_in[i];
    a.out = (float*)d_out; a.ws = (unsigned char*)d_ws;
#if MK_MULTI_LAUNCH
    for (int ph = 0; ph < N_PHASES; ++ph) { a.ph_lo = ph; a.ph_hi = ph + 1; hipLaunchKernelGGL(fwd_megakernel, dim3(grid), dim3(512), LDS_BYTES, stream, a); }
#else
    a.ph_lo = 0; a.ph_hi = N_PHASES;
    void* args[] = {&a};
    hipError_t e = hipLaunchCooperativeKernel((const void*)fwd_megakernel, dim3(grid), dim3(512), args, LDS_BYTES, stream);
    if (e != hipSuccess) fprintf(stderr, "cooperative launch failed: %s (grid %d)\n", hipGetErrorString(e), grid);
#endif
}
```
